# Optimizing an MI355X kernel written in HIP

```python
import math
import jax, jax.numpy as jnp
from jax import lax
import numpy as np

D_MODEL = 1024
BATCH = 2
SEQ = 16384
DEPTH = 2

GRID_W = 64
CTX_LEN = 256
N_EVEN = (DEPTH + 1) // 2
N_ODD = DEPTH // 2
D_FF = 2816
N_MOD = 9
EPS = 1e-6
NEG_INF = -1e30

GM_CHUNK = 128
GM_GROUPS = 4
GM_WIDTH = D_MODEL // 2
GM_GROUP_CH = GM_WIDTH // GM_GROUPS

HEAD_DIM = 64
N_Q_HEADS = (D_MODEL // 2) // HEAD_DIM
N_KV_HEADS = 2
Q_PER_KV = N_Q_HEADS // N_KV_HEADS
WINDOW = 128
ATT_BLOCK = 128
ROPE_BASE = 10000.0

Q_WIDTH = N_Q_HEADS * HEAD_DIM
KV_WIDTH = N_KV_HEADS * HEAD_DIM
KV_START = 2 * GM_WIDTH + Q_WIDTH
EVEN_IN = KV_START + 2 * KV_WIDTH
EVEN_MIX = GM_WIDTH + Q_WIDTH

RNN_WIDTH = D_MODEL
RG_HEADS = 4
RG_BLOCK = RNN_WIDTH // RG_HEADS
CONV_W = 4
CONV_LEFT = 1
RG_C = 8.0
ODD_IN = 2 * RNN_WIDTH

kernel_name = "hybrid_gmlp_swa_rglru_prefix_dit"


def rmsnorm(x, g):
    xf = x.astype(jnp.float32)
    y = xf * lax.rsqrt(jnp.mean(xf * xf, axis=-1, keepdims=True) + EPS)
    return (y * g.astype(jnp.float32)).astype(x.dtype)


def modulate(h, shift, scale):
    return h * (1.0 + scale) + shift


def swiglu(h, wg, wu, wd):
    return (jax.nn.silu(h @ wg) * (h @ wu)) @ wd


def ffn_half_step(x, g, shift, scale, gate, wg, wu, wd):
    h = modulate(rmsnorm(x, g), shift, scale)
    return x + 0.5 * gate * swiglu(h, wg, wu, wd)


def rope_tables(n_tokens):
    pos = jnp.arange(n_tokens, dtype=jnp.int32)
    row = (pos // GRID_W).astype(jnp.float32)
    col = (pos % GRID_W).astype(jnp.float32)
    n_freq = HEAD_DIM // 4
    inv = ROPE_BASE ** (-jnp.arange(n_freq, dtype=jnp.float32) / n_freq)
    ang_r = row[:, None] * inv
    ang_c = col[:, None] * inv
    return jnp.cos(ang_r), jnp.sin(ang_r), jnp.cos(ang_c), jnp.sin(ang_c)


def _rot(x, cos, sin):
    x1, x2 = jnp.split(x, 2, axis=-1)
    cos = cos[:, None, :]
    sin = sin[:, None, :]
    return jnp.concatenate([x1 * cos - x2 * sin, x1 * sin + x2 * cos], axis=-1)


def rope_2d(x, tables):
    cr, sr, cc, sc = tables
    xr, xc = jnp.split(x, 2, axis=-1)
    return jnp.concatenate([_rot(xr, cr, sr), _rot(xc, cc, sc)], axis=-1).astype(x.dtype)


def spatial_gating(u, z, gain, ws, bs):
    B, N, _ = u.shape
    z = rmsnorm(z, gain).reshape(B, N // GM_CHUNK, GM_CHUNK, GM_GROUPS, GM_GROUP_CH)
    s = jnp.einsum('gpq,bnqgc->bnpgc', ws, z) + bs.T[None, None, :, :, None]
    return u * s.reshape(B, N, GM_WIDTH)


def window_attention(q, k, v, k_ctx, v_ctx, sink):
    B, S = q.shape[0], q.shape[1]
    L = k_ctx.shape[1]
    nblk = S // ATT_BLOCK
    n_loc = 3 * ATT_BLOCK
    scale = HEAD_DIM ** -0.5
    qb = q.reshape(B, nblk, ATT_BLOCK, N_KV_HEADS, Q_PER_KV, HEAD_DIM)
    pad = ((0, 0), (ATT_BLOCK, ATT_BLOCK), (0, 0), (0, 0))
    kp = jnp.pad(k, pad).reshape(B, nblk + 2, ATT_BLOCK, N_KV_HEADS, HEAD_DIM)
    vp = jnp.pad(v, pad).reshape(B, nblk + 2, ATT_BLOCK, N_KV_HEADS, HEAD_DIM)

    def band(t):
        return jnp.concatenate([t[:, :-2], t[:, 1:-1], t[:, 2:]], axis=2)

    kb, vb = band(kp), band(vp)
    blk = jnp.arange(nblk, dtype=jnp.int32)[:, None]
    qpos = blk * ATT_BLOCK + jnp.arange(ATT_BLOCK, dtype=jnp.int32)[None]
    kpos = (blk - 1) * ATT_BLOCK + jnp.arange(n_loc, dtype=jnp.int32)[None]
    kp_ = kpos[:, None, :]
    mask = (jnp.abs(kp_ - qpos[:, :, None]) <= WINDOW) & (kp_ >= 0) & (kp_ < S)
    sink_g = sink.reshape(N_KV_HEADS, Q_PER_KV).astype(jnp.float32)

    def block(args):
        qj, kj, vj, mj = args
        s_loc = jnp.einsum('bqkgd,bnkd->bkgqn', qj, kj).astype(jnp.float32) * scale
        s_loc = jnp.where(mj, s_loc, NEG_INF)
        s_ctx = jnp.einsum('bqkgd,bnkd->bkgqn', qj, k_ctx).astype(jnp.float32) * scale
        s_sink = jnp.broadcast_to(sink_g[None, :, :, None, None], s_loc.shape[:-1] + (1,))
        p = jax.nn.softmax(jnp.concatenate([s_loc, s_ctx, s_sink], axis=-1), axis=-1)
        p_loc = p[..., :n_loc].astype(vj.dtype)
        p_ctx = p[..., n_loc:n_loc + L].astype(vj.dtype)
        return (jnp.einsum('bkgqn,bnkd->bqkgd', p_loc, vj)
                + jnp.einsum('bkgqn,bnkd->bqkgd', p_ctx, v_ctx))

    o = lax.map(block, (jnp.moveaxis(qb, 1, 0), jnp.moveaxis(kb, 1, 0),
                        jnp.moveaxis(vb, 1, 0), mask))
    return jnp.moveaxis(o, 0, 1).reshape(B, S, Q_WIDTH)


def context_attention(q, k, v, sink):
    B, L = q.shape[0], q.shape[1]
    qg = q.reshape(B, L, N_KV_HEADS, Q_PER_KV, HEAD_DIM)
    s = jnp.einsum('bqkgd,bnkd->bkgqn', qg, k).astype(jnp.float32) * (HEAD_DIM ** -0.5)
    sink_g = sink.reshape(N_KV_HEADS, Q_PER_KV).astype(jnp.float32)
    s_sink = jnp.broadcast_to(sink_g[None, :, :, None, None], s.shape[:-1] + (1,))
    p = jax.nn.softmax(jnp.concatenate([s, s_sink], axis=-1), axis=-1)[..., :L].astype(v.dtype)
    return jnp.einsum('bkgqn,bnkd->bqkgd', p, v).reshape(B, L, Q_WIDTH)


def even_mixer(hx, hc, rope, w_in, w_out, gm_g, gm_ws, gm_bs, sink, need_ctx):
    B, S, _ = hx.shape
    L = hc.shape[1]
    ux, zx, qx, kx, vx = jnp.split(
        hx @ w_in, [GM_WIDTH, 2 * GM_WIDTH, KV_START, KV_START + KV_WIDTH], axis=-1)
    kc, vc = jnp.split(hc @ w_in[:, KV_START:], 2, axis=-1)
    kc = kc.reshape(B, L, N_KV_HEADS, HEAD_DIM)
    vc = vc.reshape(B, L, N_KV_HEADS, HEAD_DIM)
    qx = rope_2d(qx.reshape(B, S, N_Q_HEADS, HEAD_DIM), rope)
    kx = rope_2d(kx.reshape(B, S, N_KV_HEADS, HEAD_DIM), rope)
    vx = vx.reshape(B, S, N_KV_HEADS, HEAD_DIM)
    a_x = spatial_gating(jax.nn.gelu(ux), jax.nn.gelu(zx), gm_g, gm_ws, gm_bs)
    b_x = window_attention(qx, kx, vx, kc, vc, sink)
    yx = jnp.concatenate([a_x, b_x], axis=-1) @ w_out
    if not need_ctx:
        return yx, None
    uc, zc, qc = jnp.split(hc @ w_in[:, :KV_START], [GM_WIDTH, 2 * GM_WIDTH], axis=-1)
    a_c = spatial_gating(jax.nn.gelu(uc), jax.nn.gelu(zc), gm_g, gm_ws, gm_bs)
    b_c = context_attention(qc.reshape(B, L, N_Q_HEADS, HEAD_DIM), kc, vc, sink)
    yc = jnp.concatenate([a_c, b_c], axis=-1) @ w_out
    return yx, yc


def centred_dwconv(x, w, b):
    C = x.shape[-1]
    y = lax.conv_general_dilated(
        x, w[:, None, :], window_strides=(1,),
        padding=[(CONV_LEFT, CONV_W - 1 - CONV_LEFT)],
        dimension_numbers=('NWC', 'WIO', 'NWC'), feature_group_count=C)
    return y + b


def block_diag(x, w, b):
    B, N, _ = x.shape
    xh = x.reshape(B, N, RG_HEADS, RG_BLOCK)
    return jnp.einsum('bnhi,hij->bnhj', xh, w).reshape(B, N, RNN_WIDTH) + b


def rglru_coeffs(x, wa, ba, wx, bx, lam):
    r = jax.nn.sigmoid(block_diag(x, wa, ba)).astype(jnp.float32)
    i = jax.nn.sigmoid(block_diag(x, wx, bx)).astype(jnp.float32)
    log_a = -RG_C * r * jax.nn.softplus(-lam.astype(jnp.float32))
    a = jnp.exp(log_a)
    mult = jnp.sqrt(-jnp.expm1(2.0 * log_a))
    return a, mult * (i * x.astype(jnp.float32))


def _combine(e1, e2):
    a1, b1 = e1
    a2, b2 = e2
    return a1 * a2, a2 * b1 + b2


def linear_scan(a, b, h0):
    b = b.at[:, 0].add(a[:, 0] * h0)
    _, h = lax.associative_scan(_combine, (a, b), axis=1)
    return h


def rglru_bidir(xc, wa, ba, wx, bx, lam, h0_f, h0_b):
    a_f, b_f = rglru_coeffs(xc, wa[0], ba[0], wx[0], bx[0], lam[0])
    h_f = linear_scan(a_f, b_f, h0_f)
    a_b, b_b = rglru_coeffs(xc, wa[1], ba[1], wx[1], bx[1], lam[1])
    h_b = jnp.flip(linear_scan(jnp.flip(a_b, 1), jnp.flip(b_b, 1), h0_b), 1)
    return h_f, h_b


def odd_mixer(hx, hc, w_in, w_out, cw, cb, wa, ba, wx, bx, lam, need_ctx):
    B = hx.shape[0]
    gx, xx = jnp.split(hx @ w_in, 2, axis=-1)
    xc = hc @ w_in[:, RNN_WIDTH:]
    zero = jnp.zeros((B, RNN_WIDTH), jnp.float32)
    hf_c, hb_c = rglru_bidir(centred_dwconv(xc, cw, cb), wa, ba, wx, bx, lam, zero, zero)
    hf_x, hb_x = rglru_bidir(centred_dwconv(xx, cw, cb), wa, ba, wx, bx, lam,
                             hf_c[:, -1], hb_c[:, 0])
    yx = ((hf_x + hb_x).astype(hx.dtype) * jax.nn.gelu(gx)) @ w_out
    if not need_ctx:
        return yx, None
    gc = hc @ w_in[:, :RNN_WIDTH]
    yc = ((hf_c + hb_c).astype(hc.dtype) * jax.nn.gelu(gc)) @ w_out
    return yx, yc


def setup_inputs(seed: int = 0) -> dict:
    key = jax.random.key(seed)
    ks = jax.random.split(key, 32)
    f32 = jnp.float32
    n = lambda k, s, sc: jax.random.normal(k, s, f32) * sc
    a_init = jax.random.uniform(ks[25], (N_ODD, 2, RNN_WIDTH), f32, 0.9, 0.999)
    return {
        "x": n(ks[0], (BATCH, SEQ, D_MODEL), 1.0),
        "c": n(ks[1], (BATCH, D_MODEL), 1.0),
        "ctx": n(ks[2], (BATCH, CTX_LEN, D_MODEL), 1.0),
        "c_ctx": n(ks[3], (D_MODEL,), 1.0),
        "ada_w": n(ks[4], (DEPTH, D_MODEL, N_MOD * D_MODEL), 0.5 * D_MODEL ** -0.5),
        "ada_b": n(ks[5], (DEPTH, N_MOD * D_MODEL), 0.02),
        "norm_g": 1.0 + n(ks[6], (DEPTH, 3, D_MODEL), 0.02),
        "ffn_w_gate": n(ks[7], (DEPTH, 2, D_MODEL, D_FF), D_MODEL ** -0.5),
        "ffn_w_up": n(ks[8], (DEPTH, 2, D_MODEL, D_FF), D_MODEL ** -0.5),
        "ffn_w_down": n(ks[9], (DEPTH, 2, D_FF, D_MODEL), D_FF ** -0.5),
        "ev_w_in": n(ks[10], (N_EVEN, D_MODEL, EVEN_IN), D_MODEL ** -0.5),
        "ev_w_out": n(ks[11], (N_EVEN, EVEN_MIX, D_MODEL), EVEN_MIX ** -0.5),
        "gm_norm_g": 1.0 + n(ks[12], (N_EVEN, GM_WIDTH), 0.02),
        "gm_ws": n(ks[13], (N_EVEN, GM_GROUPS, GM_CHUNK, GM_CHUNK), GM_CHUNK ** -0.5),
        "gm_bs": 1.0 + n(ks[14], (N_EVEN, GM_GROUPS, GM_CHUNK), 0.02),
        "attn_sink": n(ks[15], (N_EVEN, N_Q_HEADS), 1.0),
        "od_w_in": n(ks[16], (N_ODD, D_MODEL, ODD_IN), D_MODEL ** -0.5),
        "od_w_out": n(ks[17], (N_ODD, RNN_WIDTH, D_MODEL), RNN_WIDTH ** -0.5),
        "conv_w": n(ks[18], (N_ODD, CONV_W, RNN_WIDTH), CONV_W ** -0.5),
        "conv_b": n(ks[19], (N_ODD, RNN_WIDTH), 0.02),
        "rg_wa": n(ks[20], (N_ODD, 2, RG_HEADS, RG_BLOCK, RG_BLOCK), RG_BLOCK ** -0.5),
        "rg_ba": n(ks[21], (N_ODD, 2, RNN_WIDTH), 0.02),
        "rg_wx": n(ks[22], (N_ODD, 2, RG_HEADS, RG_BLOCK, RG_BLOCK), RG_BLOCK ** -0.5),
        "rg_bx": n(ks[23], (N_ODD, 2, RNN_WIDTH), 0.02),
        "rg_lambda": jnp.log(a_init) - jnp.log1p(-a_init),
        "final_norm_g": 1.0 + n(ks[24], (D_MODEL,), 0.02),
    }


def reference(x, c, ctx, c_ctx, ada_w, ada_b, norm_g, ffn_w_gate, ffn_w_up, ffn_w_down,
              ev_w_in, ev_w_out, gm_norm_g, gm_ws, gm_bs, attn_sink,
              od_w_in, od_w_out, conv_w, conv_b, rg_wa, rg_ba, rg_wx, rg_bx, rg_lambda,
              final_norm_g):
    S = x.shape[1]
    rope = rope_tables(S)
    for l in range(DEPTH):
        last = l == DEPTH - 1
        mx = [t[:, None, :] for t in jnp.split(jax.nn.silu(c) @ ada_w[l] + ada_b[l], N_MOD, axis=-1)]
        mc = jnp.split(jax.nn.silu(c_ctx) @ ada_w[l] + ada_b[l], N_MOD, axis=-1)
        x = ffn_half_step(x, norm_g[l, 0], mx[0], mx[1], mx[2],
                          ffn_w_gate[l, 0], ffn_w_up[l, 0], ffn_w_down[l, 0])
        ctx = ffn_half_step(ctx, norm_g[l, 0], mc[0], mc[1], mc[2],
                            ffn_w_gate[l, 0], ffn_w_up[l, 0], ffn_w_down[l, 0])
        hx = modulate(rmsnorm(x, norm_g[l, 1]), mx[3], mx[4])
        hc = modulate(rmsnorm(ctx, norm_g[l, 1]), mc[3], mc[4])
        if l % 2 == 0:
            e = l // 2
            yx, yc = even_mixer(hx, hc, rope, ev_w_in[e], ev_w_out[e], gm_norm_g[e],
                                gm_ws[e], gm_bs[e], attn_sink[e], not last)
        else:
            o = l // 2
            yx, yc = odd_mixer(hx, hc, od_w_in[o], od_w_out[o], conv_w[o], conv_b[o],
                               rg_wa[o], rg_ba[o], rg_wx[o], rg_bx[o], rg_lambda[o], not last)
        x = x + mx[5] * yx
        x = ffn_half_step(x, norm_g[l, 2], mx[6], mx[7], mx[8],
                          ffn_w_gate[l, 1], ffn_w_up[l, 1], ffn_w_down[l, 1])
        if not last:
            ctx = ctx + mc[5] * yc
            ctx = ffn_half_step(ctx, norm_g[l, 2], mc[6], mc[7], mc[8],
                                ffn_w_gate[l, 1], ffn_w_up[l, 1], ffn_w_down[l, 1])
    return rmsnorm(x, final_norm_g)
```

```cpp
#include <hip/hip_runtime.h>
#include <hip/hip_cooperative_groups.h>
#include <cstdio>
namespace cg = cooperative_groups;

#define LAS __attribute__((address_space(3)))
typedef unsigned short bf16_t;
typedef short bf16x8 __attribute__((ext_vector_type(8)));
typedef short bf16x4 __attribute__((ext_vector_type(4)));
typedef float f32x4 __attribute__((ext_vector_type(4)));
typedef unsigned u32x2 __attribute__((ext_vector_type(2)));
typedef unsigned u32x4 __attribute__((ext_vector_type(4)));

constexpr int D = 1024, FF = 2816, SEQ = 16384, MX = 32768, MC = 512, MR = MX + MC, CTXL = 256;
constexpr int NMOD = 9216;
constexpr int EVIN_N = 1792;
constexpr int LDS_BYTES = 131072;
constexpr int NCH = 520;

constexpr size_t SZ_W1 = (size_t)2 * FF * D * 2;
constexpr size_t SZ_W2 = (size_t)D * FF * 2;
constexpr size_t OFF_W1 = 0;
constexpr size_t OFF_W2 = OFF_W1 + 4 * SZ_W1;
constexpr size_t OFF_EVIN = OFF_W2 + 4 * SZ_W2;
constexpr size_t OFF_EVOUT = OFF_EVIN + (size_t)EVIN_N * D * 2;
constexpr size_t OFF_ODIN = OFF_EVOUT + (size_t)D * D * 2;
constexpr size_t OFF_ODOUT = OFF_ODIN + (size_t)2048 * D * 2;
constexpr size_t OFF_RGW = OFF_ODOUT + (size_t)D * D * 2;
constexpr size_t OFF_GMWS = OFF_RGW + (size_t)4096 * 256 * 2;
constexpr size_t OFF_MOD = OFF_GMWS + (size_t)4 * 128 * 128 * 2;
constexpr size_t OFF_ROPE = OFF_MOD + (size_t)2 * 3 * NMOD * 4;
constexpr size_t OFF_SP = OFF_ROPE + (size_t)256 * 16 * 2 * 4;
constexpr size_t OFF_CTXR = OFF_SP + (size_t)2 * 1024 * 4;
constexpr size_t OFF_PE = OFF_CTXR + (size_t)MC * D * 4;
constexpr size_t SZ_CARRY = (size_t)2 * 2 * NCH * 1024 * 4;
constexpr size_t OFF_HIN = OFF_PE + 2 * SZ_CARRY;
constexpr size_t OFF_H = OFF_HIN + SZ_CARRY;
constexpr size_t SZ_ROWS = (size_t)MR * D * 2;
constexpr size_t OFF_BIG = OFF_H + SZ_ROWS;
constexpr size_t SZ_ACT = (size_t)MR * FF * 2;
constexpr size_t OFF_EXTRA = OFF_BIG + SZ_ACT;
constexpr size_t OFF_UZ = OFF_BIG;
constexpr size_t OFF_Q = OFF_UZ + SZ_ROWS;
constexpr size_t OFF_K = OFF_Q + SZ_ROWS / 2;
constexpr size_t OFF_V = OFF_K + SZ_ROWS / 8;
constexpr size_t OFF_MIXE = OFF_EXTRA;
constexpr size_t OFF_G = OFF_BIG;
constexpr size_t OFF_XX = OFF_G + SZ_ROWS;
constexpr size_t OFF_XC = OFF_H;
constexpr size_t OFF_LAB = OFF_XX;
constexpr size_t OFF_MIXO = OFF_H;
constexpr size_t WS_NEED = OFF_LAB + 4 * SZ_ROWS;
static_assert(OFF_MIXE + SZ_ROWS <= WS_NEED, "ws");
static_assert(WS_NEED <= (size_t)536870912, "workspace budget");

struct Params { const float* in[26]; float* out; unsigned char* ws; };
typedef const Params __attribute__((address_space(4))) * PK;
__device__ __forceinline__ PK get_pk() { PK pk = (PK)__builtin_amdgcn_kernarg_segment_ptr(); asm volatile("" : "+s"(pk)); return pk; }
__device__ __forceinline__ int launder_i(int v) { asm volatile("" : "+s"(v)); return v; }
__device__ __forceinline__ int launder_v(int v) { asm volatile("" : "+v"(v)); return v; }
#define TID_X tid_l
enum { I_X = 0, I_C, I_CTX, I_CCTX, I_ADAW, I_ADAB, I_NORMG, I_WG, I_WU, I_WD, I_EVIN, I_EVOUT, I_GMG, I_GMWS, I_GMBS, I_SINK,
       I_ODIN, I_ODOUT, I_CONVW, I_CONVB, I_RGWA, I_RGBA, I_RGWX, I_RGBX, I_LAM, I_FNG };

__device__ __forceinline__ unsigned cvt_pk_bf16(float lo, float hi) { unsigned r; asm volatile("v_cvt_pk_bf16_f32 %0, %1, %2" : "=v"(r) : "v"(lo), "v"(hi)); return r; }
__device__ __forceinline__ bf16_t f2bf(float f) { return (bf16_t)(cvt_pk_bf16(f, 0.f) & 0xffffu); }
__device__ __forceinline__ float bf2f(bf16_t b) { return __uint_as_float(((unsigned)b) << 16); }
__device__ __forceinline__ float bflo(unsigned w) { return __uint_as_float(w << 16); }
__device__ __forceinline__ float bfhi(unsigned w) { return __uint_as_float(w & 0xffff0000u); }
__device__ __forceinline__ u32x2 pack4(f32x4 v) { u32x2 r; r.x = cvt_pk_bf16(v[0], v[1]); r.y = cvt_pk_bf16(v[2], v[3]); return r; }
__device__ __forceinline__ f32x4 unpack4(u32x2 w) { f32x4 r; r[0] = bflo(w.x); r[1] = bfhi(w.x); r[2] = bflo(w.y); r[3] = bfhi(w.y); return r; }
__device__ __forceinline__ float fast_sigmoid(float x) { return __fdividef(1.0f, 1.0f + __expf(-x)); }
__device__ __forceinline__ float gelu_tanh(float x) { const float t = 1.5957691216f * (x + 0.044715f * x * x * x); return x * fast_sigmoid(t); }
__device__ __forceinline__ float wave_sum(float v) {
#pragma unroll
  for (int o = 32; o >= 1; o >>= 1) v += __shfl_xor(v, o);
  return v;
}

namespace pg8 {
constexpr int BM = 256, BK = 64, HALF = 128, HTB = HALF * BK * 2, NXCD = 8, WGM = 8;
__device__ __forceinline__ int lds_byte(int r, int c) { const int st = (r >> 4) * 2 + (c >> 5), rr = r & 15, cc = c & 31, ob = rr * 64 + cc * 2; return st * 1024 + (ob ^ (((ob >> 9) & 1) << 5)); }
__device__ __forceinline__ void stage_rc(int b, int& R, int& C) { const int st = b / 1024, sb = b % 1024, swz = sb ^ (((sb >> 9) & 1) << 5); R = (st >> 1) * 16 + swz / 64; C = (st & 1) * 32 + (swz % 64) / 2; }
struct Unit { int pm, pn; };
struct Gemm { const bf16_t* A; const bf16_t* Bt; int M, N, K, lda; int bd; };
struct StaticOrder {
  int nM, nN, nwg, G, c;
  __device__ void init(int M, int N, int G_, int c_) { nM = M / BM; nN = N / BM; nwg = nM * nN; G = G_; c = c_; }
  __device__ bool next(int i, Unit& u) const {
    const long L = (long)i * G + c; if (L >= nwg) return false;
    int wgid = (int)L; { const int q = nwg / NXCD, r = nwg % NXCD, xcd = wgid % NXCD, off = wgid / NXCD; wgid = (xcd < r ? xcd * (q + 1) : r * (q + 1) + (xcd - r) * q) + off; }
    const int nig = WGM * nN, gid = wgid / nig, fm = gid * WGM, gsz = (nM - fm) < WGM ? (nM - fm) : WGM;
    u.pm = fm + ((wgid % nig) % gsz); u.pn = (wgid % nig) / gsz; return true;
  }
};

template <class Epi>
__device__ __forceinline__ void gemm_phase(LAS unsigned char* lds, const Gemm g, const StaticOrder& S, const Epi& E) { const int tid_l = launder_v((int)threadIdx.x);
  const int tid = tid_l, wid = __builtin_amdgcn_readfirstlane(tid >> 6), lane = tid & 63, wr = wid >> 2, wc = wid & 3, fr = lane & 15, fq = lane >> 4;
  const int K = g.K, nt = K / BK;
  unsigned voffA[2], voffB[2];
#pragma unroll
  for (int i = 0; i < 2; ++i) { int R, C; stage_rc(tid * 16 + i * 8192, R, C); voffA[i] = (unsigned)(R * g.lda + C) * 2u; voffB[i] = (unsigned)(R * K + C) * 2u; }
  const size_t kstep = (size_t)(BK * 2);
  const size_t hstepA = (size_t)HALF * g.lda * 2, hstepB = (size_t)HALF * K * 2;
  const size_t tstepA = 2 * hstepA, tstepB = 2 * hstepB;
  const unsigned ldsw = (unsigned)wid * 1024u;
  const int aoff = lds_byte(wr * 64 + fr, fq * 8), boff = lds_byte(wc * 32 + fr, fq * 8);
#define PG8_SA(b, h) (((b) * 2 + (h)) * HTB)
#define PG8_SB(b, h) ((4 + (b) * 2 + (h)) * HTB)
#define PG8_STAGE(bufoff, gbase, voff) do { _Pragma("unroll") for (int _i = 0; _i < 2; ++_i) \
        __builtin_amdgcn_global_load_lds((const unsigned*)((const char*)(gbase) + (voff)[_i]), (LAS unsigned*)(lds + (bufoff) + ldsw + _i * 8192), 16, 0, 0); } while (0)
#define PG8_LDA(dst, b, h) do { _Pragma("unroll") for (int m = 0; m < 4; ++m) _Pragma("unroll") for (int k = 0; k < 2; ++k) dst[m][k] = *(const LAS bf16x8*)(lds + PG8_SA(b, h) + aoff + m * 2048 + k * 1024); } while (0)
#define PG8_LDB(dst, b, h) do { _Pragma("unroll") for (int n = 0; n < 2; ++n) _Pragma("unroll") for (int k = 0; k < 2; ++k) dst[n][k] = *(const LAS bf16x8*)(lds + PG8_SB(b, h) + boff + n * 2048 + k * 1024); } while (0)
#define PG8_MMA(ai, bj, At, Bt) do { __builtin_amdgcn_s_setprio(1); _Pragma("unroll") for (int m = 0; m < 4; ++m) _Pragma("unroll") for (int n = 0; n < 2; ++n) _Pragma("unroll") for (int k = 0; k < 2; ++k) \
        acc[ai][bj][m][n] = __builtin_amdgcn_mfma_f32_16x16x32_bf16(Bt[n][k], At[m][k], acc[ai][bj][m][n], 0, 0, 0); __builtin_amdgcn_s_setprio(0); } while (0)
#define PG8_WAIT_V(n) asm volatile("s_waitcnt vmcnt(" #n ")" ::: "memory")
#define PG8_WAIT_L(n) asm volatile("s_waitcnt lgkmcnt(" #n ")" ::: "memory")
#define PG8_BAR __builtin_amdgcn_s_barrier()
#define PG8_SCHED __builtin_amdgcn_sched_barrier(0)
#define PG8_ABASE(u) ((const char*)g.A + (size_t)(u).pm * tstepA + (g.bd ? (size_t)((((u).pn >> 1) & 3) * 512) : (size_t)0))
  Unit cur, nxt; int ui = 0;
  if (!S.next(0, cur)) return;
  f32x4 acc[2][2][4][2];
#pragma unroll
  for (int a = 0; a < 2; ++a)
#pragma unroll
    for (int b = 0; b < 2; ++b)
#pragma unroll
      for (int m = 0; m < 4; ++m)
#pragma unroll
        for (int n = 0; n < 2; ++n) acc[a][b][m][n] = (f32x4){0.f, 0.f, 0.f, 0.f};
  bf16x8 At[4][2], B0[2][2], B1[2][2];
  const char* cA = PG8_ABASE(cur); const char* cB = (const char*)g.Bt + (size_t)cur.pn * tstepB;
  PG8_STAGE(PG8_SB(0, 0), cB, voffB); PG8_STAGE(PG8_SA(0, 0), cA, voffA); PG8_STAGE(PG8_SB(0, 1), cB + hstepB, voffB); PG8_STAGE(PG8_SA(0, 1), cA + hstepA, voffA);
  if (wr == 1) PG8_BAR;
  PG8_WAIT_V(4); PG8_BAR;
  PG8_STAGE(PG8_SB(1, 0), cB + kstep, voffB); PG8_STAGE(PG8_SA(1, 0), cA + kstep, voffA); PG8_STAGE(PG8_SB(1, 1), cB + hstepB + kstep, voffB);
  PG8_WAIT_V(6); PG8_BAR;
  for (;;) {
    const bool has_next = S.next(ui + 1, nxt);
    const char* nA = has_next ? PG8_ABASE(nxt) : cA; const char* nB = has_next ? (const char*)g.Bt + (size_t)nxt.pn * tstepB : cB;
#pragma unroll 1
    for (int t = 0; t < nt; t += 2) {
      const bool last = (t == nt - 2);
      const char* a1 = cA + (size_t)(t + 1) * kstep;
      const char* a2 = last ? nA : cA + (size_t)(t + 2) * kstep; const char* b2 = last ? nB : cB + (size_t)(t + 2) * kstep;
      const char* a3 = a2 + kstep; const char* b3 = b2 + kstep;
      PG8_LDB(B0, 0, 0); PG8_SCHED; PG8_LDA(At, 0, 0); PG8_STAGE(PG8_SA(1, 1), a1 + hstepA, voffA);
      PG8_WAIT_L(8); PG8_BAR; PG8_WAIT_L(0); PG8_MMA(0, 0, At, B0); PG8_BAR; PG8_SCHED;
      PG8_LDB(B1, 0, 1); PG8_STAGE(PG8_SB(0, 0), b2, voffB);
      PG8_BAR; PG8_WAIT_L(0); PG8_MMA(0, 1, At, B1); PG8_BAR;
      PG8_LDA(At, 0, 1); PG8_STAGE(PG8_SA(0, 0), a2, voffA);
      PG8_BAR; PG8_WAIT_L(0); PG8_MMA(1, 0, At, B0); PG8_BAR; PG8_SCHED;
      PG8_STAGE(PG8_SB(0, 1), b2 + hstepB, voffB);
      PG8_WAIT_V(6); PG8_BAR; PG8_MMA(1, 1, At, B1); PG8_BAR;
      PG8_LDB(B0, 1, 0); PG8_SCHED; PG8_LDA(At, 1, 0); PG8_STAGE(PG8_SA(0, 1), a2 + hstepA, voffA);
      PG8_WAIT_L(8); PG8_BAR; PG8_WAIT_L(0); PG8_MMA(0, 0, At, B0); PG8_BAR; PG8_SCHED;
      PG8_LDB(B1, 1, 1); PG8_STAGE(PG8_SB(1, 0), b3, voffB);
      PG8_BAR; PG8_WAIT_L(0); PG8_MMA(0, 1, At, B1); PG8_BAR;
      PG8_LDA(At, 1, 1); PG8_STAGE(PG8_SA(1, 0), a3, voffA);
      PG8_BAR; PG8_WAIT_L(0); PG8_MMA(1, 0, At, B0); PG8_BAR; PG8_SCHED;
      PG8_STAGE(PG8_SB(1, 1), b3 + hstepB, voffB);
      PG8_WAIT_V(6); PG8_BAR; PG8_MMA(1, 1, At, B1); PG8_BAR;
    }
    E(acc, cur, wr, wc, fr, fq);
    if (!has_next) break;
#pragma unroll
    for (int a = 0; a < 2; ++a)
#pragma unroll
      for (int b = 0; b < 2; ++b)
#pragma unroll
        for (int m = 0; m < 4; ++m)
#pragma unroll
          for (int n = 0; n < 2; ++n) acc[a][b][m][n] = (f32x4){0.f, 0.f, 0.f, 0.f};
    cur = nxt; cA = nA; cB = nB; ++ui;
  }
  PG8_WAIT_V(0);
  if (wr == 0) PG8_BAR;
  PG8_BAR;
#undef PG8_SA
#undef PG8_SB
#undef PG8_STAGE
#undef PG8_LDA
#undef PG8_LDB
#undef PG8_MMA
#undef PG8_WAIT_V
#undef PG8_WAIT_L
#undef PG8_BAR
#undef PG8_SCHED
#undef PG8_ABASE
}
}
using pg8::Unit;
typedef f32x4 AccT[2][2][4][2];

struct EpiSwiglu {
  bf16_t* act;
  __device__ __forceinline__ void operator()(const AccT& acc, const Unit& u, int wr, int wc, int fr, int fq) const {
    const int row0 = u.pm * 256 + wr * 64 + fr, col0 = u.pn * 128 + wc * 32 + 4 * fq;
#pragma unroll
    for (int ai = 0; ai < 2; ++ai)
#pragma unroll
      for (int m = 0; m < 4; ++m) {
        bf16_t* rowp = act + (size_t)(row0 + ai * 128 + m * 16) * FF + col0;
#pragma unroll
        for (int n = 0; n < 2; ++n) {
          const f32x4 gg = acc[ai][0][m][n], uu = acc[ai][1][m][n]; f32x4 v;
#pragma unroll
          for (int j = 0; j < 4; ++j) v[j] = gg[j] * fast_sigmoid(gg[j]) * uu[j];
          *(u32x2*)(rowp + n * 16) = pack4(v);
        }
      }
  }
};
struct EpiResid {
  const float* src_lat; const float* src_ctx; float* dst_lat; float* dst_ctx; const float* gate; float scale;
  __device__ __forceinline__ void operator()(const AccT& acc, const Unit& u, int wr, int wc, int fr, int fq) const {
    const int row0 = u.pm * 256 + wr * 64 + fr, col0 = u.pn * 256 + wc * 32 + 4 * fq;
    const int mi = u.pm < 64 ? 0 : (u.pm < 128 ? 1 : 2);
    const float* gp = gate + (size_t)mi * NMOD + col0;
    f32x4 gv[2][2];
#pragma unroll
    for (int bj = 0; bj < 2; ++bj)
#pragma unroll
      for (int n = 0; n < 2; ++n) gv[bj][n] = *(const f32x4*)(gp + bj * 128 + n * 16) * scale;
#pragma unroll
    for (int ai = 0; ai < 2; ++ai)
#pragma unroll
      for (int m = 0; m < 4; ++m) {
        const int r = row0 + ai * 128 + m * 16;
        const float* s = (r < MX ? src_lat + (size_t)r * D : src_ctx + (size_t)(r - MX) * D) + col0;
        float* d = (r < MX ? dst_lat + (size_t)r * D : dst_ctx + (size_t)(r - MX) * D) + col0;
#pragma unroll
        for (int bj = 0; bj < 2; ++bj)
#pragma unroll
          for (int n = 0; n < 2; ++n) { const f32x4 xv = *(const f32x4*)(s + bj * 128 + n * 16); *(f32x4*)(d + bj * 128 + n * 16) = xv + gv[bj][n] * acc[ai][bj][m][n]; }
      }
  }
};
struct EpiEvenIn {
  bf16_t* UZ; bf16_t* Q; bf16_t* Kb; bf16_t* Vb; const float* ropeC; const float* ropeS;
  __device__ __forceinline__ void operator()(const AccT& acc, const Unit& u, int wr, int wc, int fr, int fq) const {
    const int row0 = u.pm * 256 + wr * 64 + fr;
    if (u.pn < 4) {
      const int col0 = u.pn * 256 + wc * 32 + 4 * fq;
#pragma unroll
      for (int ai = 0; ai < 2; ++ai)
#pragma unroll
        for (int m = 0; m < 4; ++m) {
          bf16_t* rowp = UZ + (size_t)(row0 + ai * 128 + m * 16) * D + col0;
#pragma unroll
          for (int bj = 0; bj < 2; ++bj)
#pragma unroll
            for (int n = 0; n < 2; ++n) { f32x4 v;
#pragma unroll
              for (int j = 0; j < 4; ++j) v[j] = gelu_tanh(acc[ai][bj][m][n][j]);
              *(u32x2*)(rowp + bj * 128 + n * 16) = pack4(v); }
        }
    } else {
      const bool rope_on = u.pm < 128;
      const bool by_col = (wc & 1) != 0;
#pragma unroll
      for (int ai = 0; ai < 2; ++ai)
#pragma unroll
        for (int m = 0; m < 4; ++m) {
          const int r = row0 + ai * 128 + m * 16;
          const int pos = r & (SEQ - 1);
          const int pidx = by_col ? (pos & 63) : (pos >> 6);
          f32x4 cs = {1.f, 1.f, 1.f, 1.f}, sn = {0.f, 0.f, 0.f, 0.f};
          if (rope_on) { cs = *(const f32x4*)(ropeC + pidx * 16 + 4 * fq); sn = *(const f32x4*)(ropeS + pidx * 16 + 4 * fq); }
#pragma unroll
          for (int bj = 0; bj < 2; ++bj) {
            const f32x4 x1 = acc[ai][bj][m][0], x2 = acc[ai][bj][m][1];
            if (u.pn < 6) {
              const f32x4 o1 = (x1 * cs - x2 * sn) * 0.125f, o2 = (x1 * sn + x2 * cs) * 0.125f;
              bf16_t* qp = Q + (size_t)r * 512 + (u.pn - 4) * 256 + bj * 128 + wc * 32 + 4 * fq;
              *(u32x2*)(qp) = pack4(o1); *(u32x2*)(qp + 16) = pack4(o2);
            } else if (bj == 0) {
              const f32x4 o1 = x1 * cs - x2 * sn, o2 = x1 * sn + x2 * cs;
              bf16_t* kp = Kb + (size_t)r * 128 + wc * 32 + 4 * fq;
              *(u32x2*)(kp) = pack4(o1); *(u32x2*)(kp + 16) = pack4(o2);
            } else {
              bf16_t* vp = Vb + (size_t)r * 128 + wc * 32 + 4 * fq;
              *(u32x2*)(vp) = pack4(x1); *(u32x2*)(vp + 16) = pack4(x2);
            }
          }
        }
    }
  }
};
struct EpiOddIn {
  bf16_t* G; bf16_t* XX;
  __device__ __forceinline__ void operator()(const AccT& acc, const Unit& u, int wr, int wc, int fr, int fq) const {
    const int row0 = u.pm * 256 + wr * 64 + fr;
    const bool isg = u.pn < 4;
    bf16_t* base = isg ? G : XX;
    const int col0 = (u.pn & 3) * 256 + wc * 32 + 4 * fq;
#pragma unroll
    for (int ai = 0; ai < 2; ++ai)
#pragma unroll
      for (int m = 0; m < 4; ++m) {
        bf16_t* rowp = base + (size_t)(row0 + ai * 128 + m * 16) * D + col0;
#pragma unroll
        for (int bj = 0; bj < 2; ++bj)
#pragma unroll
          for (int n = 0; n < 2; ++n) { f32x4 v = acc[ai][bj][m][n];
            if (isg) {
#pragma unroll
              for (int j = 0; j < 4; ++j) v[j] = gelu_tanh(v[j]); }
            *(u32x2*)(rowp + bj * 128 + n * 16) = pack4(v); }
      }
  }
};
struct EpiRG {
  const bf16_t* XC; bf16_t* LAB; const float* ba; const float* bx; const float* sp;
  __device__ __forceinline__ void operator()(const AccT& acc, const Unit& u, int wr, int wc, int fr, int fq) const {
    const int row0 = u.pm * 256 + wr * 64 + fr;
    const int d = u.pn >> 3, h = (u.pn >> 1) & 3, cb = u.pn & 1;
    const int ch0 = h * 256 + cb * 128 + wc * 32 + 4 * fq;
    bf16_t* LA = LAB + (size_t)(2 * d) * MR * D; bf16_t* BB = LA + (size_t)MR * D;
#pragma unroll
    for (int n = 0; n < 2; ++n) {
      const f32x4 bav = *(const f32x4*)(ba + d * 1024 + ch0 + n * 16), bxv = *(const f32x4*)(bx + d * 1024 + ch0 + n * 16), spv = *(const f32x4*)(sp + d * 1024 + ch0 + n * 16);
#pragma unroll
      for (int ai = 0; ai < 2; ++ai)
#pragma unroll
        for (int m = 0; m < 4; ++m) {
          const size_t ro = (size_t)(row0 + ai * 128 + m * 16) * D + ch0 + n * 16;
          const f32x4 xv = unpack4(*(const u32x2*)(XC + ro));
          f32x4 la, bb;
#pragma unroll
          for (int j = 0; j < 4; ++j) {
            const float rr = fast_sigmoid(acc[ai][0][m][n][j] + bav[j]), ii = fast_sigmoid(acc[ai][1][m][n][j] + bxv[j]);
            const float l = rr * spv[j];
            la[j] = l; bb[j] = __fsqrt_rn(fmaxf(1.0f - __expf(2.0f * l), 0.f)) * ii * xv[j];
          }
          *(u32x2*)(LA + ro) = pack4(la); *(u32x2*)(BB + ro) = pack4(bb);
          __builtin_amdgcn_sched_barrier(0);
        }
    }
  }
};

__device__ __forceinline__ void cvt_tile(const float* src, int ld, bf16_t* dst, int ldd, LAS float* tile) { const int tid_l = launder_v((int)threadIdx.x);
  const int t = tid_l, a = t >> 6, b = t & 63;
#pragma unroll
  for (int i = 0; i < 8; ++i) tile[(i * 8 + a) * 65 + b] = src[(size_t)(i * 8 + a) * ld + b];
  __syncthreads();
#pragma unroll
  for (int i = 0; i < 8; ++i) dst[(size_t)(i * 8 + a) * ldd + b] = f2bf(tile[b * 65 + i * 8 + a]);
  __syncthreads();
}
__device__ __forceinline__ void sincos_taylor(double r, double& s, double& c) {
  const double r2 = r * r; double ts = r, tc = 1.0; s = r; c = 1.0;
  for (int i = 1; i <= 15; ++i) { tc = -tc * r2 / (double)((2 * i - 1) * (2 * i)); ts = -ts * r2 / (double)((2 * i) * (2 * i + 1)); c += tc; s += ts; }
}
__device__ __forceinline__ void prologue(PK pk, LAS unsigned char* lds, const int bid, const int nb) { const int tid_l = launder_v((int)threadIdx.x);
  unsigned char* ws = pk->ws;
  const int tid = tid_l;
  LAS float* tile = (LAS float*)lds;
  LAS float* sc = (LAS float*)(lds + 16640);
  LAS float* red = (LAS float*)(lds + 16640 + 12288);
  for (int i = tid; i < 3072; i += 512) { const int v = i >> 10, k = i & 1023; const float x = v < 2 ? pk->in[I_C][v * 1024 + k] : pk->in[I_CCTX][k]; sc[i] = x * fast_sigmoid(x); }
  __syncthreads();
  float* mod = (float*)(ws + OFF_MOD);
  for (int it = bid; it < 288; it += nb) {
    const int l = it / 144, cb = it % 144, kg = tid >> 6, j = tid & 63;
    const float* w = pk->in[I_ADAW] + (size_t)l * D * NMOD + (size_t)(kg * 128) * NMOD + cb * 64 + j;
    float a0 = 0.f, a1 = 0.f, a2 = 0.f;
    for (int k = 0; k < 128; ++k) { const float wv = w[(size_t)k * NMOD]; a0 += sc[kg * 128 + k] * wv; a1 += sc[1024 + kg * 128 + k] * wv; a2 += sc[2048 + kg * 128 + k] * wv; }
    red[(kg * 3 + 0) * 64 + j] = a0; red[(kg * 3 + 1) * 64 + j] = a1; red[(kg * 3 + 2) * 64 + j] = a2;
    __syncthreads();
    if (tid < 192) { const int v = tid >> 6, jj = tid & 63; float s = pk->in[I_ADAB][l * NMOD + cb * 64 + jj];
      for (int q = 0; q < 8; ++q) s += red[(q * 3 + v) * 64 + jj];
      mod[((size_t)l * 3 + v) * NMOD + cb * 64 + jj] = s; }
    __syncthreads();
  }
  { float* rc = (float*)(ws + OFF_ROPE); float* rs = rc + 4096;
    for (int i = bid * 512 + tid; i < 4096; i += nb * 512) { const int pp = i >> 4, f = i & 15;
      const float inv = powf(10000.0f, -(float)f / 16.0f); const float ang = (float)pp * inv;
      const double ad = (double)ang; const double kq = rint(ad * 0.15915494309189535); const double r = ad - kq * 6.283185307179586477;
      double s, c; sincos_taylor(r, s, c); rc[i] = (float)c; rs[i] = (float)s; } }
  { float* sp = (float*)(ws + OFF_SP); for (int i = bid * 512 + tid; i < 2048; i += nb * 512) sp[i] = -8.0f * log1pf(expf(-pk->in[I_LAM][i])); }
  { bf16_t* o = (bf16_t*)(ws + OFF_GMWS); for (int i = bid * 512 + tid; i < 65536; i += nb * 512) o[i] = f2bf(pk->in[I_GMWS][i]); }
  for (int ti = bid; ti < 10176; ti += nb) {
    int r = ti;
    if (r < 5632) { const int j = r / 1408, rem = r % 1408, nbk = rem >> 4, kb = rem & 15, pn = nbk >> 2, sub = nbk & 3;
      const float* src = (sub < 2 ? pk->in[I_WG] : pk->in[I_WU]) + (size_t)j * D * FF + (size_t)(kb * 64) * FF + pn * 128 + (sub & 1) * 64;
      cvt_tile(src, FF, (bf16_t*)(ws + OFF_W1 + j * SZ_W1) + (size_t)(nbk * 64) * D + kb * 64, D, tile); continue; }
    r -= 5632;
    if (r < 2816) { const int j = r / 704, rem = r % 704, nbk = rem / 44, kb = rem % 44;
      const float* src = pk->in[I_WD] + (size_t)j * FF * D + (size_t)(kb * 64) * D + nbk * 64;
      cvt_tile(src, D, (bf16_t*)(ws + OFF_W2 + j * SZ_W2) + (size_t)(nbk * 64) * FF + kb * 64, FF, tile); continue; }
    r -= 2816;
    if (r < 448) { const int nbk = r >> 4, kb = r & 15;
      cvt_tile(pk->in[I_EVIN] + (size_t)(kb * 64) * EVIN_N + nbk * 64, EVIN_N, (bf16_t*)(ws + OFF_EVIN) + (size_t)(nbk * 64) * D + kb * 64, D, tile); continue; }
    r -= 448;
    if (r < 256) { const int nbk = r >> 4, kb = r & 15;
      cvt_tile(pk->in[I_EVOUT] + (size_t)(kb * 64) * D + nbk * 64, D, (bf16_t*)(ws + OFF_EVOUT) + (size_t)(nbk * 64) * D + kb * 64, D, tile); continue; }
    r -= 256;
    if (r < 512) { const int nbk = r >> 4, kb = r & 15;
      cvt_tile(pk->in[I_ODIN] + (size_t)(kb * 64) * 2048 + nbk * 64, 2048, (bf16_t*)(ws + OFF_ODIN) + (size_t)(nbk * 64) * D + kb * 64, D, tile); continue; }
    r -= 512;
    if (r < 256) { const int nbk = r >> 4, kb = r & 15;
      cvt_tile(pk->in[I_ODOUT] + (size_t)(kb * 64) * D + nbk * 64, D, (bf16_t*)(ws + OFF_ODOUT) + (size_t)(nbk * 64) * D + kb * 64, D, tile); continue; }
    r -= 256;
    { const int nbk = r >> 2, kb = r & 3, t = nbk >> 2, sub = nbk & 3, d = t >> 3, h = (t >> 1) & 3, cb = t & 1;
      const float* src = (sub < 2 ? pk->in[I_RGWA] : pk->in[I_RGWX]) + (size_t)(d * 4 + h) * 65536 + (size_t)(kb * 64) * 256 + cb * 128 + (sub & 1) * 64;
      cvt_tile(src, 256, (bf16_t*)(ws + OFF_RGW) + (size_t)(nbk * 64) * 256 + kb * 64, 256, tile); }
  }
}

__device__ __forceinline__ void phase_norm(const float* src_lat, const float* src_ctx, const float* g, const float* modl, int j3, bf16_t* h, const int bid, const int nb) { const int tid_l = launder_v((int)threadIdx.x);
  const int lane = tid_l & 63, wv = tid_l >> 6;
  f32x4 gv[4];
#pragma unroll
  for (int i = 0; i < 4; ++i) gv[i] = *(const f32x4*)(g + i * 256 + lane * 4);
  for (int r = bid * 8 + wv; r < MR; r += nb * 8) {
    const float* xr = r < MX ? src_lat + (size_t)r * D : src_ctx + (size_t)(r - MX) * D;
    const int mi = r < SEQ ? 0 : (r < MX ? 1 : 2);
    const float* sh = modl + (size_t)mi * NMOD + (3 * j3) * 1024; const float* scl = sh + 1024;
    f32x4 v[4]; float ss = 0.f;
#pragma unroll
    for (int i = 0; i < 4; ++i) { v[i] = *(const f32x4*)(xr + i * 256 + lane * 4); ss += v[i][0] * v[i][0] + v[i][1] * v[i][1] + v[i][2] * v[i][2] + v[i][3] * v[i][3]; }
    ss = wave_sum(ss);
    const float rstd = rsqrtf(ss * (1.0f / 1024.0f) + 1e-6f);
#pragma unroll
    for (int i = 0; i < 4; ++i) {
      const f32x4 s1 = *(const f32x4*)(scl + i * 256 + lane * 4), s0 = *(const f32x4*)(sh + i * 256 + lane * 4);
      f32x4 y = v[i] * rstd * gv[i]; y = y * (s1 + 1.0f) + s0;
      *(u32x2*)(h + (size_t)r * D + i * 256 + lane * 4) = pack4(y);
    }
  }
}
__device__ __forceinline__ void phase_final_norm(float* out, const float* g, const int bid, const int nb) { const int tid_l = launder_v((int)threadIdx.x);
  const int lane = tid_l & 63, wv = tid_l >> 6;
  f32x4 gv[4];
#pragma unroll
  for (int i = 0; i < 4; ++i) gv[i] = *(const f32x4*)(g + i * 256 + lane * 4);
  for (int r = bid * 8 + wv; r < MX; r += nb * 8) {
    float* xr = out + (size_t)r * D;
    f32x4 v[4]; float ss = 0.f;
#pragma unroll
    for (int i = 0; i < 4; ++i) { v[i] = *(const f32x4*)(xr + i * 256 + lane * 4); ss += v[i][0] * v[i][0] + v[i][1] * v[i][1] + v[i][2] * v[i][2] + v[i][3] * v[i][3]; }
    ss = wave_sum(ss);
    const float rstd = rsqrtf(ss * (1.0f / 1024.0f) + 1e-6f);
#pragma unroll
    for (int i = 0; i < 4; ++i) *(f32x4*)(xr + i * 256 + lane * 4) = v[i] * rstd * gv[i];
  }
}

constexpr int VSTR = 648;
__device__ __forceinline__ void attn_unit(PK pk, int u, LAS unsigned char* lds) { const int tid_l = launder_v((int)threadIdx.x);
  const bf16_t* Q = (const bf16_t*)(pk->ws + OFF_Q); const bf16_t* Kb = (const bf16_t*)(pk->ws + OFF_K); const bf16_t* Vb = (const bf16_t*)(pk->ws + OFF_V);
  bf16_t* MIX = (bf16_t*)(pk->ws + OFF_MIXE);
  const int tid = tid_l, wv = tid >> 6, lane = tid & 63, fr = lane & 15, fq = lane >> 4;
  const bool is_ctx = u >= 512;
  int b, qb, kvh;
  if (!is_ctx) { b = u >> 8; qb = (u >> 1) & 127; kvh = u & 1; } else { const int j = u - 512; b = j >> 2; qb = (j >> 1) & 1; kvh = j & 1; }
  const int qrow0 = is_ctx ? MX + b * CTXL + qb * 128 : b * SEQ + qb * 128;
  LAS bf16_t* VT = (LAS bf16_t*)lds;
#pragma unroll 1
  for (int c = 0; c < 5; ++c) {
    const bool active = c >= 3 ? true : (is_ctx ? false : (c == 0 ? qb > 0 : (c == 2 ? qb < 127 : true)));
    if (!active) continue;
    const int base = c >= 3 ? MX + b * CTXL + (c - 3) * 128 : qrow0 + (c - 1) * 128;
#pragma unroll
    for (int i = 0; i < 2; ++i) {
      const int idx = tid + i * 512, key = idx >> 3, oc = idx & 7;
      const bf16x8 v = *(const bf16x8*)(Vb + (size_t)(base + key) * 128 + kvh * 64 + oc * 8);
#pragma unroll
      for (int e = 0; e < 8; ++e) VT[(oc * 8 + e) * VSTR + c * 128 + key] = (bf16_t)v[e];
    }
  }
  __syncthreads();
  const int head = kvh * 4 + (wv >> 1);
  const float LOG2E = 1.4426950408889634f;
  const float sink2 = pk->in[I_SINK][head] * LOG2E;
#pragma unroll 1
  for (int hq = 0; hq < 2; ++hq) {
    const int qoff = (wv & 1) * 64 + hq * 32;
    float mrun[2], lrun[2]; f32x4 o[2][4];
#pragma unroll
    for (int qt = 0; qt < 2; ++qt) { mrun[qt] = sink2; lrun[qt] = 0.25f;
#pragma unroll
      for (int dt = 0; dt < 4; ++dt) o[qt][dt] = (f32x4){0.f, 0.f, 0.f, 0.f}; }
#pragma unroll 1
    for (int c = 0; c < 5; ++c) {
      const bool active = c >= 3 ? true : (is_ctx ? false : (c == 0 ? qb > 0 : (c == 2 ? qb < 127 : true)));
      if (!active) continue;
      const int base = c >= 3 ? MX + b * CTXL + (c - 3) * 128 : qrow0 + (c - 1) * 128;
      const bf16_t* kbase = Kb + (size_t)(base + fr) * 128 + kvh * 64 + fq * 8;
#pragma unroll
      for (int qt = 0; qt < 2; ++qt) {
        const int iq = qoff + qt * 16 + fr;
        const bf16_t* qp = Q + (size_t)(qrow0 + iq) * 512 + head * 64 + fq * 8;
        const bf16x8 q0 = *(const bf16x8*)(qp), q1 = *(const bf16x8*)(qp + 32);
        f32x4 st[8];
#pragma unroll
        for (int kt = 0; kt < 8; ++kt) {
          const bf16x8 k0 = *(const bf16x8*)(kbase + (size_t)kt * 16 * 128), k1 = *(const bf16x8*)(kbase + (size_t)kt * 16 * 128 + 32);
          f32x4 sx = __builtin_amdgcn_mfma_f32_16x16x32_bf16(k0, q0, (f32x4){0.f, 0.f, 0.f, 0.f}, 0, 0, 0);
          st[kt] = __builtin_amdgcn_mfma_f32_16x16x32_bf16(k1, q1, sx, 0, 0, 0);
        }
        float mx = -1e30f;
#pragma unroll
        for (int kt = 0; kt < 8; ++kt)
#pragma unroll
          for (int j = 0; j < 4; ++j) {
            const int jk = kt * 16 + 4 * fq + j;
            float sv = st[kt][j] * LOG2E;
            if ((c == 0 && jk < iq) || (c == 2 && jk > iq)) sv = -1e30f;
            st[kt][j] = sv; mx = fmaxf(mx, sv);
          }
        mx = fmaxf(mx, __shfl_xor(mx, 16)); mx = fmaxf(mx, __shfl_xor(mx, 32));
        const float mnew = fmaxf(mrun[qt], mx), alpha = exp2f(mrun[qt] - mnew);
        mrun[qt] = mnew;
        float ls = 0.f;
#pragma unroll
        for (int kt = 0; kt < 8; ++kt)
#pragma unroll
          for (int j = 0; j < 4; ++j) { const float pv = exp2f(st[kt][j] - mnew); st[kt][j] = pv; ls += pv; }
        lrun[qt] = lrun[qt] * alpha + ls;
#pragma unroll
        for (int dt = 0; dt < 4; ++dt) o[qt][dt] = o[qt][dt] * alpha;
#pragma unroll
        for (int kk = 0; kk < 4; ++kk) {
          u32x4 pw; pw.x = cvt_pk_bf16(st[2 * kk][0], st[2 * kk][1]); pw.y = cvt_pk_bf16(st[2 * kk][2], st[2 * kk][3]);
          pw.z = cvt_pk_bf16(st[2 * kk + 1][0], st[2 * kk + 1][1]); pw.w = cvt_pk_bf16(st[2 * kk + 1][2], st[2 * kk + 1][3]);
          const bf16x8 pf = __builtin_bit_cast(bf16x8, pw);
#pragma unroll
          for (int dt = 0; dt < 4; ++dt) {
            const LAS bf16_t* vp = VT + (dt * 16 + fr) * VSTR + c * 128 + kk * 32 + 4 * fq;
            u32x4 vw; const u32x2 va = *(const LAS u32x2*)(vp), vb = *(const LAS u32x2*)(vp + 16);
            vw.x = va.x; vw.y = va.y; vw.z = vb.x; vw.w = vb.y;
            o[qt][dt] = __builtin_amdgcn_mfma_f32_16x16x32_bf16(__builtin_bit_cast(bf16x8, vw), pf, o[qt][dt], 0, 0, 0);
          }
        }
      }
    }
#pragma unroll
    for (int qt = 0; qt < 2; ++qt) {
      float l = lrun[qt]; l += __shfl_xor(l, 16); l += __shfl_xor(l, 32);
      const float inv = 1.0f / l;
      bf16_t* op = MIX + (size_t)(qrow0 + qoff + qt * 16 + fr) * D + 512 + head * 64 + 4 * fq;
#pragma unroll
      for (int dt = 0; dt < 4; ++dt) *(u32x2*)(op + dt * 16) = pack4(o[qt][dt] * inv);
    }
  }
  __syncthreads();
}
__device__ __forceinline__ void gate_unit(PK pk, int u, LAS unsigned char* lds) { const int tid_l = launder_v((int)threadIdx.x);
  const bf16_t* UZ = (const bf16_t*)(pk->ws + OFF_UZ); bf16_t* MIX = (bf16_t*)(pk->ws + OFF_MIXE); const bf16_t* WS = (const bf16_t*)(pk->ws + OFF_GMWS);
  const int tid = tid_l, wv = tid >> 6, lane = tid & 63, fr = lane & 15, fq = lane >> 4;
  const int n = u >> 2, g = u & 3, row0 = n * 128;
  LAS float* rstd = (LAS float*)lds; LAS bf16_t* ZT = (LAS bf16_t*)(lds + 512);
  for (int i = 0; i < 16; ++i) { const int tok = wv * 16 + i;
    const u32x4 w = *(const u32x4*)(UZ + (size_t)(row0 + tok) * D + 512 + lane * 8);
    float ss = bflo(w.x) * bflo(w.x) + bfhi(w.x) * bfhi(w.x) + bflo(w.y) * bflo(w.y) + bfhi(w.y) * bfhi(w.y) + bflo(w.z) * bflo(w.z) + bfhi(w.z) * bfhi(w.z) + bflo(w.w) * bflo(w.w) + bfhi(w.w) * bfhi(w.w);
    ss = wave_sum(ss);
    if (lane == 0) rstd[tok] = rsqrtf(ss * (1.0f / 512.0f) + 1e-6f); }
  __syncthreads();
#pragma unroll
  for (int i = 0; i < 4; ++i) { const int idx = tid + i * 512, tok = idx >> 4, oc = idx & 15;
    const bf16x8 v = *(const bf16x8*)(UZ + (size_t)(row0 + tok) * D + 512 + g * 128 + oc * 8);
    const float rs = rstd[tok]; const float* gn = pk->in[I_GMG] + g * 128 + oc * 8;
#pragma unroll
    for (int e = 0; e < 8; ++e) ZT[(oc * 8 + e) * 136 + tok] = f2bf(bf2f((bf16_t)v[e]) * rs * gn[e]); }
  __syncthreads();
  bf16x8 bw[4];
#pragma unroll
  for (int kk = 0; kk < 4; ++kk) bw[kk] = *(const bf16x8*)(WS + (size_t)(g * 128 + wv * 16 + fr) * 128 + kk * 32 + fq * 8);
  const int row = row0 + wv * 16 + fr;
  const float bsv = pk->in[I_GMBS][g * 128 + wv * 16 + fr];
#pragma unroll
  for (int ct = 0; ct < 8; ++ct) {
    f32x4 acc = {0.f, 0.f, 0.f, 0.f};
#pragma unroll
    for (int kk = 0; kk < 4; ++kk) { const bf16x8 a = *(const LAS bf16x8*)(ZT + (ct * 16 + fr) * 136 + kk * 32 + fq * 8); acc = __builtin_amdgcn_mfma_f32_16x16x32_bf16(a, bw[kk], acc, 0, 0, 0); }
    const int col = g * 128 + ct * 16 + 4 * fq;
    const f32x4 uu = unpack4(*(const u32x2*)(UZ + (size_t)row * D + col));
    *(u32x2*)(MIX + (size_t)row * D + col) = pack4(uu * (acc + bsv));
  }
  __syncthreads();
}

__device__ __forceinline__ void phase_conv(PK pk, const int bid, const int nb) { const int tid_l = launder_v((int)threadIdx.x);
  const bf16_t* XX = (const bf16_t*)(pk->ws + OFF_XX); bf16_t* XC = (bf16_t*)(pk->ws + OFF_XC);
  const float* cw = pk->in[I_CONVW]; const float* cb = pk->in[I_CONVB];
  for (int idx = bid * 512 + tid_l; idx < MR * 128; idx += nb * 512) {
    const int r = idx >> 7, c = (idx & 127) * 8;
    int pos, len; if (r < MX) { pos = r & (SEQ - 1); len = SEQ; } else { pos = (r - MX) & (CTXL - 1); len = CTXL; }
    float a[8];
#pragma unroll
    for (int e = 0; e < 8; ++e) a[e] = cb[c + e];
#pragma unroll
    for (int j = 0; j < 4; ++j) { const int pp = pos - 1 + j;
      if (pp >= 0 && pp < len) { const u32x4 w = *(const u32x4*)(XX + (size_t)(r - 1 + j) * D + c); const float* cwj = cw + j * 1024 + c;
        a[0] += cwj[0] * bflo(w.x); a[1] += cwj[1] * bfhi(w.x); a[2] += cwj[2] * bflo(w.y); a[3] += cwj[3] * bfhi(w.y);
        a[4] += cwj[4] * bflo(w.z); a[5] += cwj[5] * bfhi(w.z); a[6] += cwj[6] * bflo(w.w); a[7] += cwj[7] * bfhi(w.w); } }
    u32x4 o; o.x = cvt_pk_bf16(a[0], a[1]); o.y = cvt_pk_bf16(a[2], a[3]); o.z = cvt_pk_bf16(a[4], a[5]); o.w = cvt_pk_bf16(a[6], a[7]);
    *(u32x4*)(XC + (size_t)r * D + c) = o;
  }
}
__device__ __forceinline__ void scan_item(int it, int& b, int& ci, int& row0) {
  if (it < 1024) { b = it >> 9; const int lc = it & 511; ci = 8 + lc; row0 = b * SEQ + lc * 32; }
  else { const int j = it - 1024; b = j >> 3; ci = j & 7; row0 = MX + b * CTXL + ci * 32; }
}
#define SCAN_STEP(H, LAW, BW) do { \
    H[0] = __expf(bflo(LAW.x)) * H[0] + bflo(BW.x); H[1] = __expf(bfhi(LAW.x)) * H[1] + bfhi(BW.x); \
    H[2] = __expf(bflo(LAW.y)) * H[2] + bflo(BW.y); H[3] = __expf(bfhi(LAW.y)) * H[3] + bfhi(BW.y); \
    H[4] = __expf(bflo(LAW.z)) * H[4] + bflo(BW.z); H[5] = __expf(bfhi(LAW.z)) * H[5] + bfhi(BW.z); \
    H[6] = __expf(bflo(LAW.w)) * H[6] + bflo(BW.w); H[7] = __expf(bfhi(LAW.w)) * H[7] + bfhi(BW.w); } while (0)
#define SCAN_ACCP(P, LAW) do { P[0] += bflo(LAW.x); P[1] += bfhi(LAW.x); P[2] += bflo(LAW.y); P[3] += bfhi(LAW.y); P[4] += bflo(LAW.z); P[5] += bfhi(LAW.z); P[6] += bflo(LAW.w); P[7] += bfhi(LAW.w); } while (0)
__device__ __forceinline__ void phase_scan1(PK pk, const int bid, const int nb) { const int tid_l = launder_v((int)threadIdx.x);
  const bf16_t* LAB = (const bf16_t*)(pk->ws + OFF_LAB); float* PE = (float*)(pk->ws + OFF_PE);
  const int ch = (tid_l & 127) * 8;
  for (int it = bid * 4 + (tid_l >> 7); it < 1040; it += nb * 4) {
    int b, ci, row0; scan_item(it, b, ci, row0);
#pragma unroll
    for (int d = 0; d < 2; ++d) {
      const bf16_t* LA = LAB + (size_t)(2 * d) * MR * D + ch; const bf16_t* BB = LAB + (size_t)(2 * d + 1) * MR * D + ch;
      float H[8], P[8];
#pragma unroll
      for (int e = 0; e < 8; ++e) { H[e] = 0.f; P[e] = 0.f; }
#pragma unroll 8
      for (int t = 0; t < 32; ++t) { const int r = row0 + (d == 0 ? t : 31 - t);
        const u32x4 lw = *(const u32x4*)(LA + (size_t)r * D), bw = *(const u32x4*)(BB + (size_t)r * D);
        SCAN_STEP(H, lw, bw); SCAN_ACCP(P, lw); }
      float* pp = PE + ((size_t)(d * 2 + b) * NCH + ci) * 1024 + ch; float* ep = pp + (size_t)2 * 2 * NCH * 1024;
      *(f32x4*)(pp) = (f32x4){P[0], P[1], P[2], P[3]}; *(f32x4*)(pp + 4) = (f32x4){P[4], P[5], P[6], P[7]};
      *(f32x4*)(ep) = (f32x4){H[0], H[1], H[2], H[3]}; *(f32x4*)(ep + 4) = (f32x4){H[4], H[5], H[6], H[7]};
    }
  }
}
__device__ __forceinline__ void phase_scan2(PK pk, const int bid, const int nb) { const int tid_l = launder_v((int)threadIdx.x);
  const float* PE = (const float*)(pk->ws + OFF_PE); float* HIN = (float*)(pk->ws + OFF_HIN);
  if (bid >= 64 || tid_l >= 64) return;
  const int id = bid * 64 + tid_l, d = id >> 11, b = (id >> 10) & 1, ch = id & 1023;
  const float* pp = PE + (size_t)(d * 2 + b) * NCH * 1024 + ch; const float* ep = pp + (size_t)2 * 2 * NCH * 1024;
  float* hp = HIN + (size_t)(d * 2 + b) * NCH * 1024 + ch;
  float H = 0.f;
  for (int s0 = 0; s0 < NCH; s0 += 8) {
    float pv[8], ev[8]; int cis[8];
#pragma unroll
    for (int k = 0; k < 8; ++k) { const int s = s0 + k; const int ci = d == 0 ? s : (s < 8 ? 7 - s : 519 - (s - 8)); cis[k] = ci; pv[k] = pp[(size_t)ci * 1024]; ev[k] = ep[(size_t)ci * 1024]; }
#pragma unroll
    for (int k = 0; k < 8; ++k) { hp[(size_t)cis[k] * 1024] = H; H = __expf(pv[k]) * H + ev[k]; }
  }
}
__device__ __forceinline__ void phase_scan3(PK pk, const int bid, const int nb) { const int tid_l = launder_v((int)threadIdx.x);
  const bf16_t* LAB = (const bf16_t*)(pk->ws + OFF_LAB); const float* HIN = (const float*)(pk->ws + OFF_HIN);
  const bf16_t* G = (const bf16_t*)(pk->ws + OFF_G); bf16_t* MIX = (bf16_t*)(pk->ws + OFF_MIXO);
  const int ch = (tid_l & 127) * 8;
  for (int it = bid * 4 + (tid_l >> 7); it < 1040; it += nb * 4) {
    int b, ci, row0; scan_item(it, b, ci, row0);
    { const bf16_t* LA = LAB + ch; const bf16_t* BB = LAB + (size_t)MR * D + ch;
      const float* hp = HIN + ((size_t)(0 * 2 + b) * NCH + ci) * 1024 + ch;
      const f32x4 h0 = *(const f32x4*)(hp), h1 = *(const f32x4*)(hp + 4);
      float H[8] = {h0[0], h0[1], h0[2], h0[3], h1[0], h1[1], h1[2], h1[3]};
#pragma unroll 8
      for (int t = 0; t < 32; ++t) { const int r = row0 + t;
        const u32x4 lw = *(const u32x4*)(LA + (size_t)r * D), bw = *(const u32x4*)(BB + (size_t)r * D);
        SCAN_STEP(H, lw, bw);
        u32x4 o; o.x = cvt_pk_bf16(H[0], H[1]); o.y = cvt_pk_bf16(H[2], H[3]); o.z = cvt_pk_bf16(H[4], H[5]); o.w = cvt_pk_bf16(H[6], H[7]);
        *(u32x4*)(MIX + (size_t)r * D + ch) = o; } }
    __threadfence_block();
    { const bf16_t* LA = LAB + (size_t)2 * MR * D + ch; const bf16_t* BB = LAB + (size_t)3 * MR * D + ch;
      const float* hp = HIN + ((size_t)(1 * 2 + b) * NCH + ci) * 1024 + ch;
      const f32x4 h0 = *(const f32x4*)(hp), h1 = *(const f32x4*)(hp + 4);
      float H[8] = {h0[0], h0[1], h0[2], h0[3], h1[0], h1[1], h1[2], h1[3]};
#pragma unroll 8
      for (int t = 31; t >= 0; --t) { const int r = row0 + t;
        const u32x4 lw = *(const u32x4*)(LA + (size_t)r * D), bw = *(const u32x4*)(BB + (size_t)r * D);
        SCAN_STEP(H, lw, bw);
        const u32x4 hf = *(const u32x4*)(MIX + (size_t)r * D + ch), gw = *(const u32x4*)(G + (size_t)r * D + ch);
        u32x4 o;
        o.x = cvt_pk_bf16((bflo(hf.x) + H[0]) * bflo(gw.x), (bfhi(hf.x) + H[1]) * bfhi(gw.x));
        o.y = cvt_pk_bf16((bflo(hf.y) + H[2]) * bflo(gw.y), (bfhi(hf.y) + H[3]) * bfhi(gw.y));
        o.z = cvt_pk_bf16((bflo(hf.z) + H[4]) * bflo(gw.z), (bfhi(hf.z) + H[5]) * bfhi(gw.z));
        o.w = cvt_pk_bf16((bflo(hf.w) + H[6]) * bflo(gw.w), (bfhi(hf.w) + H[7]) * bfhi(gw.w));
        *(u32x4*)(MIX + (size_t)r * D + ch) = o; } }
  }
}

__global__ void __launch_bounds__(512, 2) fwd_mega(Params p_unused) {
  extern __shared__ __attribute__((aligned(16))) unsigned char shm[];
  LAS unsigned char* lds = (LAS unsigned char*)shm;
  cg::grid_group grid = cg::this_grid();

  { PK pk = get_pk(); const int bid = launder_i((int)blockIdx.x), G = launder_i((int)gridDim.x); prologue(pk, lds, bid, G); }
  grid.sync();
#pragma unroll 1
  for (int l = 0; l < 2; ++l) {
#pragma unroll 1
    for (int s3 = 0; s3 < 3; ++s3) {
      const bool first = (l == 0 && s3 == 0);
      { PK pk = get_pk(); const int bid = launder_i((int)blockIdx.x), G = launder_i((int)gridDim.x); unsigned char* ws = pk->ws;
        const float* src_lat = first ? pk->in[I_X] : pk->out; const float* src_ctx = first ? pk->in[I_CTX] : (const float*)(ws + OFF_CTXR);
        phase_norm(src_lat, src_ctx, pk->in[I_NORMG] + (size_t)(l * 3 + s3) * D, (const float*)(ws + OFF_MOD) + (size_t)l * 3 * NMOD, s3, (bf16_t*)(ws + OFF_H), bid, G); }
      grid.sync();
      if (s3 != 1) {
        const int f = s3 >> 1, j = l * 2 + f;
        { PK pk = get_pk(); const int bid = launder_i((int)blockIdx.x), G = launder_i((int)gridDim.x); unsigned char* ws = pk->ws;
          pg8::Gemm g{(const bf16_t*)(ws + OFF_H), (const bf16_t*)(ws + OFF_W1 + j * SZ_W1), MR, 2 * FF, D, D, 0};
          pg8::StaticOrder S; S.init(g.M, g.N, G, bid);
          EpiSwiglu e{(bf16_t*)(ws + OFF_BIG)};
          pg8::gemm_phase(lds, g, S, e); }
        grid.sync();
        { PK pk = get_pk(); const int bid = launder_i((int)blockIdx.x), G = launder_i((int)gridDim.x); unsigned char* ws = pk->ws;
          const float* src_lat = first ? pk->in[I_X] : pk->out; const float* src_ctx = first ? pk->in[I_CTX] : (const float*)(ws + OFF_CTXR);
          pg8::Gemm g{(const bf16_t*)(ws + OFF_BIG), (const bf16_t*)(ws + OFF_W2 + j * SZ_W2), MR, D, FF, FF, 0};
          pg8::StaticOrder S; S.init(g.M, g.N, G, bid);
          EpiResid e{src_lat, src_ctx, pk->out, (float*)(ws + OFF_CTXR), (const float*)(ws + OFF_MOD) + (size_t)l * 3 * NMOD + (3 * s3 + 2) * 1024, 0.5f};
          pg8::gemm_phase(lds, g, S, e); }
        grid.sync();
      } else if (l == 0) {
        { PK pk = get_pk(); const int bid = launder_i((int)blockIdx.x), G = launder_i((int)gridDim.x); unsigned char* ws = pk->ws;
          pg8::Gemm g{(const bf16_t*)(ws + OFF_H), (const bf16_t*)(ws + OFF_EVIN), MR, EVIN_N, D, D, 0};
          pg8::StaticOrder S; S.init(g.M, g.N, G, bid);
          EpiEvenIn e{(bf16_t*)(ws + OFF_UZ), (bf16_t*)(ws + OFF_Q), (bf16_t*)(ws + OFF_K), (bf16_t*)(ws + OFF_V), (const float*)(ws + OFF_ROPE), (const float*)(ws + OFF_ROPE) + 4096};
          pg8::gemm_phase(lds, g, S, e); }
        grid.sync();
        { PK pk = get_pk(); const int bid = launder_i((int)blockIdx.x), G = launder_i((int)gridDim.x);
          for (int u = bid; u < 520 + 1040; u += G) { if (u < 520) attn_unit(pk, u, lds); else gate_unit(pk, u - 520, lds); } }
        grid.sync();
        { PK pk = get_pk(); const int bid = launder_i((int)blockIdx.x), G = launder_i((int)gridDim.x); unsigned char* ws = pk->ws;
          pg8::Gemm g{(const bf16_t*)(ws + OFF_MIXE), (const bf16_t*)(ws + OFF_EVOUT), MR, D, D, D, 0};
          pg8::StaticOrder S; S.init(g.M, g.N, G, bid);
          EpiResid e{pk->out, (const float*)(ws + OFF_CTXR), pk->out, (float*)(ws + OFF_CTXR), (const float*)(ws + OFF_MOD) + (size_t)l * 3 * NMOD + 5 * 1024, 1.0f};
          pg8::gemm_phase(lds, g, S, e); }
        grid.sync();
      } else {
        { PK pk = get_pk(); const int bid = launder_i((int)blockIdx.x), G = launder_i((int)gridDim.x); unsigned char* ws = pk->ws;
          pg8::Gemm g{(const bf16_t*)(ws + OFF_H), (const bf16_t*)(ws + OFF_ODIN), MR, 2048, D, D, 0};
          pg8::StaticOrder S; S.init(g.M, g.N, G, bid);
          EpiOddIn e{(bf16_t*)(ws + OFF_G), (bf16_t*)(ws + OFF_XX)};
          pg8::gemm_phase(lds, g, S, e); }
        grid.sync();
        { PK pk = get_pk(); const int bid = launder_i((int)blockIdx.x), G = launder_i((int)gridDim.x); phase_conv(pk, bid, G); }
        grid.sync();
        { PK pk = get_pk(); const int bid = launder_i((int)blockIdx.x), G = launder_i((int)gridDim.x); unsigned char* ws = pk->ws;
          pg8::Gemm g{(const bf16_t*)(ws + OFF_XC), (const bf16_t*)(ws + OFF_RGW), MR, 4096, 256, D, 1};
          pg8::StaticOrder S; S.init(g.M, g.N, G, bid);
          EpiRG e{(const bf16_t*)(ws + OFF_XC), (bf16_t*)(ws + OFF_LAB), pk->in[I_RGBA], pk->in[I_RGBX], (const float*)(ws + OFF_SP)};
          pg8::gemm_phase(lds, g, S, e); }
        grid.sync();
        { PK pk = get_pk(); const int bid = launder_i((int)blockIdx.x), G = launder_i((int)gridDim.x); phase_scan1(pk, bid, G); }
        grid.sync();
        { PK pk = get_pk(); const int bid = launder_i((int)blockIdx.x), G = launder_i((int)gridDim.x); phase_scan2(pk, bid, G); }
        grid.sync();
        { PK pk = get_pk(); const int bid = launder_i((int)blockIdx.x), G = launder_i((int)gridDim.x); phase_scan3(pk, bid, G); }
        grid.sync();
        { PK pk = get_pk(); const int bid = launder_i((int)blockIdx.x), G = launder_i((int)gridDim.x); unsigned char* ws = pk->ws;
          pg8::Gemm g{(const bf16_t*)(ws + OFF_MIXO), (const bf16_t*)(ws + OFF_ODOUT), MR, D, D, D, 0};
          pg8::StaticOrder S; S.init(g.M, g.N, G, bid);
          EpiResid e{pk->out, (const float*)(ws + OFF_CTXR), pk->out, (float*)(ws + OFF_CTXR), (const float*)(ws + OFF_MOD) + (size_t)l * 3 * NMOD + 5 * 1024, 1.0f};
          pg8::gemm_phase(lds, g, S, e); }
        grid.sync();
      }
    }
  }
  { PK pk = get_pk(); const int bid = launder_i((int)blockIdx.x), G = launder_i((int)gridDim.x); phase_final_norm(pk->out, pk->in[I_FNG], bid, G); }
}

extern "C" void kernel_launch(void* const* d_in, const int* in_sizes, int n_in, void* d_out, int out_size,
                              void* d_ws, size_t ws_size, hipStream_t stream) {
  static int grid_blocks = 0;
  if (!grid_blocks) {
    int dev = 0, cus = 0, per_cu = 0;
    (void)hipGetDevice(&dev);
    (void)hipDeviceGetAttribute(&cus, hipDeviceAttributeMultiprocessorCount, dev);
    (void)hipFuncSetAttribute((const void*)fwd_mega, hipFuncAttributeMaxDynamicSharedMemorySize, LDS_BYTES);
    (void)hipOccupancyMaxActiveBlocksPerMultiprocessor(&per_cu, (const void*)fwd_mega, 512, LDS_BYTES);
    (void)hipGetLastError();
    grid_blocks = cus > 0 ? cus : 256;
    if (ws_size < WS_NEED || n_in != 26) { fprintf(stderr, "kernel_launch: ws_size %zu < %zu or n_in %d != 26\n", ws_size, (size_t)WS_NEED, n_in); grid_blocks = -1; }
  }
  if (grid_blocks < 0) return;
  Params p{};
  for (int i = 0; i < 26; ++i) p.in[i] = (const float*)d_in[i];
  p.out = (float*)d_out; p.ws = (unsigned char*)d_ws;
  void* args[] = {&p};
  hipError_t e = hipLaunchCooperativeKernel((const void*)fwd_mega, dim3(grid_blocks), dim3(512), args, LDS_BYTES, stream);
  if (e != hipSuccess) fprintf(stderr, "cooperative launch failed: %s (grid %d)\n", hipGetErrorString(e), grid_blocks);
}
```

```cpp
#include <hip/hip_runtime.h>
#include <hip/hip_cooperative_groups.h>
#include <cstdio>
namespace cg = cooperative_groups;

#define LAS __attribute__((address_space(3)))
typedef unsigned short bf16_t;
typedef short bf16x8 __attribute__((ext_vector_type(8)));
typedef short bf16x4 __attribute__((ext_vector_type(4)));
typedef float f32x4 __attribute__((ext_vector_type(4)));
typedef unsigned u32x2 __attribute__((ext_vector_type(2)));
typedef unsigned u32x4 __attribute__((ext_vector_type(4)));

constexpr int D = 1024, FF = 2816, SEQ = 16384, MX = 32768, MC = 512, MR = MX + MC, CTXL = 256;
constexpr int NMOD = 9216;
constexpr int EVIN_N = 1792;
constexpr int LDS_BYTES = 131072 + 64;
constexpr int NCH = 544;

constexpr size_t SZ_W1 = (size_t)2 * FF * D * 2;
constexpr size_t SZ_W2 = (size_t)D * FF * 2;
constexpr size_t OFF_W1 = 0;
constexpr size_t OFF_W2 = OFF_W1 + 4 * SZ_W1;
constexpr size_t OFF_EVIN = OFF_W2 + 4 * SZ_W2;
constexpr size_t OFF_EVOUT = OFF_EVIN + (size_t)EVIN_N * D * 2;
constexpr size_t OFF_ODIN = OFF_EVOUT + (size_t)D * D * 2;
constexpr size_t OFF_ODOUT = OFF_ODIN + (size_t)2048 * D * 2;
constexpr size_t OFF_RGW = OFF_ODOUT + (size_t)D * D * 2;
constexpr size_t OFF_GMWS = OFF_RGW + (size_t)4096 * 256 * 2;
constexpr size_t OFF_MOD = OFF_GMWS + (size_t)4 * 128 * 128 * 2;
constexpr size_t OFF_ROPE = OFF_MOD + (size_t)2 * 3 * NMOD * 4;
constexpr size_t OFF_SP = OFF_ROPE + (size_t)256 * 16 * 2 * 4;
constexpr size_t OFF_GS = OFF_SP + (size_t)2 * 1024 * 4;
constexpr size_t OFF_BIASF = OFF_GS + (size_t)2 * 3 * 3 * 1024 * 4;
constexpr size_t OFF_BIASE = OFF_BIASF + (size_t)4 * 3 * 5632 * 4;
constexpr size_t OFF_BIASO = OFF_BIASE + (size_t)3 * 1792 * 4;
constexpr size_t OFF_RS = OFF_BIASO + (size_t)3 * 2048 * 4;
constexpr size_t OFF_CNT = OFF_RS + (size_t)2 * MR * 4;
constexpr size_t OFF_BAR = OFF_CNT + 256;
constexpr size_t OFF_CTXR = OFF_BAR + 3456 * 4;
constexpr size_t OFF_PE = OFF_CTXR + (size_t)MC * D * 4;
constexpr size_t SZ_CARRY = (size_t)2 * 2 * NCH * 1024 * 4;
constexpr size_t OFF_HIN = OFF_PE + 2 * SZ_CARRY;
constexpr size_t OFF_H = OFF_HIN + SZ_CARRY;
constexpr size_t SZ_ROWS = (size_t)MR * D * 2;
constexpr size_t OFF_BIG = OFF_H + SZ_ROWS;
constexpr size_t SZ_ACT = (size_t)MR * FF * 2;
constexpr size_t OFF_EXTRA = OFF_BIG + SZ_ACT;
constexpr size_t OFF_UZ = OFF_BIG;
constexpr size_t OFF_Q = OFF_UZ + SZ_ROWS;
constexpr size_t OFF_K = OFF_Q + SZ_ROWS / 2;
constexpr size_t OFF_V = OFF_K + SZ_ROWS / 8;
constexpr size_t OFF_MIXE = OFF_EXTRA;
constexpr size_t OFF_G = OFF_BIG;
constexpr size_t OFF_XX = OFF_G + SZ_ROWS;
constexpr size_t OFF_XC = OFF_H;
constexpr size_t OFF_LAB = OFF_XX;
constexpr size_t OFF_MIXO = OFF_LAB;
constexpr size_t WS_NEED = OFF_LAB + 4 * SZ_ROWS;
constexpr size_t OFF_RSP = OFF_LAB + 4 * SZ_ROWS;
constexpr size_t WS_NEED2 = OFF_RSP + (size_t)MR * 16 * 4;
static_assert(OFF_MIXE + SZ_ROWS <= WS_NEED, "ws");
static_assert(WS_NEED2 <= (size_t)536870912, "workspace budget 2");
static_assert(WS_NEED <= (size_t)536870912, "workspace budget");

struct Params { const float* in[26]; float* out; unsigned char* ws; };
typedef const Params __attribute__((address_space(4))) * PK;
__device__ __forceinline__ PK get_pk() { PK pk = (PK)__builtin_amdgcn_kernarg_segment_ptr(); asm volatile("" : "+s"(pk)); return pk; }
__device__ __forceinline__ int launder_i(int v) { asm volatile("" : "+s"(v)); return v; }
__device__ __forceinline__ float launder_f(float v) { asm volatile("" : "+s"(v)); return v; }
__device__ __forceinline__ int launder_v(int v) { asm volatile("" : "+v"(v)); return v; }
#define TID_X tid_l
enum { I_X = 0, I_C, I_CTX, I_CCTX, I_ADAW, I_ADAB, I_NORMG, I_WG, I_WU, I_WD, I_EVIN, I_EVOUT, I_GMG, I_GMWS, I_GMBS, I_SINK,
       I_ODIN, I_ODOUT, I_CONVW, I_CONVB, I_RGWA, I_RGBA, I_RGWX, I_RGBX, I_LAM, I_FNG };

__device__ __forceinline__ unsigned cvt_pk_bf16(float lo, float hi) { unsigned r; asm volatile("v_cvt_pk_bf16_f32 %0, %1, %2" : "=v"(r) : "v"(lo), "v"(hi)); return r; }
__device__ __forceinline__ bf16_t f2bf(float f) { return (bf16_t)(cvt_pk_bf16(f, 0.f) & 0xffffu); }
__device__ __forceinline__ float bf2f(bf16_t b) { return __uint_as_float(((unsigned)b) << 16); }
__device__ __forceinline__ float bflo(unsigned w) { return __uint_as_float(w << 16); }
__device__ __forceinline__ float bfhi(unsigned w) { return __uint_as_float(w & 0xffff0000u); }
__device__ __forceinline__ u32x2 pack4(f32x4 v) { u32x2 r; r.x = cvt_pk_bf16(v[0], v[1]); r.y = cvt_pk_bf16(v[2], v[3]); return r; }
__device__ __forceinline__ f32x4 unpack4(u32x2 w) { f32x4 r; r[0] = bflo(w.x); r[1] = bfhi(w.x); r[2] = bflo(w.y); r[3] = bfhi(w.y); return r; }
__device__ __forceinline__ float fast_sigmoid(float x) { return __fdividef(1.0f, 1.0f + __expf(-x)); }
__device__ __forceinline__ float gelu_tanh(float x) { const float t = 1.5957691216f * (x + 0.044715f * x * x * x); return x * fast_sigmoid(t); }
__device__ __forceinline__ float shx(float v, int o, int lane) { return __int_as_float(__builtin_amdgcn_ds_bpermute((lane ^ o) << 2, __float_as_int(v))); }
__device__ __forceinline__ float wave_sum(float v, int lane) {
#pragma unroll
  for (int o = 32; o >= 1; o >>= 1) v += shx(v, o, lane);
  return v;
}

namespace pg8 {
constexpr int BM = 256, BK = 64, HALF = 128, HTB = HALF * BK * 2, NXCD = 8, WGM = 8;
__device__ __forceinline__ int lds_byte(int r, int c) { const int st = (r >> 4) * 2 + (c >> 5), rr = r & 15, cc = c & 31, ob = rr * 64 + cc * 2; return st * 1024 + (ob ^ (((ob >> 9) & 1) << 5)); }
__device__ __forceinline__ void stage_rc(int b, int& R, int& C) { const int st = b / 1024, sb = b % 1024, swz = sb ^ (((sb >> 9) & 1) << 5); R = (st >> 1) * 16 + swz / 64; C = (st & 1) * 32 + (swz % 64) / 2; }
__device__ __forceinline__ int perm32(int rho) { const int n = rho >> 4, i = rho & 15; return 8 * (i >> 2) + 4 * n + (i & 3); }
struct Unit { int pm, pn, k0, nk; };
struct Gemm { const bf16_t* A; const bf16_t* Bt; int M, N, K, lda; int bd; int ablk; };
struct StaticOrder {
  int nM, nN, nwg, G, c, ntfull, nslice, nkslice;
  __device__ void init(int M, int N, int K, int G_, int c_) { nM = M / BM; nN = N / BM; nwg = nM * nN; G = G_; c = c_; ntfull = K / BK; nslice = 0; nkslice = 0; }
  __device__ void init_split(int N, int K, int G_, int c_, int S) { nM = 128; nN = N / BM; nwg = nM * nN; G = G_; c = c_; ntfull = K / BK; nslice = S; nkslice = ntfull / S; }
  __device__ bool next(int i, Unit& u) const {
    const long L = (long)i * G + c;
    if (L >= nwg) {
      const int e = (int)(L - nwg);
      if (e >= 2 * nN * nslice) return false;
      const int sl = e % nslice, tl = e / nslice;
      u.pm = 128 + tl / nN; u.pn = tl % nN; u.k0 = sl * nkslice; u.nk = nkslice; return true;
    }
    int wgid = (int)L; { const int q = nwg / NXCD, r = nwg % NXCD, xcd = wgid % NXCD, off = wgid / NXCD; wgid = (xcd < r ? xcd * (q + 1) : r * (q + 1) + (xcd - r) * q) + off; }
    const int nig = WGM * nN, gid = wgid / nig, fm = gid * WGM, gsz = (nM - fm) < WGM ? (nM - fm) : WGM;
    u.pm = fm + ((wgid % nig) % gsz); u.pn = (wgid % nig) / gsz; u.k0 = 0; u.nk = ntfull; return true;
  }
};

template <class Epi>
__device__ __forceinline__ void gemm_phase(LAS unsigned char* lds, const Gemm g, const StaticOrder& S, const Epi& E) { const int tid_l = launder_v((int)threadIdx.x);
  const int tid = tid_l, wid = __builtin_amdgcn_readfirstlane(tid >> 6), lane = tid & 63, wr = wid >> 2, wc = wid & 3, fr = lane & 15, fq = lane >> 4;
  const int K = g.K;
  unsigned voffA[2], voffB[2];
#pragma unroll
  for (int i = 0; i < 2; ++i) { int R, C; stage_rc(tid * 16 + i * 8192, R, C); const int Rb = Epi::PERM ? ((R & ~31) + perm32(R & 31)) : R;
    voffA[i] = (unsigned)(R * (g.ablk ? 64 : g.lda) + C) * 2u; voffB[i] = (unsigned)(Rb * K + C) * 2u; }
  const size_t kstep = (size_t)(BK * 2), kstepA = g.ablk ? (size_t)32768 : kstep;
  const size_t hstepA = g.ablk ? (size_t)16384 : (size_t)HALF * g.lda * 2, hstepB = (size_t)HALF * K * 2;
  const size_t tstepA = g.ablk ? (size_t)(K / BK) * 32768 : 2 * hstepA, tstepB = 2 * hstepB;
  const unsigned ldsw = (unsigned)wid * 1024u;
  const int aoff = lds_byte(wr * 64 + fr, fq * 8), boff = lds_byte(wc * 32 + fr, fq * 8);
#define PG8_SA(b, h) (((b) * 2 + (h)) * HTB)
#define PG8_SB(b, h) ((4 + (b) * 2 + (h)) * HTB)
#define PG8_STAGE(bufoff, gbase, voff) do { _Pragma("unroll") for (int _i = 0; _i < 2; ++_i) \
        __builtin_amdgcn_global_load_lds((const unsigned*)((const char*)(gbase) + (voff)[_i]), (LAS unsigned*)(lds + (bufoff) + ldsw + _i * 8192), 16, 0, 0); } while (0)
#define PG8_LDA(dst, b, h) do { _Pragma("unroll") for (int m = 0; m < 4; ++m) _Pragma("unroll") for (int k = 0; k < 2; ++k) dst[m][k] = *(const LAS bf16x8*)(lds + PG8_SA(b, h) + aoff + m * 2048 + k * 1024); } while (0)
#define PG8_LDB(dst, b, h) do { _Pragma("unroll") for (int n = 0; n < 2; ++n) _Pragma("unroll") for (int k = 0; k < 2; ++k) dst[n][k] = *(const LAS bf16x8*)(lds + PG8_SB(b, h) + boff + n * 2048 + k * 1024); } while (0)
#define PG8_MMA(ai, bj, At, Bt) do { __builtin_amdgcn_s_setprio(1); _Pragma("unroll") for (int m = 0; m < 4; ++m) _Pragma("unroll") for (int n = 0; n < 2; ++n) _Pragma("unroll") for (int k = 0; k < 2; ++k) \
        acc[ai][bj][m][n] = __builtin_amdgcn_mfma_f32_16x16x32_bf16(Bt[n][k], At[m][k], acc[ai][bj][m][n], 0, 0, 0); __builtin_amdgcn_s_setprio(0); } while (0)
#define PG8_WAIT_V(n) asm volatile("s_waitcnt vmcnt(" #n ")" ::: "memory")
#define PG8_WAIT_L(n) asm volatile("s_waitcnt lgkmcnt(" #n ")" ::: "memory")
#define PG8_BAR __builtin_amdgcn_s_barrier()
#define PG8_SCHED __builtin_amdgcn_sched_barrier(0)
#define PG8_ABASE(u) ((const char*)g.A + (size_t)(u).pm * tstepA + (size_t)(u).k0 * kstepA + (g.bd ? (size_t)((((u).pn >> 1) & 3) * 512) : (size_t)0))
#define PG8_BBASE(u) ((const char*)g.Bt + (size_t)(u).pn * tstepB + (size_t)(u).k0 * kstep)
  Unit cur, nxt; int ui = 0;
  if (!S.next(0, cur)) return;
  f32x4 acc[2][2][4][2];
#pragma unroll
  for (int a = 0; a < 2; ++a)
#pragma unroll
    for (int b = 0; b < 2; ++b)
#pragma unroll
      for (int m = 0; m < 4; ++m)
#pragma unroll
        for (int n = 0; n < 2; ++n) acc[a][b][m][n] = (f32x4){0.f, 0.f, 0.f, 0.f};
  bf16x8 At[4][2], B0[2][2], B1[2][2];
  const char* cA = PG8_ABASE(cur); const char* cB = PG8_BBASE(cur);
  PG8_STAGE(PG8_SB(0, 0), cB, voffB); PG8_STAGE(PG8_SA(0, 0), cA, voffA); PG8_STAGE(PG8_SB(0, 1), cB + hstepB, voffB); PG8_STAGE(PG8_SA(0, 1), cA + hstepA, voffA);
  if (wr == 1) PG8_BAR;
  PG8_WAIT_V(4); PG8_BAR;
  PG8_STAGE(PG8_SB(1, 0), cB + kstep, voffB); PG8_STAGE(PG8_SA(1, 0), cA + kstepA, voffA); PG8_STAGE(PG8_SB(1, 1), cB + hstepB + kstep, voffB);
  PG8_WAIT_V(6); PG8_BAR;
  for (;;) {
    const bool has_next = S.next(ui + 1, nxt);
    const char* nA = has_next ? PG8_ABASE(nxt) : cA; const char* nB = has_next ? PG8_BBASE(nxt) : cB;
    const int nt = cur.nk;
#pragma unroll 1
    for (int t = 0; t < nt; t += 2) {
      const bool last = (t == nt - 2);
      const char* a1 = cA + (size_t)(t + 1) * kstepA;
      const char* a2 = last ? nA : cA + (size_t)(t + 2) * kstepA; const char* b2 = last ? nB : cB + (size_t)(t + 2) * kstep;
      const char* a3 = a2 + kstepA; const char* b3 = b2 + kstep;
      PG8_LDB(B0, 0, 0); PG8_SCHED; PG8_LDA(At, 0, 0); PG8_STAGE(PG8_SA(1, 1), a1 + hstepA, voffA);
      PG8_WAIT_L(8); PG8_BAR; PG8_WAIT_L(0); PG8_MMA(0, 0, At, B0); PG8_BAR; PG8_SCHED;
      PG8_LDB(B1, 0, 1); PG8_STAGE(PG8_SB(0, 0), b2, voffB);
      PG8_BAR; PG8_WAIT_L(0); PG8_MMA(0, 1, At, B1); PG8_BAR;
      PG8_LDA(At, 0, 1); PG8_STAGE(PG8_SA(0, 0), a2, voffA);
      PG8_BAR; PG8_WAIT_L(0); PG8_MMA(1, 0, At, B0); PG8_BAR; PG8_SCHED;
      PG8_STAGE(PG8_SB(0, 1), b2 + hstepB, voffB);
      PG8_WAIT_V(6); PG8_BAR; PG8_MMA(1, 1, At, B1); PG8_BAR;
      PG8_LDB(B0, 1, 0); PG8_SCHED; PG8_LDA(At, 1, 0); PG8_STAGE(PG8_SA(0, 1), a2 + hstepA, voffA);
      PG8_WAIT_L(8); PG8_BAR; PG8_WAIT_L(0); PG8_MMA(0, 0, At, B0); PG8_BAR; PG8_SCHED;
      PG8_LDB(B1, 1, 1); PG8_STAGE(PG8_SB(1, 0), b3, voffB);
      PG8_BAR; PG8_WAIT_L(0); PG8_MMA(0, 1, At, B1); PG8_BAR;
      PG8_LDA(At, 1, 1); PG8_STAGE(PG8_SA(1, 0), a3, voffA);
      PG8_BAR; PG8_WAIT_L(0); PG8_MMA(1, 0, At, B0); PG8_BAR; PG8_SCHED;
      PG8_STAGE(PG8_SB(1, 1), b3 + hstepB, voffB);
      PG8_WAIT_V(6); PG8_BAR; PG8_MMA(1, 1, At, B1); PG8_BAR;
    }
    E(acc, cur, wr, wc, fr, fq);
    if (!has_next) break;
#pragma unroll
    for (int a = 0; a < 2; ++a)
#pragma unroll
      for (int b = 0; b < 2; ++b)
#pragma unroll
        for (int m = 0; m < 4; ++m)
#pragma unroll
          for (int n = 0; n < 2; ++n) acc[a][b][m][n] = (f32x4){0.f, 0.f, 0.f, 0.f};
    cur = nxt; cA = nA; cB = nB; ++ui;
  }
  PG8_WAIT_V(0);
  if (wr == 0) PG8_BAR;
  PG8_BAR;
#undef PG8_SA
#undef PG8_SB
#undef PG8_STAGE
#undef PG8_LDA
#undef PG8_LDB
#undef PG8_MMA
#undef PG8_WAIT_V
#undef PG8_WAIT_L
#undef PG8_BAR
#undef PG8_SCHED
#undef PG8_ABASE
#undef PG8_BBASE
}
}
using pg8::Unit;
typedef f32x4 AccT[2][2][4][2];

struct EpiSwiglu {
  static constexpr bool PERM = true;
  bf16_t* act; const float* rs; const float* bias;
  __device__ __forceinline__ void operator()(const AccT& acc, const Unit& u, int wr, int wc, int fr, int fq) const {
    const int row0 = u.pm * 256 + wr * 64 + fr, col0 = u.pn * 128 + wc * 32 + 8 * fq;
    const int mi = u.pm < 64 ? 0 : (u.pm < 128 ? 1 : 2);
    const float* bp = bias + (size_t)mi * (2 * FF) + u.pn * 256 + wc * 32 + 8 * fq;
    f32x4 bg[2], bu[2]; float rv[2][4];
#pragma unroll
    for (int n = 0; n < 2; ++n) { bg[n] = *(const f32x4*)(bp + n * 4); bu[n] = *(const f32x4*)(bp + 128 + n * 4); }
#pragma unroll
    for (int ai = 0; ai < 2; ++ai)
#pragma unroll
      for (int m = 0; m < 4; ++m) rv[ai][m] = rs[row0 + ai * 128 + m * 16];
#pragma unroll
    for (int ai = 0; ai < 2; ++ai)
#pragma unroll
      for (int m = 0; m < 4; ++m) rv[ai][m] = rsqrtf(rv[ai][m] * (1.0f / 1024.0f) + 1e-6f);
#pragma unroll
    for (int ai = 0; ai < 2; ++ai)
#pragma unroll
      for (int m = 0; m < 4; ++m) {
        const int r = row0 + ai * 128 + m * 16;
        bf16_t* rowp = act + ((size_t)(r >> 8) * (FF / 64) + (col0 >> 6)) * 16384 + (size_t)(r & 255) * 64 + (col0 & 63);
        u32x4 ow;
#pragma unroll
        for (int n = 0; n < 2; ++n) {
          const f32x4 gg = acc[ai][0][m][n] * rv[ai][m] + bg[n], uu = acc[ai][1][m][n] * rv[ai][m] + bu[n]; f32x4 v;
#pragma unroll
          for (int j = 0; j < 4; ++j) v[j] = gg[j] * fast_sigmoid(gg[j]) * uu[j];
          const u32x2 pk2 = pack4(v);
          if (n == 0) { ow.x = pk2.x; ow.y = pk2.y; } else { ow.z = pk2.x; ow.w = pk2.y; }
        }
        *(u32x4*)(rowp) = ow;
      }
  }
};
template <bool SRCF32, bool HALF>
struct EpiResid {
  static constexpr bool PERM = true;
  const float* src_f32; bf16_t* xbuf; unsigned char* wsb; int qi;
  __device__ __forceinline__ void operator()(const AccT& acc, const Unit& u, int wr, int wc, int fr, int fq) const {
    unsigned char* w2 = wsb; asm volatile("" : "+s"(w2));
    const int q = qi, l = q / 3, s3 = q - 3 * l;
    const float* gate = (const float*)(w2 + OFF_MOD) + l * 3 * NMOD + (HALF ? 3 * s3 + 2 : 5) * 1024;
    bf16_t* anext = q < 5 ? (bf16_t*)(w2 + OFF_H) : (bf16_t*)nullptr; const float* gsn = (const float*)(w2 + OFF_GS) + (q + 1) * 3072; float* rsp = (float*)(w2 + OFF_RSP);
    const size_t slab_off = HALF ? OFF_EXTRA : OFF_BIG;
    bf16_t* xdst = q < 5 ? xbuf : (bf16_t*)(w2 + OFF_H);
    const int row0 = u.pm * 256 + wr * 64 + fr, col0 = u.pn * 256 + wc * 32 + 8 * fq;
    const int mi = u.pm < 64 ? 0 : (u.pm < 128 ? 1 : 2);
    const float* gp = gate + (size_t)mi * NMOD + col0;
    f32x4 gv[2][2];
#pragma unroll
    for (int bj = 0; bj < 2; ++bj)
#pragma unroll
      for (int n = 0; n < 2; ++n) gv[bj][n] = *(const f32x4*)(gp + bj * 128 + n * 4) * (HALF ? 0.5f : 1.0f);
    if (u.pm < 128) {
      const size_t e0 = (size_t)row0 * D + col0;
      const float* gsp = gsn + mi * 1024 + col0;
      f32x4 gsv[2][2];
#pragma unroll
      for (int bj = 0; bj < 2; ++bj)
#pragma unroll
        for (int n = 0; n < 2; ++n) gsv[bj][n] = anext ? *(const f32x4*)(gsp + bj * 128 + n * 4) : (f32x4){0.f, 0.f, 0.f, 0.f};
      f32x4 xb[2][2][2];
#define RES_LOAD(dst, eoff) do { _Pragma("unroll") for (int bj = 0; bj < 2; ++bj) { \
          if (SRCF32) { dst[bj][0] = *(const f32x4*)(src_f32 + (eoff) + bj * 128); dst[bj][1] = *(const f32x4*)(src_f32 + (eoff) + bj * 128 + 4); } \
          else { const u32x4 w_ = *(const u32x4*)(xbuf + (eoff) + bj * 128); u32x2 lo_, hi_; lo_.x = w_.x; lo_.y = w_.y; hi_.x = w_.z; hi_.y = w_.w; dst[bj][0] = unpack4(lo_); dst[bj][1] = unpack4(hi_); } } } while (0)
      RES_LOAD(xb[0], e0);
#pragma unroll
      for (int st = 0; st < 8; ++st) {
        const int ai = st >> 2, m = st & 3, cur = st & 1, rr = ai * 128 + m * 16;
        if (st < 7) { const int rn = ((st + 1) >> 2) * 128 + ((st + 1) & 3) * 16; RES_LOAD(xb[cur ^ 1], e0 + (size_t)rn * D); }
        float ss = 0.f;
#pragma unroll
        for (int bj = 0; bj < 2; ++bj) {
          const f32x4 x0 = xb[cur][bj][0] + gv[bj][0] * acc[ai][bj][m][0], x1 = xb[cur][bj][1] + gv[bj][1] * acc[ai][bj][m][1];
          const u32x2 p0 = pack4(x0), p1 = pack4(x1);
          u32x4 ow; ow.x = p0.x; ow.y = p0.y; ow.z = p1.x; ow.w = p1.y;
          *(u32x4*)(xdst + e0 + (size_t)rr * D + bj * 128) = ow;
          if (anext) {
            const u32x2 q0 = pack4(x0 * gsv[bj][0]), q1 = pack4(x1 * gsv[bj][1]);
            u32x4 aw; aw.x = q0.x; aw.y = q0.y; aw.z = q1.x; aw.w = q1.y;
            *(u32x4*)(anext + e0 + (size_t)rr * D + bj * 128) = aw;
            ss += x0[0] * x0[0] + x0[1] * x0[1] + x0[2] * x0[2] + x0[3] * x0[3] + x1[0] * x1[0] + x1[1] * x1[1] + x1[2] * x1[2] + x1[3] * x1[3];
          }
        }
        if (anext) { ss += shx(ss, 16, fr + 16 * fq); ss += shx(ss, 32, fr + 16 * fq); if (fq == 0) rsp[(size_t)(row0 + rr) * 16 + u.pn * 4 + wc] = ss; }
      }
#undef RES_LOAD
    } else {
#pragma unroll
      for (int ai = 0; ai < 2; ++ai)
#pragma unroll
        for (int m = 0; m < 4; ++m) {
          float* d = (float*)(w2 + slab_off) + (size_t)(u.k0 / u.nk) * MC * D + (size_t)(row0 + ai * 128 + m * 16 - MX) * D + col0;
#pragma unroll
          for (int bj = 0; bj < 2; ++bj)
#pragma unroll
            for (int n = 0; n < 2; ++n) *(f32x4*)(d + bj * 128 + n * 4) = gv[bj][n] * acc[ai][bj][m][n];
        }
    }
  }
};
struct EpiEvenIn {
  static constexpr bool PERM = false;
  bf16_t* UZ; bf16_t* Q; bf16_t* Kb; bf16_t* Vb; const float* ropeC; const float* ropeS; const float* rs; const float* bias;
  __device__ __forceinline__ void operator()(const AccT& acc, const Unit& u, int wr, int wc, int fr, int fq) const {
    const int row0 = u.pm * 256 + wr * 64 + fr;
    const int mi = u.pm < 64 ? 0 : (u.pm < 128 ? 1 : 2);
    const float* bp = bias + (size_t)mi * EVIN_N + u.pn * 256 + wc * 32 + 4 * fq;
    f32x4 bv[2][2]; float rv[2][4];
#pragma unroll
    for (int bj = 0; bj < 2; ++bj)
#pragma unroll
      for (int n = 0; n < 2; ++n) bv[bj][n] = *(const f32x4*)(bp + bj * 128 + n * 16);
#pragma unroll
    for (int ai = 0; ai < 2; ++ai)
#pragma unroll
      for (int m = 0; m < 4; ++m) rv[ai][m] = rs[row0 + ai * 128 + m * 16];
#pragma unroll
    for (int ai = 0; ai < 2; ++ai)
#pragma unroll
      for (int m = 0; m < 4; ++m) rv[ai][m] = rsqrtf(rv[ai][m] * (1.0f / 1024.0f) + 1e-6f);
    if (u.pn < 4) {
      const int col0 = u.pn * 256 + wc * 32 + 4 * fq;
#pragma unroll
      for (int ai = 0; ai < 2; ++ai)
#pragma unroll
        for (int m = 0; m < 4; ++m) {
          const int r = row0 + ai * 128 + m * 16;
          bf16_t* rowp = UZ + (size_t)r * D + col0;
#pragma unroll
          for (int bj = 0; bj < 2; ++bj)
#pragma unroll
            for (int n = 0; n < 2; ++n) { f32x4 v = acc[ai][bj][m][n] * rv[ai][m] + bv[bj][n];
#pragma unroll
              for (int j = 0; j < 4; ++j) v[j] = gelu_tanh(v[j]);
              *(u32x2*)(rowp + bj * 128 + n * 16) = pack4(v); }
        }
    } else {
      const bool rope_on = u.pm < 128;
      const bool by_col = (wc & 1) != 0;
      f32x4 csb[2], snb[2];
      { const int pos = row0 & (SEQ - 1); const int pidx = by_col ? (pos & 63) : (pos >> 6);
        csb[0] = *(const f32x4*)(ropeC + pidx * 16 + 4 * fq); snb[0] = *(const f32x4*)(ropeS + pidx * 16 + 4 * fq); }
#pragma unroll
      for (int st = 0; st < 8; ++st) {
        const int ai = st >> 2, m = st & 3, cur = st & 1;
        const int r = row0 + ai * 128 + m * 16;
        if (st < 7) { const int rn = row0 + ((st + 1) >> 2) * 128 + ((st + 1) & 3) * 16; const int pos = rn & (SEQ - 1); const int pidx = by_col ? (pos & 63) : (pos >> 6);
          csb[cur ^ 1] = *(const f32x4*)(ropeC + pidx * 16 + 4 * fq); snb[cur ^ 1] = *(const f32x4*)(ropeS + pidx * 16 + 4 * fq); }
        f32x4 cs = csb[cur], sn = snb[cur];
        if (!rope_on) { cs = (f32x4){1.f, 1.f, 1.f, 1.f}; sn = (f32x4){0.f, 0.f, 0.f, 0.f}; }
#pragma unroll
        for (int bj = 0; bj < 2; ++bj) {
          const f32x4 x1 = acc[ai][bj][m][0] * rv[ai][m] + bv[bj][0], x2 = acc[ai][bj][m][1] * rv[ai][m] + bv[bj][1];
          if (u.pn < 6) {
            const f32x4 o1 = (x1 * cs - x2 * sn) * 0.18033688011112042f, o2 = (x1 * sn + x2 * cs) * 0.18033688011112042f;
            bf16_t* qp = Q + (size_t)r * 512 + (u.pn - 4) * 256 + bj * 128 + wc * 32 + 4 * fq;
            *(u32x2*)(qp) = pack4(o1); *(u32x2*)(qp + 16) = pack4(o2);
          } else if (bj == 0) {
            const f32x4 o1 = x1 * cs - x2 * sn, o2 = x1 * sn + x2 * cs;
            bf16_t* kp = Kb + (size_t)r * 128 + wc * 32 + 4 * fq;
            *(u32x2*)(kp) = pack4(o1); *(u32x2*)(kp + 16) = pack4(o2);
          } else {
            bf16_t* vp = Vb + (size_t)r * 128 + wc * 32 + 4 * fq;
            *(u32x2*)(vp) = pack4(x1); *(u32x2*)(vp + 16) = pack4(x2);
          }
        }
      }
    }
  }
};
struct EpiOddIn {
  static constexpr bool PERM = false;
  bf16_t* G; bf16_t* XX; const float* rs; const float* bias;
  __device__ __forceinline__ void operator()(const AccT& acc, const Unit& u, int wr, int wc, int fr, int fq) const {
    const int row0 = u.pm * 256 + wr * 64 + fr;
    const int mi = u.pm < 64 ? 0 : (u.pm < 128 ? 1 : 2);
    const float* bp = bias + (size_t)mi * 2048 + u.pn * 256 + wc * 32 + 4 * fq;
    f32x4 bv[2][2];
#pragma unroll
    for (int bj = 0; bj < 2; ++bj)
#pragma unroll
      for (int n = 0; n < 2; ++n) bv[bj][n] = *(const f32x4*)(bp + bj * 128 + n * 16);
    float rvv[2][4];
#pragma unroll
    for (int ai = 0; ai < 2; ++ai)
#pragma unroll
      for (int m = 0; m < 4; ++m) rvv[ai][m] = rs[row0 + ai * 128 + m * 16];
#pragma unroll
    for (int ai = 0; ai < 2; ++ai)
#pragma unroll
      for (int m = 0; m < 4; ++m) rvv[ai][m] = rsqrtf(rvv[ai][m] * (1.0f / 1024.0f) + 1e-6f);
    const bool isg = u.pn < 4;
    bf16_t* base = isg ? G : XX;
    const int col0 = (u.pn & 3) * 256 + wc * 32 + 4 * fq;
#pragma unroll
    for (int ai = 0; ai < 2; ++ai)
#pragma unroll
      for (int m = 0; m < 4; ++m) {
        const int r = row0 + ai * 128 + m * 16;
        const float rv = rvv[ai][m];
        bf16_t* rowp = base + (size_t)r * D + col0;
#pragma unroll
        for (int bj = 0; bj < 2; ++bj)
#pragma unroll
          for (int n = 0; n < 2; ++n) { f32x4 v = acc[ai][bj][m][n] * rv + bv[bj][n];
            if (isg) {
#pragma unroll
              for (int j = 0; j < 4; ++j) v[j] = gelu_tanh(v[j]); }
            *(u32x2*)(rowp + bj * 128 + n * 16) = pack4(v); }
      }
  }
};
struct EpiRG {
  static constexpr bool PERM = false;
  const bf16_t* XC; bf16_t* LAB; const float* ba; const float* bx; const float* sp;
  __device__ __forceinline__ void operator()(const AccT& acc, const Unit& u, int wr, int wc, int fr, int fq) const {
    const int row0 = u.pm * 256 + wr * 64 + fr;
    const int d = u.pn >> 3, h = (u.pn >> 1) & 3, cb = u.pn & 1;
    const int ch0 = h * 256 + cb * 128 + wc * 32 + 4 * fq;
    bf16_t* LA = LAB + (size_t)(2 * d) * MR * D; bf16_t* BB = LA + (size_t)MR * D;
    f32x4 bav[2], bxv[2], spv[2]; u32x2 xw[2][2][4];
#pragma unroll
    for (int n = 0; n < 2; ++n) { bav[n] = *(const f32x4*)(ba + d * 1024 + ch0 + n * 16); bxv[n] = *(const f32x4*)(bx + d * 1024 + ch0 + n * 16); spv[n] = *(const f32x4*)(sp + d * 1024 + ch0 + n * 16); }
#pragma unroll
    for (int ai = 0; ai < 2; ++ai)
#pragma unroll
      for (int m = 0; m < 4; ++m) xw[0][ai][m] = *(const u32x2*)(XC + (size_t)(row0 + ai * 128 + m * 16) * D + ch0);
#pragma unroll
    for (int n = 0; n < 2; ++n)
#pragma unroll
      for (int ai = 0; ai < 2; ++ai)
#pragma unroll
        for (int m = 0; m < 4; ++m) {
          const size_t ro = (size_t)(row0 + ai * 128 + m * 16) * D + ch0 + n * 16;
          if (n == 0) xw[1][ai][m] = *(const u32x2*)(XC + ro + 16);
          const f32x4 xv = unpack4(xw[n][ai][m]);
          f32x4 la, bb;
#pragma unroll
          for (int j = 0; j < 4; ++j) {
            const float rr = fast_sigmoid(acc[ai][0][m][n][j] + bav[n][j]), ii = fast_sigmoid(acc[ai][1][m][n][j] + bxv[n][j]);
            const float l = rr * spv[n][j];
            la[j] = l; bb[j] = __fsqrt_rn(fmaxf(1.0f - __expf(2.0f * l), 0.f)) * ii * xv[j];
          }
          *(u32x2*)(LA + ro) = pack4(la); *(u32x2*)(BB + ro) = pack4(bb);
        }
  }
};

__device__ __forceinline__ void cvt_tile(const float* src, int ld, bf16_t* dst, int ldd, LAS float* tile) { const int tid_l = launder_v((int)threadIdx.x);
  const int t = tid_l, a = t >> 6, b = t & 63;
#pragma unroll
  for (int i = 0; i < 8; ++i) tile[(i * 8 + a) * 65 + b] = src[(size_t)(i * 8 + a) * ld + b];
  __syncthreads();
#pragma unroll
  for (int i = 0; i < 8; ++i) dst[(size_t)(i * 8 + a) * ldd + b] = f2bf(tile[b * 65 + i * 8 + a]);
  __syncthreads();
}
__device__ __forceinline__ void sincos_taylor(double r, double& s, double& c) {
  const double r2 = r * r; double ts = r, tc = 1.0; s = r; c = 1.0;
  for (int i = 1; i <= 15; ++i) { tc = -tc * r2 / (double)((2 * i - 1) * (2 * i)); ts = -ts * r2 / (double)((2 * i) * (2 * i + 1)); c += tc; s += ts; }
}
__device__ __forceinline__ void prologue(PK pk, LAS unsigned char* lds, const int bid, const int nb) { const int tid_l = launder_v((int)threadIdx.x);
  unsigned char* ws = pk->ws;
  const int tid = tid_l;
  LAS float* tile = (LAS float*)lds;
  LAS float* sc = (LAS float*)(lds + 16640);
  LAS float* red = (LAS float*)(lds + 16640 + 12288);
  for (int i = tid; i < 3072; i += 512) { const int v = i >> 10, k = i & 1023; const float x = v < 2 ? pk->in[I_C][v * 1024 + k] : pk->in[I_CCTX][k]; sc[i] = x * fast_sigmoid(x); }
  __syncthreads();
  float* mod = (float*)(ws + OFF_MOD);
  for (int it = bid; it < 288; it += nb) {
    const int l = it / 144, cb = it % 144, kg = tid >> 6, j = tid & 63;
    const float* w = pk->in[I_ADAW] + (size_t)l * D * NMOD + (size_t)(kg * 128) * NMOD + cb * 64 + j;
    float a0 = 0.f, a1 = 0.f, a2 = 0.f;
    for (int k = 0; k < 128; ++k) { const float wv = w[(size_t)k * NMOD]; a0 += sc[kg * 128 + k] * wv; a1 += sc[1024 + kg * 128 + k] * wv; a2 += sc[2048 + kg * 128 + k] * wv; }
    red[(kg * 3 + 0) * 64 + j] = a0; red[(kg * 3 + 1) * 64 + j] = a1; red[(kg * 3 + 2) * 64 + j] = a2;
    __syncthreads();
    if (tid < 192) { const int v = tid >> 6, jj = tid & 63; float s = pk->in[I_ADAB][l * NMOD + cb * 64 + jj];
      for (int q = 0; q < 8; ++q) s += red[(q * 3 + v) * 64 + jj];
      mod[((size_t)l * 3 + v) * NMOD + cb * 64 + jj] = s; }
    __syncthreads();
  }
  { float* rc = (float*)(ws + OFF_ROPE); float* rs = rc + 4096;
    for (int i = bid * 512 + tid; i < 4096; i += nb * 512) { const int pp = i >> 4, f = i & 15;
      const float inv = powf(10000.0f, -(float)f / 16.0f); const float ang = (float)pp * inv;
      const double ad = (double)ang; const double kq = rint(ad * 0.15915494309189535); const double r = ad - kq * 6.283185307179586477;
      double s, c; sincos_taylor(r, s, c); rc[i] = (float)c; rs[i] = (float)s; } }
  { float* sp = (float*)(ws + OFF_SP); for (int i = bid * 512 + tid; i < 2048; i += nb * 512) sp[i] = -8.0f * log1pf(expf(-pk->in[I_LAM][i])); }
  { float* cr = (float*)(ws + OFF_CTXR); const float* ci = pk->in[I_CTX]; for (int i = bid * 512 + tid_l; i < MC * D / 4; i += nb * 512) *(f32x4*)(cr + 4 * (size_t)i) = *(const f32x4*)(ci + 4 * (size_t)i); }
  { bf16_t* o = (bf16_t*)(ws + OFF_GMWS); for (int i = bid * 512 + tid; i < 65536; i += nb * 512) o[i] = f2bf(pk->in[I_GMWS][i]); }
  for (int ti = bid; ti < 10176; ti += nb) {
    int r = ti;
    if (r < 5632) { const int j = r / 1408, rem = r % 1408, nbk = rem >> 4, kb = rem & 15, pn = nbk >> 2, sub = nbk & 3;
      const float* src = (sub < 2 ? pk->in[I_WG] : pk->in[I_WU]) + (size_t)j * D * FF + (size_t)(kb * 64) * FF + pn * 128 + (sub & 1) * 64;
      cvt_tile(src, FF, (bf16_t*)(ws + OFF_W1 + j * SZ_W1) + (size_t)(nbk * 64) * D + kb * 64, D, tile); continue; }
    r -= 5632;
    if (r < 2816) { const int j = r / 704, rem = r % 704, nbk = rem / 44, kb = rem % 44;
      const float* src = pk->in[I_WD] + (size_t)j * FF * D + (size_t)(kb * 64) * D + nbk * 64;
      cvt_tile(src, D, (bf16_t*)(ws + OFF_W2 + j * SZ_W2) + (size_t)(nbk * 64) * FF + kb * 64, FF, tile); continue; }
    r -= 2816;
    if (r < 448) { const int nbk = r >> 4, kb = r & 15;
      cvt_tile(pk->in[I_EVIN] + (size_t)(kb * 64) * EVIN_N + nbk * 64, EVIN_N, (bf16_t*)(ws + OFF_EVIN) + (size_t)(nbk * 64) * D + kb * 64, D, tile); continue; }
    r -= 448;
    if (r < 256) { const int nbk = r >> 4, kb = r & 15;
      cvt_tile(pk->in[I_EVOUT] + (size_t)(kb * 64) * D + nbk * 64, D, (bf16_t*)(ws + OFF_EVOUT) + (size_t)(nbk * 64) * D + kb * 64, D, tile); continue; }
    r -= 256;
    if (r < 512) { const int nbk = r >> 4, kb = r & 15;
      cvt_tile(pk->in[I_ODIN] + (size_t)(kb * 64) * 2048 + nbk * 64, 2048, (bf16_t*)(ws + OFF_ODIN) + (size_t)(nbk * 64) * D + kb * 64, D, tile); continue; }
    r -= 512;
    if (r < 256) { const int nbk = r >> 4, kb = r & 15;
      cvt_tile(pk->in[I_ODOUT] + (size_t)(kb * 64) * D + nbk * 64, D, (bf16_t*)(ws + OFF_ODOUT) + (size_t)(nbk * 64) * D + kb * 64, D, tile); continue; }
    r -= 256;
    { const int nbk = r >> 2, kb = r & 3, t = nbk >> 2, sub = nbk & 3, d = t >> 3, h = (t >> 1) & 3, cb = t & 1;
      const float* src = (sub < 2 ? pk->in[I_RGWA] : pk->in[I_RGWX]) + (size_t)(d * 4 + h) * 65536 + (size_t)(kb * 64) * 256 + cb * 128 + (sub & 1) * 64;
      cvt_tile(src, 256, (bf16_t*)(ws + OFF_RGW) + (size_t)(nbk * 64) * 256 + kb * 64, 256, tile); }
  }
}

__device__ __forceinline__ void phase_prep(const float* src_lat, float* src_ctx, const float* gs, bf16_t* h, float* rs, int r0, const float* slab, int nslab, const float* rsp, bool reduce_lat, const int bid, const int nb) { const int tid_l = launder_v((int)threadIdx.x);
  const int lane = tid_l & 63, wv = tid_l >> 6;
  for (int rb = r0 + (bid * 8 + wv) * 2; rb < MR; rb += nb * 16) {
    f32x4 v[2][4];
#pragma unroll
    for (int q = 0; q < 2; ++q) { const int r = rb + q; const float* xr = r < MX ? src_lat + (size_t)r * D : src_ctx + (size_t)(r - MX) * D;
#pragma unroll
      for (int i = 0; i < 4; ++i) v[q][i] = *(const f32x4*)(xr + i * 256 + lane * 4); }
    if (rb >= MX && nslab > 0) {
      for (int sl = 0; sl < nslab; ++sl)
#pragma unroll
        for (int q = 0; q < 2; ++q)
#pragma unroll
          for (int i = 0; i < 4; ++i) v[q][i] = v[q][i] + *(const f32x4*)(slab + ((size_t)sl * MC + (rb + q - MX)) * D + i * 256 + lane * 4);
#pragma unroll
      for (int q = 0; q < 2; ++q)
#pragma unroll
        for (int i = 0; i < 4; ++i) *(f32x4*)(src_ctx + (size_t)(rb + q - MX) * D + i * 256 + lane * 4) = v[q][i];
    }
#pragma unroll
    for (int q = 0; q < 2; ++q) { const int r = rb + q; const int mi = r < SEQ ? 0 : (r < MX ? 1 : 2);
      float ss = 0.f;
#pragma unroll
      for (int i = 0; i < 4; ++i) { ss += v[q][i][0] * v[q][i][0] + v[q][i][1] * v[q][i][1] + v[q][i][2] * v[q][i][2] + v[q][i][3] * v[q][i][3];
        const f32x4 g4 = *(const f32x4*)(gs + mi * 1024 + i * 256 + lane * 4);
        *(u32x2*)(h + (size_t)r * D + i * 256 + lane * 4) = pack4(v[q][i] * g4); }
      ss = wave_sum(ss, lane);
      if (lane == 0) rs[r] = ss; }
  }
  if (reduce_lat) {
    for (int r = bid * 512 + tid_l; r < MX; r += nb * 512) {
      const f32x4 a = *(const f32x4*)(rsp + (size_t)r * 16), b = *(const f32x4*)(rsp + (size_t)r * 16 + 4), c = *(const f32x4*)(rsp + (size_t)r * 16 + 8), d = *(const f32x4*)(rsp + (size_t)r * 16 + 12);
      rs[r] = ((((a[0] + a[1]) + (a[2] + a[3])) + ((b[0] + b[1]) + (b[2] + b[3]))) + (((c[0] + c[1]) + (c[2] + c[3])) + ((d[0] + d[1]) + (d[2] + d[3]))));
    }
  }
}
__device__ __forceinline__ void prologue2(PK pk, const int bid, const int nb) { const int tid_l = launder_v((int)threadIdx.x);
  unsigned char* ws = pk->ws; const float* mod = (const float*)(ws + OFF_MOD);
  { float* gs = (float*)(ws + OFF_GS);
    for (int i = bid * 512 + tid_l; i < 2 * 3 * 3 * 1024; i += nb * 512) { const int c = i & 1023, mi = (i >> 10) % 3, lj = i / 3072, l = lj / 3, j = lj % 3;
      gs[i] = pk->in[I_NORMG][(size_t)(l * 3 + j) * D + c] * (1.0f + mod[(size_t)(l * 3 + mi) * NMOD + (3 * j + 1) * 1024 + c]); } }
  const int lane = tid_l & 63, wv = tid_l >> 6;
  for (int t = bid * 8 + wv; t < 4 * 5632 + 1792 + 2048; t += nb * 8) {
    const bf16_t* wrow; float* bo; int l, j, n, ncols;
    if (t < 4 * 5632) { const int j4 = t / 5632; n = t % 5632; l = j4 >> 1; j = (j4 & 1) * 2; ncols = 5632; wrow = (const bf16_t*)(ws + OFF_W1 + j4 * SZ_W1) + (size_t)n * D; bo = (float*)(ws + OFF_BIASF) + (size_t)j4 * 3 * 5632; }
    else if (t < 4 * 5632 + 1792) { n = t - 4 * 5632; l = 0; j = 1; ncols = 1792; wrow = (const bf16_t*)(ws + OFF_EVIN) + (size_t)n * D; bo = (float*)(ws + OFF_BIASE); }
    else { n = t - 4 * 5632 - 1792; l = 1; j = 1; ncols = 2048; wrow = (const bf16_t*)(ws + OFF_ODIN) + (size_t)n * D; bo = (float*)(ws + OFF_BIASO); }
    const u32x4 w0 = *(const u32x4*)(wrow + lane * 16), w1 = *(const u32x4*)(wrow + lane * 16 + 8);
    const float wf[16] = {bflo(w0.x), bfhi(w0.x), bflo(w0.y), bfhi(w0.y), bflo(w0.z), bfhi(w0.z), bflo(w0.w), bfhi(w0.w), bflo(w1.x), bfhi(w1.x), bflo(w1.y), bfhi(w1.y), bflo(w1.z), bfhi(w1.z), bflo(w1.w), bfhi(w1.w)};
#pragma unroll
    for (int mi = 0; mi < 3; ++mi) { const float* sh = mod + (size_t)(l * 3 + mi) * NMOD + (3 * j) * 1024 + lane * 16; float a = 0.f;
#pragma unroll
      for (int q = 0; q < 4; ++q) { const f32x4 s4 = *(const f32x4*)(sh + 4 * q); a += s4[0] * wf[4 * q] + s4[1] * wf[4 * q + 1] + s4[2] * wf[4 * q + 2] + s4[3] * wf[4 * q + 3]; }
      a = wave_sum(a, lane);
      if (lane == 0) bo[(size_t)mi * ncols + n] = a; }
  }
}
__device__ __forceinline__ void phase_final_norm(float* out, const bf16_t* xb, const float* g, const int bid, const int nb) { const int tid_l = launder_v((int)threadIdx.x);
  const int lane = tid_l & 63, wv = tid_l >> 6;
  f32x4 gv[4];
#pragma unroll
  for (int i = 0; i < 4; ++i) gv[i] = *(const f32x4*)(g + i * 256 + lane * 4);
  for (int rb = (bid * 8 + wv) * 2; rb < MX; rb += nb * 16) {
    u32x2 w[2][4];
#pragma unroll
    for (int q = 0; q < 2; ++q)
#pragma unroll
      for (int i = 0; i < 4; ++i) w[q][i] = *(const u32x2*)(xb + (size_t)(rb + q) * D + i * 256 + lane * 4);
#pragma unroll
    for (int q = 0; q < 2; ++q) {
      f32x4 v[4]; float ss = 0.f;
#pragma unroll
      for (int i = 0; i < 4; ++i) { v[i] = unpack4(w[q][i]); ss += v[i][0] * v[i][0] + v[i][1] * v[i][1] + v[i][2] * v[i][2] + v[i][3] * v[i][3]; }
      ss = wave_sum(ss, lane);
      const float rstd = rsqrtf(ss * (1.0f / 1024.0f) + 1e-6f);
#pragma unroll
      for (int i = 0; i < 4; ++i) *(f32x4*)(out + (size_t)(rb + q) * D + i * 256 + lane * 4) = v[i] * rstd * gv[i]; }
  }
}

constexpr int VSTR = 648;
__device__ __forceinline__ void attn_unit(PK pk, int u, LAS unsigned char* lds) { const int tid_l = launder_v((int)threadIdx.x);
  const bf16_t* Q = (const bf16_t*)(pk->ws + OFF_Q); const bf16_t* Kb = (const bf16_t*)(pk->ws + OFF_K); const bf16_t* Vb = (const bf16_t*)(pk->ws + OFF_V);
  bf16_t* MIX = (bf16_t*)(pk->ws + OFF_MIXE);
  const int tid = tid_l, wv = tid >> 6, lane = tid & 63, fr = lane & 15, fq = lane >> 4;
  const bool is_ctx = u >= 512;
  int b, qb, kvh;
  if (!is_ctx) { b = u >> 8; qb = (u >> 1) & 127; kvh = u & 1; } else { const int j = u - 512; b = j >> 2; qb = (j >> 1) & 1; kvh = j & 1; }
  const int qrow0 = is_ctx ? MX + b * CTXL + qb * 128 : b * SEQ + qb * 128;
  LAS bf16_t* VT = (LAS bf16_t*)lds;
#pragma unroll 1
  for (int c = 0; c < 5; ++c) {
    const bool active = c >= 3 ? true : (is_ctx ? false : (c == 0 ? qb > 0 : (c == 2 ? qb < 127 : true)));
    if (!active) continue;
    const int base = c >= 3 ? MX + b * CTXL + (c - 3) * 128 : qrow0 + (c - 1) * 128;
    const int kp = tid & 63, oc = tid >> 6;
    const bf16_t* vsrc = Vb + (size_t)(base + 2 * kp) * 128 + kvh * 64 + oc * 8;
    const u32x4 v0 = *(const u32x4*)(vsrc), v1 = *(const u32x4*)(vsrc + 128);
    LAS unsigned* vdst = (LAS unsigned*)(VT + (oc * 8) * VSTR + c * 128 + 2 * kp);
    vdst[0 * (VSTR / 2)] = (v0.x & 0xffffu) | (v1.x << 16); vdst[1 * (VSTR / 2)] = (v0.x >> 16) | (v1.x & 0xffff0000u);
    vdst[2 * (VSTR / 2)] = (v0.y & 0xffffu) | (v1.y << 16); vdst[3 * (VSTR / 2)] = (v0.y >> 16) | (v1.y & 0xffff0000u);
    vdst[4 * (VSTR / 2)] = (v0.z & 0xffffu) | (v1.z << 16); vdst[5 * (VSTR / 2)] = (v0.z >> 16) | (v1.z & 0xffff0000u);
    vdst[6 * (VSTR / 2)] = (v0.w & 0xffffu) | (v1.w << 16); vdst[7 * (VSTR / 2)] = (v0.w >> 16) | (v1.w & 0xffff0000u);
  }
  __syncthreads();
  const int head = kvh * 4 + (wv >> 1);
  const float LOG2E = 1.4426950408889634f;
  const float sink2 = pk->in[I_SINK][head] * LOG2E;
  LAS unsigned char* KB0 = lds + 83968;
  constexpr int KROW = 144, KBUF = 128 * KROW;
  const int skey = tid >> 2, sseg = (tid & 3) * 2;
#define ATT_ACTIVE(c_) ((c_) >= 3 ? true : (is_ctx ? false : ((c_) == 0 ? qb > 0 : ((c_) == 2 ? qb < 127 : true))))
#define ATT_BASE(c_) ((c_) >= 3 ? MX + b * CTXL + ((c_) - 3) * 128 : qrow0 + ((c_) - 1) * 128)
  int par = 0;
#pragma unroll 1
  for (int hq = 0; hq < 2; ++hq) {
    const int qoff = (wv & 1) * 64 + hq * 32;
    float mrun[2], lrun[2]; f32x4 o[2][4];
#pragma unroll
    for (int qt = 0; qt < 2; ++qt) { mrun[qt] = sink2; lrun[qt] = 0.25f;
#pragma unroll
      for (int dt = 0; dt < 4; ++dt) o[qt][dt] = (f32x4){0.f, 0.f, 0.f, 0.f}; }
    int c = is_ctx ? 3 : (qb > 0 ? 0 : 1);
    { const bf16_t* ks = Kb + (size_t)(ATT_BASE(c) + skey) * 128 + kvh * 64 + sseg * 8;
      const u32x4 a0 = *(const u32x4*)(ks), a1 = *(const u32x4*)(ks + 8);
      LAS unsigned char* kd = KB0 + par * KBUF + skey * KROW + sseg * 16;
      *(LAS u32x4*)(kd) = a0; *(LAS u32x4*)(kd + 16) = a1; }
    __syncthreads();
#pragma unroll 1
    while (c < 5) {
      int cn = c + 1; while (cn < 5 && !ATT_ACTIVE(cn)) ++cn;
      u32x4 n0 = {0u, 0u, 0u, 0u}, n1 = {0u, 0u, 0u, 0u};
      if (cn < 5) { const bf16_t* ks = Kb + (size_t)(ATT_BASE(cn) + skey) * 128 + kvh * 64 + sseg * 8; n0 = *(const u32x4*)(ks); n1 = *(const u32x4*)(ks + 8); }
      const int dlo = c == 0 ? 0 : -100000, dhi = c == 2 ? 0 : 100000;
      const LAS unsigned char* kcur = KB0 + par * KBUF + fr * KROW + fq * 16;
#pragma unroll
      for (int qt = 0; qt < 2; ++qt) {
        const int iq = qoff + qt * 16 + fr; const int dq = 4 * fq - iq;
        const bf16_t* qp = Q + (size_t)(qrow0 + iq) * 512 + head * 64 + fq * 8;
        const bf16x8 q0 = *(const bf16x8*)(qp), q1 = *(const bf16x8*)(qp + 32);
        f32x4 st[8];
#pragma unroll
        for (int kt = 0; kt < 8; ++kt) {
          const bf16x8 k0 = *(const LAS bf16x8*)(kcur + kt * 16 * KROW), k1 = *(const LAS bf16x8*)(kcur + kt * 16 * KROW + 64);
          f32x4 sx = __builtin_amdgcn_mfma_f32_16x16x32_bf16(k0, q0, (f32x4){0.f, 0.f, 0.f, 0.f}, 0, 0, 0);
          st[kt] = __builtin_amdgcn_mfma_f32_16x16x32_bf16(k1, q1, sx, 0, 0, 0);
        }
        float mx = -1e30f;
#pragma unroll
        for (int kt = 0; kt < 8; ++kt)
#pragma unroll
          for (int j = 0; j < 4; ++j) {
            const int df = kt * 16 + j + dq;
            float sv = st[kt][j];
            if (df < dlo || df > dhi) sv = -1e30f;
            st[kt][j] = sv; mx = fmaxf(mx, sv);
          }
        mx = fmaxf(mx, shx(mx, 16, lane)); mx = fmaxf(mx, shx(mx, 32, lane));
        const float mnew = fmaxf(mrun[qt], mx), alpha = exp2f(mrun[qt] - mnew);
        mrun[qt] = mnew;
        float ls = 0.f;
#pragma unroll
        for (int kt = 0; kt < 8; ++kt)
#pragma unroll
          for (int j = 0; j < 4; ++j) { const float pv = exp2f(st[kt][j] - mnew); st[kt][j] = pv; ls += pv; }
        lrun[qt] = lrun[qt] * alpha + ls;
#pragma unroll
        for (int dt = 0; dt < 4; ++dt) o[qt][dt] = o[qt][dt] * alpha;
#pragma unroll
        for (int kk = 0; kk < 4; ++kk) {
          u32x4 pw; pw.x = cvt_pk_bf16(st[2 * kk][0], st[2 * kk][1]); pw.y = cvt_pk_bf16(st[2 * kk][2], st[2 * kk][3]);
          pw.z = cvt_pk_bf16(st[2 * kk + 1][0], st[2 * kk + 1][1]); pw.w = cvt_pk_bf16(st[2 * kk + 1][2], st[2 * kk + 1][3]);
          const bf16x8 pf = __builtin_bit_cast(bf16x8, pw);
#pragma unroll
          for (int dt = 0; dt < 4; ++dt) {
            const LAS bf16_t* vp = VT + (dt * 16 + fr) * VSTR + c * 128 + kk * 32 + 4 * fq;
            u32x4 vw; const u32x2 va = *(const LAS u32x2*)(vp), vb = *(const LAS u32x2*)(vp + 16);
            vw.x = va.x; vw.y = va.y; vw.z = vb.x; vw.w = vb.y;
            o[qt][dt] = __builtin_amdgcn_mfma_f32_16x16x32_bf16(__builtin_bit_cast(bf16x8, vw), pf, o[qt][dt], 0, 0, 0);
          }
        }
      }
      if (cn < 5) { LAS unsigned char* kd = KB0 + (par ^ 1) * KBUF + skey * KROW + sseg * 16; *(LAS u32x4*)(kd) = n0; *(LAS u32x4*)(kd + 16) = n1; }
      __syncthreads();
      c = cn; par ^= 1;
    }
#pragma unroll
    for (int qt = 0; qt < 2; ++qt) {
      float l = lrun[qt]; l += shx(l, 16, lane); l += shx(l, 32, lane);
      const float inv = 1.0f / l;
      bf16_t* op = MIX + (size_t)(qrow0 + qoff + qt * 16 + fr) * D + 512 + head * 64 + 4 * fq;
#pragma unroll
      for (int dt = 0; dt < 4; ++dt) *(u32x2*)(op + dt * 16) = pack4(o[qt][dt] * inv);
    }
  }
  __syncthreads();
}
__device__ __forceinline__ void gate_unit(PK pk, int u, LAS unsigned char* lds) { const int tid_l = launder_v((int)threadIdx.x);
  const bf16_t* UZ = (const bf16_t*)(pk->ws + OFF_UZ); bf16_t* MIX = (bf16_t*)(pk->ws + OFF_MIXE); const bf16_t* WS = (const bf16_t*)(pk->ws + OFF_GMWS);
  const int tid = tid_l, wv = tid >> 6, lane = tid & 63, fr = lane & 15, fq = lane >> 4;
  const int n = u >> 2, g = u & 3, row0 = n * 128;
  LAS float* rstd = (LAS float*)lds; LAS bf16_t* ZT = (LAS bf16_t*)(lds + 512);
  { u32x4 w[16];
#pragma unroll
    for (int i = 0; i < 16; ++i) w[i] = *(const u32x4*)(UZ + (size_t)(row0 + wv * 16 + i) * D + 512 + lane * 8);
#pragma unroll
    for (int i = 0; i < 16; ++i) {
      float ss = bflo(w[i].x) * bflo(w[i].x) + bfhi(w[i].x) * bfhi(w[i].x) + bflo(w[i].y) * bflo(w[i].y) + bfhi(w[i].y) * bfhi(w[i].y) + bflo(w[i].z) * bflo(w[i].z) + bfhi(w[i].z) * bfhi(w[i].z) + bflo(w[i].w) * bflo(w[i].w) + bfhi(w[i].w) * bfhi(w[i].w);
      ss = wave_sum(ss, lane);
      if (lane == 0) rstd[wv * 16 + i] = rsqrtf(ss * (1.0f / 512.0f) + 1e-6f); } }
  __syncthreads();
#pragma unroll
  for (int i = 0; i < 2; ++i) { const int tp = lane, oc = wv + 8 * i;
    const bf16_t* zsrc = UZ + (size_t)(row0 + 2 * tp) * D + 512 + g * 128 + oc * 8;
    const u32x4 z0 = *(const u32x4*)(zsrc), z1 = *(const u32x4*)(zsrc + D);
    const float r0 = rstd[2 * tp], r1 = rstd[2 * tp + 1]; const float* gn = pk->in[I_GMG] + g * 128 + oc * 8;
    const f32x4 g0 = *(const f32x4*)(gn), g1 = *(const f32x4*)(gn + 4);
    LAS unsigned* zd = (LAS unsigned*)(ZT + (oc * 8) * 136 + 2 * tp);
    zd[0 * 68] = cvt_pk_bf16(bflo(z0.x) * r0 * g0[0], bflo(z1.x) * r1 * g0[0]); zd[1 * 68] = cvt_pk_bf16(bfhi(z0.x) * r0 * g0[1], bfhi(z1.x) * r1 * g0[1]);
    zd[2 * 68] = cvt_pk_bf16(bflo(z0.y) * r0 * g0[2], bflo(z1.y) * r1 * g0[2]); zd[3 * 68] = cvt_pk_bf16(bfhi(z0.y) * r0 * g0[3], bfhi(z1.y) * r1 * g0[3]);
    zd[4 * 68] = cvt_pk_bf16(bflo(z0.z) * r0 * g1[0], bflo(z1.z) * r1 * g1[0]); zd[5 * 68] = cvt_pk_bf16(bfhi(z0.z) * r0 * g1[1], bfhi(z1.z) * r1 * g1[1]);
    zd[6 * 68] = cvt_pk_bf16(bflo(z0.w) * r0 * g1[2], bflo(z1.w) * r1 * g1[2]); zd[7 * 68] = cvt_pk_bf16(bfhi(z0.w) * r0 * g1[3], bfhi(z1.w) * r1 * g1[3]); }
  __syncthreads();
  bf16x8 bw[4];
#pragma unroll
  for (int kk = 0; kk < 4; ++kk) bw[kk] = *(const bf16x8*)(WS + (size_t)(g * 128 + wv * 16 + fr) * 128 + kk * 32 + fq * 8);
  const int row = row0 + wv * 16 + fr;
  const float bsv = pk->in[I_GMBS][g * 128 + wv * 16 + fr];
#pragma unroll
  for (int ct = 0; ct < 8; ++ct) {
    f32x4 acc = {0.f, 0.f, 0.f, 0.f};
#pragma unroll
    for (int kk = 0; kk < 4; ++kk) { const bf16x8 a = *(const LAS bf16x8*)(ZT + (ct * 16 + fr) * 136 + kk * 32 + fq * 8); acc = __builtin_amdgcn_mfma_f32_16x16x32_bf16(a, bw[kk], acc, 0, 0, 0); }
    const int col = g * 128 + ct * 16 + 4 * fq;
    const f32x4 uu = unpack4(*(const u32x2*)(UZ + (size_t)row * D + col));
    *(u32x2*)(MIX + (size_t)row * D + col) = pack4(uu * (acc + bsv));
  }
  __syncthreads();
}

__device__ __forceinline__ void phase_conv(PK pk, const int bid, const int nb) { const int tid_l = launder_v((int)threadIdx.x);
  const bf16_t* __restrict__ XX = (const bf16_t*)(pk->ws + OFF_XX); bf16_t* __restrict__ XC = (bf16_t*)(pk->ws + OFF_XC);
  const float* __restrict__ cw = pk->in[I_CONVW]; const float* __restrict__ cb = pk->in[I_CONVB];
#pragma unroll 4
  for (int idx = bid * 512 + tid_l; idx < MR * 128; idx += nb * 512) {
    const int r = idx >> 7, c = (idx & 127) * 8;
    int pos, len; if (r < MX) { pos = r & (SEQ - 1); len = SEQ; } else { pos = (r - MX) & (CTXL - 1); len = CTXL; }
    float a[8];
#pragma unroll
    for (int e = 0; e < 8; ++e) a[e] = cb[c + e];
#pragma unroll
    for (int j = 0; j < 4; ++j) { const int pp = pos - 1 + j;
      if (pp >= 0 && pp < len) { const u32x4 w = *(const u32x4*)(XX + (size_t)(r - 1 + j) * D + c); const float* cwj = cw + j * 1024 + c;
        a[0] += cwj[0] * bflo(w.x); a[1] += cwj[1] * bfhi(w.x); a[2] += cwj[2] * bflo(w.y); a[3] += cwj[3] * bfhi(w.y);
        a[4] += cwj[4] * bflo(w.z); a[5] += cwj[5] * bfhi(w.z); a[6] += cwj[6] * bflo(w.w); a[7] += cwj[7] * bfhi(w.w); } }
    u32x4 o; o.x = cvt_pk_bf16(a[0], a[1]); o.y = cvt_pk_bf16(a[2], a[3]); o.z = cvt_pk_bf16(a[4], a[5]); o.w = cvt_pk_bf16(a[6], a[7]);
    *(u32x4*)(XC + (size_t)r * D + c) = o;
  }
}
__device__ __forceinline__ void scan_item(int it, int& b, int& ci, int& row0, int& len) {
  if (it < 1024) { b = it >> 9; const int lc = it & 511; ci = 32 + lc; row0 = b * SEQ + lc * 32; len = 32; }
  else { const int j = it - 1024; b = j >> 5; ci = j & 31; row0 = MX + b * CTXL + ci * 8; len = 8; }
}
#define SCAN_STEP(H, LAW, BW) do { \
    H[0] = __expf(bflo(LAW.x)) * H[0] + bflo(BW.x); H[1] = __expf(bfhi(LAW.x)) * H[1] + bfhi(BW.x); \
    H[2] = __expf(bflo(LAW.y)) * H[2] + bflo(BW.y); H[3] = __expf(bfhi(LAW.y)) * H[3] + bfhi(BW.y); \
    H[4] = __expf(bflo(LAW.z)) * H[4] + bflo(BW.z); H[5] = __expf(bfhi(LAW.z)) * H[5] + bfhi(BW.z); \
    H[6] = __expf(bflo(LAW.w)) * H[6] + bflo(BW.w); H[7] = __expf(bfhi(LAW.w)) * H[7] + bfhi(BW.w); } while (0)
#define SCAN_ACCP(P, LAW) do { P[0] += bflo(LAW.x); P[1] += bfhi(LAW.x); P[2] += bflo(LAW.y); P[3] += bfhi(LAW.y); P[4] += bflo(LAW.z); P[5] += bfhi(LAW.z); P[6] += bflo(LAW.w); P[7] += bfhi(LAW.w); } while (0)
__device__ __forceinline__ void phase_scan1(PK pk, const int bid, const int nb) { const int tid_l = launder_v((int)threadIdx.x);
  const bf16_t* __restrict__ LAB = (const bf16_t*)(pk->ws + OFF_LAB); float* __restrict__ PE = (float*)(pk->ws + OFF_PE);
  const int ch = (tid_l & 127) * 8;
  for (int it = bid * 4 + (tid_l >> 7); it < 1088; it += nb * 4) {
    int b, ci, row0, len; scan_item(it, b, ci, row0, len);
#pragma unroll
    for (int d = 0; d < 2; ++d) {
      const bf16_t* __restrict__ LA = LAB + (size_t)(2 * d) * MR * D + ch; const bf16_t* __restrict__ BB = LAB + (size_t)(2 * d + 1) * MR * D + ch;
      float H[8], P[8];
#pragma unroll
      for (int e = 0; e < 8; ++e) { H[e] = 0.f; P[e] = 0.f; }
#pragma unroll 1
      for (int t0 = 0; t0 < len; t0 += 8) {
        u32x4 lw[8], bw[8];
#pragma unroll
        for (int k = 0; k < 8; ++k) { const int r = row0 + (d == 0 ? t0 + k : len - 1 - t0 - k); lw[k] = *(const u32x4*)(LA + (size_t)r * D); bw[k] = *(const u32x4*)(BB + (size_t)r * D); }
#pragma unroll
        for (int k = 0; k < 8; ++k) { SCAN_STEP(H, lw[k], bw[k]); SCAN_ACCP(P, lw[k]); }
      }
      float* pp = PE + ((size_t)(d * 2 + b) * NCH + ci) * 1024 + ch; float* ep = pp + (size_t)2 * 2 * NCH * 1024;
      *(f32x4*)(pp) = (f32x4){P[0], P[1], P[2], P[3]}; *(f32x4*)(pp + 4) = (f32x4){P[4], P[5], P[6], P[7]};
      *(f32x4*)(ep) = (f32x4){H[0], H[1], H[2], H[3]}; *(f32x4*)(ep + 4) = (f32x4){H[4], H[5], H[6], H[7]};
    }
  }
}
__device__ __forceinline__ void phase_scan2(PK pk, const int bid, const int nb) { const int tid_l = launder_v((int)threadIdx.x);
  const float* PE = (const float*)(pk->ws + OFF_PE); float* HIN = (float*)(pk->ws + OFF_HIN);
  if (bid >= 64 || tid_l >= 64) return;
  const int id = bid * 64 + tid_l, d = id >> 11, b = (id >> 10) & 1, ch = id & 1023;
  const float* pp = PE + (size_t)(d * 2 + b) * NCH * 1024 + ch; const float* ep = pp + (size_t)2 * 2 * NCH * 1024;
  float* hp = HIN + (size_t)(d * 2 + b) * NCH * 1024 + ch;
  float H = 0.f;
#pragma unroll 1
  for (int s0 = 0; s0 < NCH; s0 += 32) {
    float pv[32], ev[32];
#pragma unroll
    for (int k = 0; k < 32; ++k) { const int s = s0 + k; const int ci = d == 0 ? s : (s < 32 ? 31 - s : 575 - s); pv[k] = pp[(size_t)ci * 1024]; ev[k] = ep[(size_t)ci * 1024]; }
#pragma unroll
    for (int k = 0; k < 32; ++k) { const int s = s0 + k; const int ci = d == 0 ? s : (s < 32 ? 31 - s : 575 - s); hp[(size_t)ci * 1024] = H; H = __expf(pv[k]) * H + ev[k]; }
  }
}
__device__ __forceinline__ void phase_scan3(PK pk, const int bid, const int nb) { const int tid_l = launder_v((int)threadIdx.x);
  const bf16_t* __restrict__ LAB = (const bf16_t*)(pk->ws + OFF_LAB); const float* __restrict__ HIN = (const float*)(pk->ws + OFF_HIN);
  const bf16_t* __restrict__ G = (const bf16_t*)(pk->ws + OFF_G); bf16_t* MIX = (bf16_t*)(pk->ws + OFF_MIXO);
  const int ch = (tid_l & 127) * 8;
  for (int it = bid * 4 + (tid_l >> 7); it < 1024  ; it += nb * 4) {
    int b, ci, row0, len; scan_item(it, b, ci, row0, len);
    { const bf16_t* LA = LAB + ch; const bf16_t* __restrict__ BB = LAB + (size_t)MR * D + ch;
      const float* hp = HIN + ((size_t)(0 * 2 + b) * NCH + ci) * 1024 + ch;
      const f32x4 h0 = *(const f32x4*)(hp), h1 = *(const f32x4*)(hp + 4);
      float H[8] = {h0[0], h0[1], h0[2], h0[3], h1[0], h1[1], h1[2], h1[3]};
#pragma unroll 1
      for (int t0 = 0; t0 < len; t0 += 8) {
        u32x4 lw[8], bw[8];
#pragma unroll
        for (int k = 0; k < 8; ++k) { const int r = row0 + t0 + k; lw[k] = *(const u32x4*)(LA + (size_t)r * D); bw[k] = *(const u32x4*)(BB + (size_t)r * D); }
#pragma unroll
        for (int k = 0; k < 8; ++k) { const int r = row0 + t0 + k;
          SCAN_STEP(H, lw[k], bw[k]);
          u32x4 o; o.x = cvt_pk_bf16(H[0], H[1]); o.y = cvt_pk_bf16(H[2], H[3]); o.z = cvt_pk_bf16(H[4], H[5]); o.w = cvt_pk_bf16(H[6], H[7]);
          *(u32x4*)(MIX + (size_t)r * D + ch) = o; }
      } }
    { const bf16_t* __restrict__ LA = LAB + (size_t)2 * MR * D + ch; const bf16_t* __restrict__ BB = LAB + (size_t)3 * MR * D + ch;
      const float* hp = HIN + ((size_t)(1 * 2 + b) * NCH + ci) * 1024 + ch;
      const f32x4 h0 = *(const f32x4*)(hp), h1 = *(const f32x4*)(hp + 4);
      float H[8] = {h0[0], h0[1], h0[2], h0[3], h1[0], h1[1], h1[2], h1[3]};
#pragma unroll 1
      for (int t0 = 0; t0 < len; t0 += 8) {
        u32x4 lw[8], bw[8], hfw[8], gw[8];
#pragma unroll
        for (int k = 0; k < 8; ++k) { const int r = row0 + len - 1 - t0 - k; lw[k] = *(const u32x4*)(LA + (size_t)r * D); bw[k] = *(const u32x4*)(BB + (size_t)r * D);
          hfw[k] = *(const u32x4*)(MIX + (size_t)r * D + ch); gw[k] = *(const u32x4*)(G + (size_t)r * D + ch); }
#pragma unroll
        for (int k = 0; k < 8; ++k) { const int r = row0 + len - 1 - t0 - k;
          SCAN_STEP(H, lw[k], bw[k]);
          const u32x4 hf = hfw[k], gg = gw[k];
          u32x4 o;
          o.x = cvt_pk_bf16((bflo(hf.x) + H[0]) * bflo(gg.x), (bfhi(hf.x) + H[1]) * bfhi(gg.x));
          o.y = cvt_pk_bf16((bflo(hf.y) + H[2]) * bflo(gg.y), (bfhi(hf.y) + H[3]) * bfhi(gg.y));
          o.z = cvt_pk_bf16((bflo(hf.z) + H[4]) * bflo(gg.z), (bfhi(hf.z) + H[5]) * bfhi(gg.z));
          o.w = cvt_pk_bf16((bflo(hf.w) + H[6]) * bflo(gg.w), (bfhi(hf.w) + H[7]) * bfhi(gg.w));
          *(u32x4*)(MIX + (size_t)r * D + ch) = o; }
      } }
  }
}

#define XB_TMO      128
#define XB_XCNT(j)  (256  + 64 * (j))
#define XB_XSUB(j)  (1280 + 64 * (j))
#define XB_XGEN(j)  (2304 + 64 * (j))
#define XB_TOP      3328
#define XB_TOPGEN   3392
#define XCD_BAR_WORDS 3456
#define XB_SPIN_CAP (1u << 22)
__device__ __forceinline__ unsigned xb_ld(unsigned* p)              { return __hip_atomic_load(p, __ATOMIC_RELAXED, __HIP_MEMORY_SCOPE_AGENT); }
__device__ __forceinline__ unsigned xb_add(unsigned* p, unsigned v) { return __hip_atomic_fetch_add(p, v, __ATOMIC_RELAXED, __HIP_MEMORY_SCOPE_AGENT); }
__device__ __forceinline__ unsigned xb_xcc_id() { return (unsigned)__builtin_amdgcn_s_getreg((3 << 11) | 20) & 0xFu; }
#define XB_SPIN(cond, bar) do { unsigned _sp = 0; while (cond) { __builtin_amdgcn_s_sleep(1); \
    if ((++_sp & 255u) == 0u) { if (xb_ld(&(bar)[XB_TMO])) break; if (_sp > XB_SPIN_CAP) { atomicAdd(&(bar)[XB_TMO], 1u); break; } } } } while (0)
__device__ __forceinline__ void xcd_barrier_complete(unsigned* bar, unsigned x, unsigned& nloc, unsigned& nx) {
    const unsigned G = gridDim.x * gridDim.y * gridDim.z;
    unsigned sum, cnt, mine, sp = 0u;
    for (;;) {
        sum = 0u; cnt = 0u; mine = 0u;
#pragma unroll
        for (unsigned j = 0; j < 16; ++j) { const unsigned c = xb_ld(&bar[XB_XCNT(j)]); sum += c; cnt += (c > 0u) ? 1u : 0u; mine = (j == x) ? c : mine; }
        if (sum == G) break;
        __builtin_amdgcn_s_sleep(1);
        if ((++sp & 255u) == 0u) { if (xb_ld(&bar[XB_TMO])) break; if (sp > XB_SPIN_CAP) { atomicAdd(&bar[XB_TMO], 1u); break; } }
    }
    nloc = mine > 0u ? mine : 1u; nx = cnt > 0u ? cnt : 1u;
}
__device__ __forceinline__ void xcd_barrier(LAS unsigned char* lds) {
    asm volatile("s_waitcnt vmcnt(0)" ::: "memory");
    __syncthreads();
    if (threadIdx.x == 0) {
        PK pk_ = get_pk(); unsigned* bar = (unsigned*)(pk_->ws + OFF_BAR);
        volatile LAS unsigned* st = (volatile LAS unsigned*)(lds + 131072);
        const unsigned x = xb_xcc_id();
        __builtin_amdgcn_s_waitcnt(0);
        unsigned nloc = st[0], nx = st[1];
        if (nloc == 0u) { xcd_barrier_complete(bar, x, nloc, nx); st[0] = nloc; st[1] = nx; }
        const unsigned old = xb_add(&bar[XB_XSUB(x)], 1u);
        const unsigned gen = old / nloc;
        if (old + 1u == (gen + 1u) * nloc) {
            __builtin_amdgcn_fence(__ATOMIC_RELEASE, "agent");
            asm volatile("s_waitcnt vmcnt(0)" ::: "memory");
            const unsigned og = xb_add(&bar[XB_TOP], 1u);
            const unsigned tg = og / nx;
            if (og + 1u == (tg + 1u) * nx) xb_add(&bar[XB_TOPGEN], 1u);
            else XB_SPIN(xb_ld(&bar[XB_TOPGEN]) == tg, bar);
            __builtin_amdgcn_fence(__ATOMIC_ACQUIRE, "agent");
            xb_add(&bar[XB_XGEN(x)], 1u);
            asm volatile("s_waitcnt vmcnt(0)" ::: "memory");
        } else {
            XB_SPIN(xb_ld(&bar[XB_XGEN(x)]) == gen, bar);
            __builtin_amdgcn_fence(__ATOMIC_ACQUIRE, "agent");
            asm volatile("s_waitcnt vmcnt(0)" ::: "memory");
        }
    }
    __syncthreads();
}

#define PHASE_VARS PK pk = get_pk(); const int bid = launder_i(cid), G = launder_i((int)gridDim.x); unsigned char* ws = pk->ws; (void)ws; (void)bid; (void)G
__global__ void __launch_bounds__(512, 2) fwd_mega(Params p_unused) {
  extern __shared__ __attribute__((aligned(16))) unsigned char shm[];
  LAS unsigned char* lds = (LAS unsigned char*)shm;
  cg::grid_group grid = cg::this_grid();
  int cid;
  { PK pk_ = get_pk(); unsigned* cnt = (unsigned*)(pk_->ws + OFF_CNT);
    if (threadIdx.x == 0) { const unsigned x = xb_xcc_id(); const unsigned slot = atomicAdd(cnt + (x & 7u), 1u); *(LAS int*)lds = (int)((slot & 31u) * 8u + (x & 7u));
      ((volatile LAS unsigned*)(lds + 131072))[0] = 0u; ((volatile LAS unsigned*)(lds + 131072))[1] = 0u;
      (void)xb_add((unsigned*)(pk_->ws + OFF_BAR) + XB_XCNT(x), 1u); }
    __syncthreads(); cid = __builtin_amdgcn_readfirstlane(*(LAS int*)lds); __syncthreads(); }

  { PHASE_VARS; prologue(pk, lds, bid, G); }
  grid.sync();
  { PHASE_VARS; prologue2(pk, bid, G); }
  xcd_barrier(lds);
#pragma unroll 1
  for (int l = 0; l < 2; ++l) {
#pragma unroll 1
    for (int s3 = 0; s3 < 3; ++s3) {
      const bool first = (l == 0 && s3 == 0);
      const bool lastp = (l == 1 && s3 == 2);
      const int q = l * 3 + s3, rb = q & 1;
      { PHASE_VARS;
        phase_prep(pk->in[I_X], (float*)(ws + OFF_CTXR), (const float*)(ws + OFF_GS) + (size_t)q * 3072, (bf16_t*)(ws + OFF_H), (float*)(ws + OFF_RS) + (size_t)rb * MR, first ? 0 : (lastp ? MR : MX),
                   (const float*)(ws + (s3 == 2 ? OFF_BIG : OFF_EXTRA)), first ? 0 : (s3 == 2 ? 4 : 11), (const float*)(ws + OFF_RSP), !first, bid, G); }
      xcd_barrier(lds);
      if (s3 != 1) {
        const int f = s3 >> 1, j = l * 2 + f;
        { PHASE_VARS;
          pg8::Gemm g{(const bf16_t*)(ws + OFF_H), (const bf16_t*)(ws + OFF_W1 + j * SZ_W1), MR, 2 * FF, D, D, 0, 0};
          pg8::StaticOrder S; S.init(lastp ? MX : g.M, g.N, g.K, G, bid);
          EpiSwiglu e{(bf16_t*)(ws + OFF_BIG), (const float*)(ws + OFF_RS) + (size_t)rb * MR, (const float*)(ws + OFF_BIASF) + (size_t)j * 3 * 5632};
          pg8::gemm_phase(lds, g, S, e); }
        xcd_barrier(lds);
        { PHASE_VARS;
          pg8::Gemm g{(const bf16_t*)(ws + OFF_BIG), (const bf16_t*)(ws + OFF_W2 + j * SZ_W2), MR, D, FF, FF, 0, 1};
          pg8::StaticOrder S; if (lastp) S.init(MX, g.N, g.K, G, bid); else S.init_split(g.N, g.K, G, bid, 11);
          if (first) { EpiResid<true, true> e{pk->in[I_X], (bf16_t*)pk->out, ws, q}; pg8::gemm_phase(lds, g, S, e); }
          else { EpiResid<false, true> e{pk->in[I_X], (bf16_t*)pk->out, ws, q}; pg8::gemm_phase(lds, g, S, e); } }
        xcd_barrier(lds);
      } else if (l == 0) {
        { PHASE_VARS;
          pg8::Gemm g{(const bf16_t*)(ws + OFF_H), (const bf16_t*)(ws + OFF_EVIN), MR, EVIN_N, D, D, 0, 0};
          pg8::StaticOrder S; S.init(g.M, g.N, g.K, G, bid);
          EpiEvenIn e{(bf16_t*)(ws + OFF_UZ), (bf16_t*)(ws + OFF_Q), (bf16_t*)(ws + OFF_K), (bf16_t*)(ws + OFF_V), (const float*)(ws + OFF_ROPE), (const float*)(ws + OFF_ROPE) + 4096,
                      (const float*)(ws + OFF_RS) + (size_t)rb * MR, (const float*)(ws + OFF_BIASE)};
          pg8::gemm_phase(lds, g, S, e); }
        xcd_barrier(lds);
        { PHASE_VARS;
          for (int u = bid; u < 520 + 1040; u += G) { if (u < 520) attn_unit(pk, u, lds); else gate_unit(pk, u - 520, lds); } }
        xcd_barrier(lds);
        { PHASE_VARS;
          pg8::Gemm g{(const bf16_t*)(ws + OFF_MIXE), (const bf16_t*)(ws + OFF_EVOUT), MR, D, D, D, 0, 0};
          pg8::StaticOrder S; S.init_split(g.N, g.K, G, bid, 4);
          EpiResid<false, false> e{pk->in[I_X], (bf16_t*)pk->out, ws, q};
          pg8::gemm_phase(lds, g, S, e); }
        xcd_barrier(lds);
      } else {
        { PHASE_VARS;
          pg8::Gemm g{(const bf16_t*)(ws + OFF_H), (const bf16_t*)(ws + OFF_ODIN), MR, 2048, D, D, 0, 0};
          pg8::StaticOrder S; S.init(g.M, g.N, g.K, G, bid);
          EpiOddIn e{(bf16_t*)(ws + OFF_G), (bf16_t*)(ws + OFF_XX), (const float*)(ws + OFF_RS) + (size_t)rb * MR, (const float*)(ws + OFF_BIASO)};
          pg8::gemm_phase(lds, g, S, e); }
        xcd_barrier(lds);
        { PHASE_VARS; phase_conv(pk, bid, G); }
        xcd_barrier(lds);
        { PHASE_VARS;
          pg8::Gemm g{(const bf16_t*)(ws + OFF_XC), (const bf16_t*)(ws + OFF_RGW), MR, 4096, 256, D, 1, 0};
          pg8::StaticOrder S; S.init(g.M, g.N, g.K, G, bid);
          EpiRG e{(const bf16_t*)(ws + OFF_XC), (bf16_t*)(ws + OFF_LAB), pk->in[I_RGBA], pk->in[I_RGBX], (const float*)(ws + OFF_SP)};
          pg8::gemm_phase(lds, g, S, e); }
        xcd_barrier(lds);
        { PHASE_VARS; phase_scan1(pk, bid, G); }
        xcd_barrier(lds);
        { PHASE_VARS; phase_scan2(pk, bid, G); }
        xcd_barrier(lds);
        { PHASE_VARS; phase_scan3(pk, bid, G); }
        xcd_barrier(lds);
        { PHASE_VARS;
          pg8::Gemm g{(const bf16_t*)(ws + OFF_MIXO), (const bf16_t*)(ws + OFF_ODOUT), MR, D, D, D, 0, 0};
          pg8::StaticOrder S; S.init(MX, g.N, g.K, G, bid);
          EpiResid<false, false> e{pk->in[I_X], (bf16_t*)pk->out, ws, q};
          pg8::gemm_phase(lds, g, S, e); }
        xcd_barrier(lds);
      }
    }
  }
  { PHASE_VARS; phase_final_norm(pk->out, (const bf16_t*)(ws + OFF_H), pk->in[I_FNG], bid, G); }
}

extern "C" void kernel_launch(void* const* d_in, const int* in_sizes, int n_in, void* d_out, int out_size,
                              void* d_ws, size_t ws_size, hipStream_t stream) {
  static int grid_blocks = 0;
  if (!grid_blocks) {
    int dev = 0, cus = 0, per_cu = 0;
    (void)hipGetDevice(&dev);
    (void)hipDeviceGetAttribute(&cus, hipDeviceAttributeMultiprocessorCount, dev);
    (void)hipFuncSetAttribute((const void*)fwd_mega, hipFuncAttributeMaxDynamicSharedMemorySize, LDS_BYTES);
    (void)hipOccupancyMaxActiveBlocksPerMultiprocessor(&per_cu, (const void*)fwd_mega, 512, LDS_BYTES);
    (void)hipGetLastError();
    grid_blocks = cus > 0 ? cus : 256;
    if (ws_size < WS_NEED2 || n_in != 26) { fprintf(stderr, "kernel_launch: ws_size %zu < %zu or n_in %d != 26\n", ws_size, (size_t)WS_NEED, n_in); grid_blocks = -1; }
  }
  if (grid_blocks < 0) return;
  Params p{};
  for (int i = 0; i < 26; ++i) p.in[i] = (const float*)d_in[i];
  p.out = (float*)d_out; p.ws = (unsigned char*)d_ws;
  (void)hipMemsetAsync((unsigned char*)d_ws + OFF_CNT, 0, 256 + 3456 * 4, stream);
  void* args[] = {&p};
  hipError_t e = hipLaunchCooperativeKernel((const void*)fwd_mega, dim3(grid_blocks), dim3(512), args, LDS_BYTES, stream);
  if (e != hipSuccess) fprintf(stderr, "cooperative launch failed: %s (grid %d)\n", hipGetErrorString(e), grid_blocks);
}
```

```cpp
#include <hip/hip_runtime.h>
#include <hip/hip_cooperative_groups.h>
#include <cstdio>
namespace cg = cooperative_groups;

#define LAS __attribute__((address_space(3)))
typedef unsigned short bf16_t;
typedef short bf16x8 __attribute__((ext_vector_type(8)));
typedef short bf16x4 __attribute__((ext_vector_type(4)));
typedef float f32x4 __attribute__((ext_vector_type(4)));
typedef unsigned u32x2 __attribute__((ext_vector_type(2)));
typedef unsigned u32x4 __attribute__((ext_vector_type(4)));

constexpr int D = 1024, FF = 2816, SEQ = 16384, MX = 32768, MC = 512, MR = MX + MC, CTXL = 256;
constexpr int NMOD = 9216;
constexpr int EVIN_N = 1792;
constexpr int LDS_BYTES = 131072 + 64;
constexpr int NCH = 544;

constexpr size_t SZ_W1 = (size_t)2 * FF * D * 2;
constexpr size_t SZ_W2 = (size_t)D * FF * 2;
constexpr size_t OFF_W1 = 0;
constexpr size_t OFF_W2 = OFF_W1 + 4 * SZ_W1;
constexpr size_t OFF_EVIN = OFF_W2 + 4 * SZ_W2;
constexpr size_t OFF_EVOUT = OFF_EVIN + (size_t)EVIN_N * D * 2;
constexpr size_t OFF_ODIN = OFF_EVOUT + (size_t)D * D * 2;
constexpr size_t OFF_ODOUT = OFF_ODIN + (size_t)2048 * D * 2;
constexpr size_t OFF_RGW = OFF_ODOUT + (size_t)D * D * 2;
constexpr size_t OFF_GMWS = OFF_RGW + (size_t)4096 * 256 * 2;
constexpr size_t OFF_MOD = OFF_GMWS + (size_t)4 * 128 * 128 * 2;
constexpr size_t OFF_ROPE = OFF_MOD + (size_t)2 * 3 * NMOD * 4;
constexpr size_t OFF_SP = OFF_ROPE + (size_t)256 * 16 * 2 * 4;
constexpr size_t OFF_GS = OFF_SP + (size_t)2 * 1024 * 4;
constexpr size_t OFF_BIASF = OFF_GS + (size_t)2 * 3 * 3 * 1024 * 4;
constexpr size_t OFF_BIASE = OFF_BIASF + (size_t)4 * 3 * 5632 * 4;
constexpr size_t OFF_BIASO = OFF_BIASE + (size_t)3 * 1792 * 4;
constexpr size_t OFF_RS = OFF_BIASO + (size_t)3 * 2048 * 4;
constexpr size_t OFF_CNT = OFF_RS + (size_t)2 * MR * 4;
constexpr size_t OFF_BAR = OFF_CNT + 256;
constexpr size_t OFF_CTXR = OFF_BAR + 3456 * 4;
constexpr size_t OFF_PE = OFF_CTXR + (size_t)MC * D * 4;
constexpr size_t SZ_CARRY = (size_t)2 * 2 * NCH * 1024 * 4;
constexpr size_t OFF_HIN = OFF_PE + 2 * SZ_CARRY;
constexpr size_t OFF_H = OFF_HIN + SZ_CARRY;
constexpr size_t SZ_ROWS = (size_t)MR * D * 2;
constexpr size_t OFF_BIG = OFF_H + SZ_ROWS;
constexpr size_t SZ_ACT = (size_t)MR * FF * 2;
constexpr size_t OFF_EXTRA = OFF_BIG + SZ_ACT;
constexpr size_t OFF_UZ = OFF_BIG;
constexpr size_t OFF_Q = OFF_UZ + SZ_ROWS;
constexpr size_t OFF_K = OFF_Q + SZ_ROWS / 2;
constexpr size_t OFF_V = OFF_K + SZ_ROWS / 8;
constexpr size_t OFF_MIXE = OFF_EXTRA;
constexpr size_t OFF_G = OFF_BIG;
constexpr size_t OFF_XX = OFF_G + SZ_ROWS;
constexpr size_t OFF_XC = OFF_H;
constexpr size_t OFF_LAB = OFF_XX;
constexpr size_t OFF_MIXO = OFF_LAB;
constexpr size_t WS_NEED = OFF_LAB + 4 * SZ_ROWS;
constexpr size_t OFF_RSP = OFF_LAB + 4 * SZ_ROWS;
constexpr size_t WS_NEED2 = OFF_RSP + (size_t)MR * 16 * 4;
static_assert(OFF_MIXE + SZ_ROWS <= WS_NEED, "ws");
static_assert(WS_NEED2 <= (size_t)536870912, "workspace budget 2");
static_assert(WS_NEED <= (size_t)536870912, "workspace budget");

struct Params { const float* in[26]; float* out; unsigned char* ws; };
typedef const Params __attribute__((address_space(4))) * PK;
__device__ __forceinline__ PK get_pk() { PK pk = (PK)__builtin_amdgcn_kernarg_segment_ptr(); asm volatile("" : "+s"(pk)); return pk; }
__device__ __forceinline__ int launder_i(int v) { asm volatile("" : "+s"(v)); return v; }
__device__ __forceinline__ float launder_f(float v) { asm volatile("" : "+s"(v)); return v; }
__device__ __forceinline__ int launder_v(int v) { asm volatile("" : "+v"(v)); return v; }
#define TID_X tid_l
enum { I_X = 0, I_C, I_CTX, I_CCTX, I_ADAW, I_ADAB, I_NORMG, I_WG, I_WU, I_WD, I_EVIN, I_EVOUT, I_GMG, I_GMWS, I_GMBS, I_SINK,
       I_ODIN, I_ODOUT, I_CONVW, I_CONVB, I_RGWA, I_RGBA, I_RGWX, I_RGBX, I_LAM, I_FNG };

__device__ __forceinline__ unsigned cvt_pk_bf16(float lo, float hi) { unsigned r; asm volatile("v_cvt_pk_bf16_f32 %0, %1, %2" : "=v"(r) : "v"(lo), "v"(hi)); return r; }
__device__ __forceinline__ bf16_t f2bf(float f) { return (bf16_t)(cvt_pk_bf16(f, 0.f) & 0xffffu); }
__device__ __forceinline__ float bf2f(bf16_t b) { return __uint_as_float(((unsigned)b) << 16); }
__device__ __forceinline__ float bflo(unsigned w) { return __uint_as_float(w << 16); }
__device__ __forceinline__ float bfhi(unsigned w) { return __uint_as_float(w & 0xffff0000u); }
__device__ __forceinline__ u32x2 pack4(f32x4 v) { u32x2 r; r.x = cvt_pk_bf16(v[0], v[1]); r.y = cvt_pk_bf16(v[2], v[3]); return r; }
__device__ __forceinline__ f32x4 unpack4(u32x2 w) { f32x4 r; r[0] = bflo(w.x); r[1] = bfhi(w.x); r[2] = bflo(w.y); r[3] = bfhi(w.y); return r; }
__device__ __forceinline__ float fast_sigmoid(float x) { return __fdividef(1.0f, 1.0f + __expf(-x)); }
__device__ __forceinline__ float gelu_tanh(float x) { const float t = 1.5957691216f * (x + 0.044715f * x * x * x); return x * fast_sigmoid(t); }
__device__ __forceinline__ float shx(float v, int o, int lane) { return __int_as_float(__builtin_amdgcn_ds_bpermute((lane ^ o) << 2, __float_as_int(v))); }
__device__ __forceinline__ float wave_sum(float v, int lane) {
#pragma unroll
  for (int o = 32; o >= 1; o >>= 1) v += shx(v, o, lane);
  return v;
}

namespace pg8 {
constexpr int BM = 256, BK = 64, HALF = 128, HTB = HALF * BK * 2, NXCD = 8, WGM = 8;
__device__ __forceinline__ int lds_byte(int r, int c) { const int st = (r >> 4) * 2 + (c >> 5), rr = r & 15, cc = c & 31, ob = rr * 64 + cc * 2; return st * 1024 + (ob ^ (((ob >> 9) & 1) << 5)); }
__device__ __forceinline__ void stage_rc(int b, int& R, int& C) { const int st = b / 1024, sb = b % 1024, swz = sb ^ (((sb >> 9) & 1) << 5); R = (st >> 1) * 16 + swz / 64; C = (st & 1) * 32 + (swz % 64) / 2; }
__device__ __forceinline__ int perm32(int rho) { const int n = rho >> 4, i = rho & 15; return 8 * (i >> 2) + 4 * n + (i & 3); }
struct Unit { int pm, pn, k0, nk; };
struct Gemm { const bf16_t* A; const bf16_t* Bt; int M, N, K, lda; int bd; int ablk; };
struct StaticOrder {
  int nM, nN, nwg, G, c, ntfull, nslice, nkslice;
  __device__ void init(int M, int N, int K, int G_, int c_) { nM = M / BM; nN = N / BM; nwg = nM * nN; G = G_; c = c_; ntfull = K / BK; nslice = 0; nkslice = 0; }
  __device__ void init_split(int N, int K, int G_, int c_, int S) { nM = 128; nN = N / BM; nwg = nM * nN; G = G_; c = c_; ntfull = K / BK; nslice = S; nkslice = ntfull / S; }
  __device__ bool next(int i, Unit& u) const {
    const long L = (long)i * G + c;
    if (L >= nwg) {
      const int e = (int)(L - nwg);
      if (e >= 2 * nN * nslice) return false;
      const int sl = e % nslice, tl = e / nslice;
      u.pm = 128 + tl / nN; u.pn = tl % nN; u.k0 = sl * nkslice; u.nk = nkslice; return true;
    }
    int wgid = (int)L; { const int q = nwg / NXCD, r = nwg % NXCD, xcd = wgid % NXCD, off = wgid / NXCD; wgid = (xcd < r ? xcd * (q + 1) : r * (q + 1) + (xcd - r) * q) + off; }
    const int nig = WGM * nN, gid = wgid / nig, fm = gid * WGM, gsz = (nM - fm) < WGM ? (nM - fm) : WGM;
    u.pm = fm + ((wgid % nig) % gsz); u.pn = (wgid % nig) / gsz; u.k0 = 0; u.nk = ntfull; return true;
  }
};

template <class Epi>
__device__ __forceinline__ void gemm_phase(LAS unsigned char* lds, const Gemm g, const StaticOrder& S, const Epi& E) { const int tid_l = launder_v((int)threadIdx.x);
  const int tid = tid_l, wid = __builtin_amdgcn_readfirstlane(tid >> 6), lane = tid & 63, wr = wid >> 2, wc = wid & 3, fr = lane & 15, fq = lane >> 4;
  const int K = g.K;
  unsigned voffA[2], voffB[2];
#pragma unroll
  for (int i = 0; i < 2; ++i) { int R, C; stage_rc(tid * 16 + i * 8192, R, C); const int Rb = Epi::PERM ? ((R & ~31) + perm32(R & 31)) : R;
    voffA[i] = (unsigned)(R * (g.ablk ? 64 : g.lda) + C) * 2u; voffB[i] = (unsigned)(Rb * K + C) * 2u; }
  const size_t kstep = (size_t)(BK * 2), kstepA = g.ablk ? (size_t)32768 : kstep;
  const size_t hstepA = g.ablk ? (size_t)16384 : (size_t)HALF * g.lda * 2, hstepB = (size_t)HALF * K * 2;
  const size_t tstepA = g.ablk ? (size_t)(K / BK) * 32768 : 2 * hstepA, tstepB = 2 * hstepB;
  const unsigned ldsw = (unsigned)wid * 1024u;
  const int aoff = lds_byte(wr * 64 + fr, fq * 8), boff = lds_byte(wc * 32 + fr, fq * 8);
#define PG8_SA(b, h) (((b) * 2 + (h)) * HTB)
#define PG8_SB(b, h) ((4 + (b) * 2 + (h)) * HTB)
#define PG8_STAGE(bufoff, gbase, voff) do { _Pragma("unroll") for (int _i = 0; _i < 2; ++_i) \
        __builtin_amdgcn_global_load_lds((const unsigned*)((const char*)(gbase) + (voff)[_i]), (LAS unsigned*)(lds + (bufoff) + ldsw + _i * 8192), 16, 0, 0); } while (0)
#define PG8_LDA(dst, b, h) do { _Pragma("unroll") for (int m = 0; m < 4; ++m) _Pragma("unroll") for (int k = 0; k < 2; ++k) dst[m][k] = *(const LAS bf16x8*)(lds + PG8_SA(b, h) + aoff + m * 2048 + k * 1024); } while (0)
#define PG8_LDB(dst, b, h) do { _Pragma("unroll") for (int n = 0; n < 2; ++n) _Pragma("unroll") for (int k = 0; k < 2; ++k) dst[n][k] = *(const LAS bf16x8*)(lds + PG8_SB(b, h) + boff + n * 2048 + k * 1024); } while (0)
#define PG8_MMA(ai, bj, At, Bt) do { __builtin_amdgcn_s_setprio(1); _Pragma("unroll") for (int m = 0; m < 4; ++m) _Pragma("unroll") for (int n = 0; n < 2; ++n) _Pragma("unroll") for (int k = 0; k < 2; ++k) \
        acc[ai][bj][m][n] = __builtin_amdgcn_mfma_f32_16x16x32_bf16(Bt[n][k], At[m][k], acc[ai][bj][m][n], 0, 0, 0); __builtin_amdgcn_s_setprio(0); } while (0)
#define PG8_WAIT_V(n) asm volatile("s_waitcnt vmcnt(" #n ")" ::: "memory")
#define PG8_WAIT_L(n) asm volatile("s_waitcnt lgkmcnt(" #n ")" ::: "memory")
#define PG8_BAR __builtin_amdgcn_s_barrier()
#define PG8_SCHED __builtin_amdgcn_sched_barrier(0)
#define PG8_ABASE(u) ((const char*)g.A + (size_t)(u).pm * tstepA + (size_t)(u).k0 * kstepA + (g.bd ? (size_t)((((u).pn >> 1) & 3) * 512) : (size_t)0))
#define PG8_BBASE(u) ((const char*)g.Bt + (size_t)(u).pn * tstepB + (size_t)(u).k0 * kstep)
  Unit cur, nxt; int ui = 0;
  if (!S.next(0, cur)) return;
  f32x4 acc[2][2][4][2];
#pragma unroll
  for (int a = 0; a < 2; ++a)
#pragma unroll
    for (int b = 0; b < 2; ++b)
#pragma unroll
      for (int m = 0; m < 4; ++m)
#pragma unroll
        for (int n = 0; n < 2; ++n) acc[a][b][m][n] = (f32x4){0.f, 0.f, 0.f, 0.f};
  bf16x8 At[4][2], B0[2][2], B1[2][2];
  const char* cA = PG8_ABASE(cur); const char* cB = PG8_BBASE(cur);
  PG8_STAGE(PG8_SB(0, 0), cB, voffB); PG8_STAGE(PG8_SA(0, 0), cA, voffA); PG8_STAGE(PG8_SB(0, 1), cB + hstepB, voffB); PG8_STAGE(PG8_SA(0, 1), cA + hstepA, voffA);
  if (wr == 1) PG8_BAR;
  PG8_WAIT_V(4); PG8_BAR;
  PG8_STAGE(PG8_SB(1, 0), cB + kstep, voffB); PG8_STAGE(PG8_SA(1, 0), cA + kstepA, voffA); PG8_STAGE(PG8_SB(1, 1), cB + hstepB + kstep, voffB);
  PG8_WAIT_V(6); PG8_BAR;
  for (;;) {
    const bool has_next = S.next(ui + 1, nxt);
    const char* nA = has_next ? PG8_ABASE(nxt) : cA; const char* nB = has_next ? PG8_BBASE(nxt) : cB;
    const int nt = cur.nk;
#pragma unroll 1
    for (int t = 0; t < nt; t += 2) {
      const bool last = (t == nt - 2);
      const char* a1 = cA + (size_t)(t + 1) * kstepA;
      const char* a2 = last ? nA : cA + (size_t)(t + 2) * kstepA; const char* b2 = last ? nB : cB + (size_t)(t + 2) * kstep;
      const char* a3 = a2 + kstepA; const char* b3 = b2 + kstep;
      PG8_LDB(B0, 0, 0); PG8_SCHED; PG8_LDA(At, 0, 0); PG8_STAGE(PG8_SA(1, 1), a1 + hstepA, voffA);
      PG8_WAIT_L(8); PG8_BAR; PG8_WAIT_L(0); PG8_MMA(0, 0, At, B0); PG8_BAR; PG8_SCHED;
      PG8_LDB(B1, 0, 1); PG8_STAGE(PG8_SB(0, 0), b2, voffB);
      PG8_BAR; PG8_WAIT_L(0); PG8_MMA(0, 1, At, B1); PG8_BAR;
      PG8_LDA(At, 0, 1); PG8_STAGE(PG8_SA(0, 0), a2, voffA);
      PG8_BAR; PG8_WAIT_L(0); PG8_MMA(1, 0, At, B0); PG8_BAR; PG8_SCHED;
      PG8_STAGE(PG8_SB(0, 1), b2 + hstepB, voffB);
      PG8_WAIT_V(6); PG8_BAR; PG8_MMA(1, 1, At, B1); PG8_BAR;
      PG8_LDB(B0, 1, 0); PG8_SCHED; PG8_LDA(At, 1, 0); PG8_STAGE(PG8_SA(0, 1), a2 + hstepA, voffA);
      PG8_WAIT_L(8); PG8_BAR; PG8_WAIT_L(0); PG8_MMA(0, 0, At, B0); PG8_BAR; PG8_SCHED;
      PG8_LDB(B1, 1, 1); PG8_STAGE(PG8_SB(1, 0), b3, voffB);
      PG8_BAR; PG8_WAIT_L(0); PG8_MMA(0, 1, At, B1); PG8_BAR;
      PG8_LDA(At, 1, 1); PG8_STAGE(PG8_SA(1, 0), a3, voffA);
      PG8_BAR; PG8_WAIT_L(0); PG8_MMA(1, 0, At, B0); PG8_BAR; PG8_SCHED;
      PG8_STAGE(PG8_SB(1, 1), b3 + hstepB, voffB);
      PG8_WAIT_V(6); PG8_BAR; PG8_MMA(1, 1, At, B1); PG8_BAR;
    }
    E(acc, cur, wr, wc, fr, fq);
    if (!has_next) break;
#pragma unroll
    for (int a = 0; a < 2; ++a)
#pragma unroll
      for (int b = 0; b < 2; ++b)
#pragma unroll
        for (int m = 0; m < 4; ++m)
#pragma unroll
          for (int n = 0; n < 2; ++n) acc[a][b][m][n] = (f32x4){0.f, 0.f, 0.f, 0.f};
    cur = nxt; cA = nA; cB = nB; ++ui;
  }
  PG8_WAIT_V(0);
  if (wr == 0) PG8_BAR;
  PG8_BAR;
#undef PG8_SA
#undef PG8_SB
#undef PG8_STAGE
#undef PG8_LDA
#undef PG8_LDB
#undef PG8_MMA
#undef PG8_WAIT_V
#undef PG8_WAIT_L
#undef PG8_BAR
#undef PG8_SCHED
#undef PG8_ABASE
#undef PG8_BBASE
}
}
using pg8::Unit;
typedef f32x4 AccT[2][2][4][2];

struct EpiSwiglu {
  static constexpr bool PERM = true;
  bf16_t* act; const float* rs; const float* bias;
  __device__ __forceinline__ void operator()(const AccT& acc, const Unit& u, int wr, int wc, int fr, int fq) const {
    const int row0 = u.pm * 256 + wr * 64 + fr, col0 = u.pn * 128 + wc * 32 + 8 * fq;
    const int mi = u.pm < 64 ? 0 : (u.pm < 128 ? 1 : 2);
    const float* bp = bias + (size_t)mi * (2 * FF) + u.pn * 256 + wc * 32 + 8 * fq;
    f32x4 bg[2], bu[2]; float rv[2][4];
#pragma unroll
    for (int n = 0; n < 2; ++n) { bg[n] = *(const f32x4*)(bp + n * 4); bu[n] = *(const f32x4*)(bp + 128 + n * 4); }
#pragma unroll
    for (int ai = 0; ai < 2; ++ai)
#pragma unroll
      for (int m = 0; m < 4; ++m) rv[ai][m] = rs[row0 + ai * 128 + m * 16];
#pragma unroll
    for (int ai = 0; ai < 2; ++ai)
#pragma unroll
      for (int m = 0; m < 4; ++m) rv[ai][m] = rsqrtf(rv[ai][m] * (1.0f / 1024.0f) + 1e-6f);
#pragma unroll
    for (int ai = 0; ai < 2; ++ai)
#pragma unroll
      for (int m = 0; m < 4; ++m) {
        const int r = row0 + ai * 128 + m * 16;
        bf16_t* rowp = act + ((size_t)(r >> 8) * (FF / 64) + (col0 >> 6)) * 16384 + (size_t)(r & 255) * 64 + (col0 & 63);
        u32x4 ow;
#pragma unroll
        for (int n = 0; n < 2; ++n) {
          const f32x4 gg = acc[ai][0][m][n] * rv[ai][m] + bg[n], uu = acc[ai][1][m][n] * rv[ai][m] + bu[n]; f32x4 v;
#pragma unroll
          for (int j = 0; j < 4; ++j) v[j] = gg[j] * fast_sigmoid(gg[j]) * uu[j];
          const u32x2 pk2 = pack4(v);
          if (n == 0) { ow.x = pk2.x; ow.y = pk2.y; } else { ow.z = pk2.x; ow.w = pk2.y; }
        }
        *(u32x4*)(rowp) = ow;
      }
  }
};
template <bool SRCF32, bool HALF>
struct EpiResid {
  static constexpr bool PERM = true;
  const float* src_f32; bf16_t* xbuf; unsigned char* wsb; int qi;
  __device__ __forceinline__ void operator()(const AccT& acc, const Unit& u, int wr, int wc, int fr, int fq) const {
    unsigned char* w2 = wsb; asm volatile("" : "+s"(w2));
    const int q = qi, l = q / 3, s3 = q - 3 * l;
    const float* gate = (const float*)(w2 + OFF_MOD) + l * 3 * NMOD + (HALF ? 3 * s3 + 2 : 5) * 1024;
    bf16_t* anext = q < 5 ? (bf16_t*)(w2 + OFF_H) : (bf16_t*)nullptr; const float* gsn = (const float*)(w2 + OFF_GS) + (q + 1) * 3072; float* rsp = (float*)(w2 + OFF_RSP);
    const size_t slab_off = HALF ? OFF_EXTRA : OFF_BIG;
    bf16_t* xdst = q < 5 ? xbuf : (bf16_t*)(w2 + OFF_H);
    const int row0 = u.pm * 256 + wr * 64 + fr, col0 = u.pn * 256 + wc * 32 + 8 * fq;
    const int mi = u.pm < 64 ? 0 : (u.pm < 128 ? 1 : 2);
    const float* gp = gate + (size_t)mi * NMOD + col0;
    f32x4 gv[2][2];
#pragma unroll
    for (int bj = 0; bj < 2; ++bj)
#pragma unroll
      for (int n = 0; n < 2; ++n) gv[bj][n] = *(const f32x4*)(gp + bj * 128 + n * 4) * (HALF ? 0.5f : 1.0f);
    if (u.pm < 128) {
      const size_t e0 = (size_t)row0 * D + col0;
      const float* gsp = gsn + mi * 1024 + col0;
      f32x4 gsv[2][2];
#pragma unroll
      for (int bj = 0; bj < 2; ++bj)
#pragma unroll
        for (int n = 0; n < 2; ++n) gsv[bj][n] = anext ? *(const f32x4*)(gsp + bj * 128 + n * 4) : (f32x4){0.f, 0.f, 0.f, 0.f};
      f32x4 xb[2][2][2];
#define RES_LOAD(dst, eoff) do { _Pragma("unroll") for (int bj = 0; bj < 2; ++bj) { \
          if (SRCF32) { dst[bj][0] = *(const f32x4*)(src_f32 + (eoff) + bj * 128); dst[bj][1] = *(const f32x4*)(src_f32 + (eoff) + bj * 128 + 4); } \
          else { const u32x4 w_ = *(const u32x4*)(xbuf + (eoff) + bj * 128); u32x2 lo_, hi_; lo_.x = w_.x; lo_.y = w_.y; hi_.x = w_.z; hi_.y = w_.w; dst[bj][0] = unpack4(lo_); dst[bj][1] = unpack4(hi_); } } } while (0)
      RES_LOAD(xb[0], e0);
#pragma unroll
      for (int st = 0; st < 8; ++st) {
        const int ai = st >> 2, m = st & 3, cur = st & 1, rr = ai * 128 + m * 16;
        if (st < 7) { const int rn = ((st + 1) >> 2) * 128 + ((st + 1) & 3) * 16; RES_LOAD(xb[cur ^ 1], e0 + (size_t)rn * D); }
        float ss = 0.f;
#pragma unroll
        for (int bj = 0; bj < 2; ++bj) {
          const f32x4 x0 = xb[cur][bj][0] + gv[bj][0] * acc[ai][bj][m][0], x1 = xb[cur][bj][1] + gv[bj][1] * acc[ai][bj][m][1];
          const u32x2 p0 = pack4(x0), p1 = pack4(x1);
          u32x4 ow; ow.x = p0.x; ow.y = p0.y; ow.z = p1.x; ow.w = p1.y;
          *(u32x4*)(xdst + e0 + (size_t)rr * D + bj * 128) = ow;
          if (anext) {
            const u32x2 q0 = pack4(x0 * gsv[bj][0]), q1 = pack4(x1 * gsv[bj][1]);
            u32x4 aw; aw.x = q0.x; aw.y = q0.y; aw.z = q1.x; aw.w = q1.y;
            *(u32x4*)(anext + e0 + (size_t)rr * D + bj * 128) = aw;
            ss += x0[0] * x0[0] + x0[1] * x0[1] + x0[2] * x0[2] + x0[3] * x0[3] + x1[0] * x1[0] + x1[1] * x1[1] + x1[2] * x1[2] + x1[3] * x1[3];
          }
        }
        if (anext) { ss += shx(ss, 16, fr + 16 * fq); ss += shx(ss, 32, fr + 16 * fq); if (fq == 0) rsp[(size_t)(row0 + rr) * 16 + u.pn * 4 + wc] = ss; }
      }
#undef RES_LOAD
    } else {
#pragma unroll
      for (int ai = 0; ai < 2; ++ai)
#pragma unroll
        for (int m = 0; m < 4; ++m) {
          float* d = (float*)(w2 + slab_off) + (size_t)(u.k0 / u.nk) * MC * D + (size_t)(row0 + ai * 128 + m * 16 - MX) * D + col0;
#pragma unroll
          for (int bj = 0; bj < 2; ++bj)
#pragma unroll
            for (int n = 0; n < 2; ++n) *(f32x4*)(d + bj * 128 + n * 4) = gv[bj][n] * acc[ai][bj][m][n];
        }
    }
  }
};
struct EpiEvenIn {
  static constexpr bool PERM = false;
  bf16_t* UZ; bf16_t* Q; bf16_t* Kb; bf16_t* Vb; const float* ropeC; const float* ropeS; const float* rs; const float* bias;
  __device__ __forceinline__ void operator()(const AccT& acc, const Unit& u, int wr, int wc, int fr, int fq) const {
    const int row0 = u.pm * 256 + wr * 64 + fr;
    const int mi = u.pm < 64 ? 0 : (u.pm < 128 ? 1 : 2);
    const float* bp = bias + (size_t)mi * EVIN_N + u.pn * 256 + wc * 32 + 4 * fq;
    f32x4 bv[2][2]; float rv[2][4];
#pragma unroll
    for (int bj = 0; bj < 2; ++bj)
#pragma unroll
      for (int n = 0; n < 2; ++n) bv[bj][n] = *(const f32x4*)(bp + bj * 128 + n * 16);
#pragma unroll
    for (int ai = 0; ai < 2; ++ai)
#pragma unroll
      for (int m = 0; m < 4; ++m) rv[ai][m] = rs[row0 + ai * 128 + m * 16];
#pragma unroll
    for (int ai = 0; ai < 2; ++ai)
#pragma unroll
      for (int m = 0; m < 4; ++m) rv[ai][m] = rsqrtf(rv[ai][m] * (1.0f / 1024.0f) + 1e-6f);
    if (u.pn < 4) {
      const int col0 = u.pn * 256 + wc * 32 + 4 * fq;
#pragma unroll
      for (int ai = 0; ai < 2; ++ai)
#pragma unroll
        for (int m = 0; m < 4; ++m) {
          const int r = row0 + ai * 128 + m * 16;
          bf16_t* rowp = UZ + (size_t)r * D + col0;
#pragma unroll
          for (int bj = 0; bj < 2; ++bj)
#pragma unroll
            for (int n = 0; n < 2; ++n) { f32x4 v = acc[ai][bj][m][n] * rv[ai][m] + bv[bj][n];
#pragma unroll
              for (int j = 0; j < 4; ++j) v[j] = gelu_tanh(v[j]);
              *(u32x2*)(rowp + bj * 128 + n * 16) = pack4(v); }
        }
    } else {
      const bool rope_on = u.pm < 128;
      const bool by_col = (wc & 1) != 0;
      f32x4 csb[2], snb[2];
      { const int pos = row0 & (SEQ - 1); const int pidx = by_col ? (pos & 63) : (pos >> 6);
        csb[0] = *(const f32x4*)(ropeC + pidx * 16 + 4 * fq); snb[0] = *(const f32x4*)(ropeS + pidx * 16 + 4 * fq); }
#pragma unroll
      for (int st = 0; st < 8; ++st) {
        const int ai = st >> 2, m = st & 3, cur = st & 1;
        const int r = row0 + ai * 128 + m * 16;
        if (st < 7) { const int rn = row0 + ((st + 1) >> 2) * 128 + ((st + 1) & 3) * 16; const int pos = rn & (SEQ - 1); const int pidx = by_col ? (pos & 63) : (pos >> 6);
          csb[cur ^ 1] = *(const f32x4*)(ropeC + pidx * 16 + 4 * fq); snb[cur ^ 1] = *(const f32x4*)(ropeS + pidx * 16 + 4 * fq); }
        f32x4 cs = csb[cur], sn = snb[cur];
        if (!rope_on) { cs = (f32x4){1.f, 1.f, 1.f, 1.f}; sn = (f32x4){0.f, 0.f, 0.f, 0.f}; }
#pragma unroll
        for (int bj = 0; bj < 2; ++bj) {
          const f32x4 x1 = acc[ai][bj][m][0] * rv[ai][m] + bv[bj][0], x2 = acc[ai][bj][m][1] * rv[ai][m] + bv[bj][1];
          if (u.pn < 6) {
            const f32x4 o1 = (x1 * cs - x2 * sn) * 0.18033688011112042f, o2 = (x1 * sn + x2 * cs) * 0.18033688011112042f;
            bf16_t* qp = Q + (size_t)r * 512 + (u.pn - 4) * 256 + bj * 128 + wc * 32 + 4 * fq;
            *(u32x2*)(qp) = pack4(o1); *(u32x2*)(qp + 16) = pack4(o2);
          } else if (bj == 0) {
            const f32x4 o1 = x1 * cs - x2 * sn, o2 = x1 * sn + x2 * cs;
            bf16_t* kp = Kb + (size_t)r * 128 + wc * 32 + 4 * fq;
            *(u32x2*)(kp) = pack4(o1); *(u32x2*)(kp + 16) = pack4(o2);
          } else {
            bf16_t* vp = Vb + (size_t)r * 128 + wc * 32 + 4 * fq;
            *(u32x2*)(vp) = pack4(x1); *(u32x2*)(vp + 16) = pack4(x2);
          }
        }
      }
    }
  }
};
struct EpiOddIn {
  static constexpr bool PERM = false;
  bf16_t* G; bf16_t* XX; const float* rs; const float* bias;
  __device__ __forceinline__ void operator()(const AccT& acc, const Unit& u, int wr, int wc, int fr, int fq) const {
    const int row0 = u.pm * 256 + wr * 64 + fr;
    const int mi = u.pm < 64 ? 0 : (u.pm < 128 ? 1 : 2);
    const float* bp = bias + (size_t)mi * 2048 + u.pn * 256 + wc * 32 + 4 * fq;
    f32x4 bv[2][2];
#pragma unroll
    for (int bj = 0; bj < 2; ++bj)
#pragma unroll
      for (int n = 0; n < 2; ++n) bv[bj][n] = *(const f32x4*)(bp + bj * 128 + n * 16);
    float rvv[2][4];
#pragma unroll
    for (int ai = 0; ai < 2; ++ai)
#pragma unroll
      for (int m = 0; m < 4; ++m) rvv[ai][m] = rs[row0 + ai * 128 + m * 16];
#pragma unroll
    for (int ai = 0; ai < 2; ++ai)
#pragma unroll
      for (int m = 0; m < 4; ++m) rvv[ai][m] = rsqrtf(rvv[ai][m] * (1.0f / 1024.0f) + 1e-6f);
    const bool isg = u.pn < 4;
    bf16_t* base = isg ? G : XX;
    const int col0 = (u.pn & 3) * 256 + wc * 32 + 4 * fq;
#pragma unroll
    for (int ai = 0; ai < 2; ++ai)
#pragma unroll
      for (int m = 0; m < 4; ++m) {
        const int r = row0 + ai * 128 + m * 16;
        const float rv = rvv[ai][m];
        bf16_t* rowp = base + (size_t)r * D + col0;
#pragma unroll
        for (int bj = 0; bj < 2; ++bj)
#pragma unroll
          for (int n = 0; n < 2; ++n) { f32x4 v = acc[ai][bj][m][n] * rv + bv[bj][n];
            if (isg) {
#pragma unroll
              for (int j = 0; j < 4; ++j) v[j] = gelu_tanh(v[j]); }
            *(u32x2*)(rowp + bj * 128 + n * 16) = pack4(v); }
      }
  }
};
struct EpiRG {
  static constexpr bool PERM = false;
  const bf16_t* XC; bf16_t* LAB; const float* ba; const float* bx; const float* sp;
  __device__ __forceinline__ void operator()(const AccT& acc, const Unit& u, int wr, int wc, int fr, int fq) const {
    const int row0 = u.pm * 256 + wr * 64 + fr;
    const int d = u.pn >> 3, h = (u.pn >> 1) & 3, cb = u.pn & 1;
    const int ch0 = h * 256 + cb * 128 + wc * 32 + 4 * fq;
    bf16_t* LA = LAB + (size_t)(2 * d) * MR * D; bf16_t* BB = LA + (size_t)MR * D;
    f32x4 bav[2], bxv[2], spv[2]; u32x2 xw[2][2][4];
#pragma unroll
    for (int n = 0; n < 2; ++n) { bav[n] = *(const f32x4*)(ba + d * 1024 + ch0 + n * 16); bxv[n] = *(const f32x4*)(bx + d * 1024 + ch0 + n * 16); spv[n] = *(const f32x4*)(sp + d * 1024 + ch0 + n * 16); }
#pragma unroll
    for (int ai = 0; ai < 2; ++ai)
#pragma unroll
      for (int m = 0; m < 4; ++m) xw[0][ai][m] = *(const u32x2*)(XC + (size_t)(row0 + ai * 128 + m * 16) * D + ch0);
#pragma unroll
    for (int n = 0; n < 2; ++n)
#pragma unroll
      for (int ai = 0; ai < 2; ++ai)
#pragma unroll
        for (int m = 0; m < 4; ++m) {
          const size_t ro = (size_t)(row0 + ai * 128 + m * 16) * D + ch0 + n * 16;
          if (n == 0) xw[1][ai][m] = *(const u32x2*)(XC + ro + 16);
          const f32x4 xv = unpack4(xw[n][ai][m]);
          f32x4 la, bb;
#pragma unroll
          for (int j = 0; j < 4; ++j) {
            const float rr = fast_sigmoid(acc[ai][0][m][n][j] + bav[n][j]), ii = fast_sigmoid(acc[ai][1][m][n][j] + bxv[n][j]);
            const float l = rr * spv[n][j];
            la[j] = l; bb[j] = __fsqrt_rn(fmaxf(1.0f - __expf(2.0f * l), 0.f)) * ii * xv[j];
          }
          *(u32x2*)(LA + ro) = pack4(la); *(u32x2*)(BB + ro) = pack4(bb);
        }
  }
};

__device__ __forceinline__ void cvt_tile(const float* src, int ld, bf16_t* dst, int ldd, LAS float* tile) { const int tid_l = launder_v((int)threadIdx.x);
  const int t = tid_l, a = t >> 6, b = t & 63;
#pragma unroll
  for (int i = 0; i < 8; ++i) tile[(i * 8 + a) * 65 + b] = src[(size_t)(i * 8 + a) * ld + b];
  __syncthreads();
#pragma unroll
  for (int i = 0; i < 8; ++i) dst[(size_t)(i * 8 + a) * ldd + b] = f2bf(tile[b * 65 + i * 8 + a]);
  __syncthreads();
}
__device__ __forceinline__ void sincos_taylor(double r, double& s, double& c) {
  const double r2 = r * r; double ts = r, tc = 1.0; s = r; c = 1.0;
  for (int i = 1; i <= 15; ++i) { tc = -tc * r2 / (double)((2 * i - 1) * (2 * i)); ts = -ts * r2 / (double)((2 * i) * (2 * i + 1)); c += tc; s += ts; }
}
__device__ __forceinline__ void prologue(PK pk, LAS unsigned char* lds, const int bid, const int nb) { const int tid_l = launder_v((int)threadIdx.x);
  unsigned char* ws = pk->ws;
  const int tid = tid_l;
  LAS float* tile = (LAS float*)lds;
  LAS float* sc = (LAS float*)(lds + 16640);
  LAS float* red = (LAS float*)(lds + 16640 + 12288);
  for (int i = tid; i < 3072; i += 512) { const int v = i >> 10, k = i & 1023; const float x = v < 2 ? pk->in[I_C][v * 1024 + k] : pk->in[I_CCTX][k]; sc[i] = x * fast_sigmoid(x); }
  __syncthreads();
  float* mod = (float*)(ws + OFF_MOD);
  for (int it = bid; it < 288; it += nb) {
    const int l = it / 144, cb = it % 144, kg = tid >> 6, j = tid & 63;
    const float* w = pk->in[I_ADAW] + (size_t)l * D * NMOD + (size_t)(kg * 128) * NMOD + cb * 64 + j;
    float a0 = 0.f, a1 = 0.f, a2 = 0.f;
    for (int k = 0; k < 128; ++k) { const float wv = w[(size_t)k * NMOD]; a0 += sc[kg * 128 + k] * wv; a1 += sc[1024 + kg * 128 + k] * wv; a2 += sc[2048 + kg * 128 + k] * wv; }
    red[(kg * 3 + 0) * 64 + j] = a0; red[(kg * 3 + 1) * 64 + j] = a1; red[(kg * 3 + 2) * 64 + j] = a2;
    __syncthreads();
    if (tid < 192) { const int v = tid >> 6, jj = tid & 63; float s = pk->in[I_ADAB][l * NMOD + cb * 64 + jj];
      for (int q = 0; q < 8; ++q) s += red[(q * 3 + v) * 64 + jj];
      mod[((size_t)l * 3 + v) * NMOD + cb * 64 + jj] = s; }
    __syncthreads();
  }
  { float* rc = (float*)(ws + OFF_ROPE); float* rs = rc + 4096;
    for (int i = bid * 512 + tid; i < 4096; i += nb * 512) { const int pp = i >> 4, f = i & 15;
      const float inv = powf(10000.0f, -(float)f / 16.0f); const float ang = (float)pp * inv;
      const double ad = (double)ang; const double kq = rint(ad * 0.15915494309189535); const double r = ad - kq * 6.283185307179586477;
      double s, c; sincos_taylor(r, s, c); rc[i] = (float)c; rs[i] = (float)s; } }
  { float* sp = (float*)(ws + OFF_SP); for (int i = bid * 512 + tid; i < 2048; i += nb * 512) sp[i] = -8.0f * log1pf(expf(-pk->in[I_LAM][i])); }
  { float* cr = (float*)(ws + OFF_CTXR); const float* ci = pk->in[I_CTX]; for (int i = bid * 512 + tid_l; i < MC * D / 4; i += nb * 512) *(f32x4*)(cr + 4 * (size_t)i) = *(const f32x4*)(ci + 4 * (size_t)i); }
  { bf16_t* o = (bf16_t*)(ws + OFF_GMWS); for (int i = bid * 512 + tid; i < 65536; i += nb * 512) o[i] = f2bf(pk->in[I_GMWS][i]); }
  for (int ti = bid; ti < 10176; ti += nb) {
    int r = ti;
    if (r < 5632) { const int j = r / 1408, rem = r % 1408, nbk = rem >> 4, kb = rem & 15, pn = nbk >> 2, sub = nbk & 3;
      const float* src = (sub < 2 ? pk->in[I_WG] : pk->in[I_WU]) + (size_t)j * D * FF + (size_t)(kb * 64) * FF + pn * 128 + (sub & 1) * 64;
      cvt_tile(src, FF, (bf16_t*)(ws + OFF_W1 + j * SZ_W1) + (size_t)(nbk * 64) * D + kb * 64, D, tile); continue; }
    r -= 5632;
    if (r < 2816) { const int j = r / 704, rem = r % 704, nbk = rem / 44, kb = rem % 44;
      const float* src = pk->in[I_WD] + (size_t)j * FF * D + (size_t)(kb * 64) * D + nbk * 64;
      cvt_tile(src, D, (bf16_t*)(ws + OFF_W2 + j * SZ_W2) + (size_t)(nbk * 64) * FF + kb * 64, FF, tile); continue; }
    r -= 2816;
    if (r < 448) { const int nbk = r >> 4, kb = r & 15;
      cvt_tile(pk->in[I_EVIN] + (size_t)(kb * 64) * EVIN_N + nbk * 64, EVIN_N, (bf16_t*)(ws + OFF_EVIN) + (size_t)(nbk * 64) * D + kb * 64, D, tile); continue; }
    r -= 448;
    if (r < 256) { const int nbk = r >> 4, kb = r & 15;
      cvt_tile(pk->in[I_EVOUT] + (size_t)(kb * 64) * D + nbk * 64, D, (bf16_t*)(ws + OFF_EVOUT) + (size_t)(nbk * 64) * D + kb * 64, D, tile); continue; }
    r -= 256;
    if (r < 512) { const int nbk = r >> 4, kb = r & 15;
      cvt_tile(pk->in[I_ODIN] + (size_t)(kb * 64) * 2048 + nbk * 64, 2048, (bf16_t*)(ws + OFF_ODIN) + (size_t)(nbk * 64) * D + kb * 64, D, tile); continue; }
    r -= 512;
    if (r < 256) { const int nbk = r >> 4, kb = r & 15;
      cvt_tile(pk->in[I_ODOUT] + (size_t)(kb * 64) * D + nbk * 64, D, (bf16_t*)(ws + OFF_ODOUT) + (size_t)(nbk * 64) * D + kb * 64, D, tile); continue; }
    r -= 256;
    { const int nbk = r >> 2, kb = r & 3, t = nbk >> 2, sub = nbk & 3, d = t >> 3, h = (t >> 1) & 3, cb = t & 1;
      const float* src = (sub < 2 ? pk->in[I_RGWA] : pk->in[I_RGWX]) + (size_t)(d * 4 + h) * 65536 + (size_t)(kb * 64) * 256 + cb * 128 + (sub & 1) * 64;
      cvt_tile(src, 256, (bf16_t*)(ws + OFF_RGW) + (size_t)(nbk * 64) * 256 + kb * 64, 256, tile); }
  }
}

__device__ __forceinline__ void phase_prep(const float* src_lat, float* src_ctx, const float* gs, bf16_t* h, float* rs, int r0, const float* slab, int nslab, const float* rsp, bool reduce_lat, const float* ng0, const float* sc0  , const int bid, const int nb) { const int tid_l = launder_v((int)threadIdx.x);
  const int lane = tid_l & 63, wv = tid_l >> 6;
  for (int rb = r0 + (bid * 8 + wv) * 2; rb < MR; rb += nb * 16) {
    f32x4 v[2][4];
#pragma unroll
    for (int q = 0; q < 2; ++q) { const int r = rb + q; const float* xr = r < MX ? src_lat + (size_t)r * D : src_ctx + (size_t)(r - MX) * D;
#pragma unroll
      for (int i = 0; i < 4; ++i) v[q][i] = *(const f32x4*)(xr + i * 256 + lane * 4); }
    if (rb >= MX && nslab > 0) {
      for (int sl = 0; sl < nslab; ++sl)
#pragma unroll
        for (int q = 0; q < 2; ++q)
#pragma unroll
          for (int i = 0; i < 4; ++i) v[q][i] = v[q][i] + *(const f32x4*)(slab + ((size_t)sl * MC + (rb + q - MX)) * D + i * 256 + lane * 4);
#pragma unroll
      for (int q = 0; q < 2; ++q)
#pragma unroll
        for (int i = 0; i < 4; ++i) *(f32x4*)(src_ctx + (size_t)(rb + q - MX) * D + i * 256 + lane * 4) = v[q][i];
    }
#pragma unroll
    for (int q = 0; q < 2; ++q) { const int r = rb + q; const int mi = r < SEQ ? 0 : (r < MX ? 1 : 2);
      float ss = 0.f;
#pragma unroll
      for (int i = 0; i < 4; ++i) { ss += v[q][i][0] * v[q][i][0] + v[q][i][1] * v[q][i][1] + v[q][i][2] * v[q][i][2] + v[q][i][3] * v[q][i][3];
        const f32x4 g4 = ng0 ? *(const f32x4*)(ng0 + i * 256 + lane * 4) * (*(const f32x4*)(sc0 + (size_t)mi * NMOD + i * 256 + lane * 4) + 1.0f) : *(const f32x4*)(gs + mi * 1024 + i * 256 + lane * 4);
        *(u32x2*)(h + (size_t)r * D + i * 256 + lane * 4) = pack4(v[q][i] * g4); }
      ss = wave_sum(ss, lane);
      if (lane == 0) rs[r] = ss; }
  }
  if (reduce_lat) {
    for (int r = bid * 512 + tid_l; r < MX; r += nb * 512) {
      const f32x4 a = *(const f32x4*)(rsp + (size_t)r * 16), b = *(const f32x4*)(rsp + (size_t)r * 16 + 4), c = *(const f32x4*)(rsp + (size_t)r * 16 + 8), d = *(const f32x4*)(rsp + (size_t)r * 16 + 12);
      rs[r] = ((((a[0] + a[1]) + (a[2] + a[3])) + ((b[0] + b[1]) + (b[2] + b[3]))) + (((c[0] + c[1]) + (c[2] + c[3])) + ((d[0] + d[1]) + (d[2] + d[3]))));
    }
  }
}
__device__ __forceinline__ void prologue2(PK pk, const int bid, const int nb) { const int tid_l = launder_v((int)threadIdx.x);
  unsigned char* ws = pk->ws; const float* mod = (const float*)(ws + OFF_MOD);
  { float* gs = (float*)(ws + OFF_GS);
    for (int i = bid * 512 + tid_l; i < 2 * 3 * 3 * 1024; i += nb * 512) { const int c = i & 1023, mi = (i >> 10) % 3, lj = i / 3072, l = lj / 3, j = lj % 3;
      gs[i] = pk->in[I_NORMG][(size_t)(l * 3 + j) * D + c] * (1.0f + mod[(size_t)(l * 3 + mi) * NMOD + (3 * j + 1) * 1024 + c]); } }
  const int lane = tid_l & 63, wv = tid_l >> 6;
  for (int t = bid * 8 + wv; t < 4 * 5632 + 1792 + 2048; t += nb * 8) {
    const bf16_t* wrow; float* bo; int l, j, n, ncols;
    if (t < 4 * 5632) { const int j4 = t / 5632; n = t % 5632; l = j4 >> 1; j = (j4 & 1) * 2; ncols = 5632; wrow = (const bf16_t*)(ws + OFF_W1 + j4 * SZ_W1) + (size_t)n * D; bo = (float*)(ws + OFF_BIASF) + (size_t)j4 * 3 * 5632; }
    else if (t < 4 * 5632 + 1792) { n = t - 4 * 5632; l = 0; j = 1; ncols = 1792; wrow = (const bf16_t*)(ws + OFF_EVIN) + (size_t)n * D; bo = (float*)(ws + OFF_BIASE); }
    else { n = t - 4 * 5632 - 1792; l = 1; j = 1; ncols = 2048; wrow = (const bf16_t*)(ws + OFF_ODIN) + (size_t)n * D; bo = (float*)(ws + OFF_BIASO); }
    const u32x4 w0 = *(const u32x4*)(wrow + lane * 16), w1 = *(const u32x4*)(wrow + lane * 16 + 8);
    const float wf[16] = {bflo(w0.x), bfhi(w0.x), bflo(w0.y), bfhi(w0.y), bflo(w0.z), bfhi(w0.z), bflo(w0.w), bfhi(w0.w), bflo(w1.x), bfhi(w1.x), bflo(w1.y), bfhi(w1.y), bflo(w1.z), bfhi(w1.z), bflo(w1.w), bfhi(w1.w)};
#pragma unroll
    for (int mi = 0; mi < 3; ++mi) { const float* sh = mod + (size_t)(l * 3 + mi) * NMOD + (3 * j) * 1024 + lane * 16; float a = 0.f;
#pragma unroll
      for (int q = 0; q < 4; ++q) { const f32x4 s4 = *(const f32x4*)(sh + 4 * q); a += s4[0] * wf[4 * q] + s4[1] * wf[4 * q + 1] + s4[2] * wf[4 * q + 2] + s4[3] * wf[4 * q + 3]; }
      a = wave_sum(a, lane);
      if (lane == 0) bo[(size_t)mi * ncols + n] = a; }
  }
}
__device__ __forceinline__ void phase_final_norm(float* out, const bf16_t* xb, const float* g, const int bid, const int nb) { const int tid_l = launder_v((int)threadIdx.x);
  const int lane = tid_l & 63, wv = tid_l >> 6;
  f32x4 gv[2][2];
#pragma unroll
  for (int i = 0; i < 2; ++i) { gv[i][0] = *(const f32x4*)(g + i * 512 + lane * 8); gv[i][1] = *(const f32x4*)(g + i * 512 + lane * 8 + 4); }
  for (int rb = (bid * 8 + wv) * 8; rb < MX; rb += nb * 64) {
    u32x4 w[8][2];
#pragma unroll
    for (int q = 0; q < 8; ++q)
#pragma unroll
      for (int i = 0; i < 2; ++i) w[q][i] = *(const u32x4*)(xb + (size_t)(rb + q) * D + i * 512 + lane * 8);
#pragma unroll
    for (int q = 0; q < 8; ++q) {
      f32x4 v[2][2]; float ss = 0.f;
#pragma unroll
      for (int i = 0; i < 2; ++i) { u32x2 lo, hi; lo.x = w[q][i].x; lo.y = w[q][i].y; hi.x = w[q][i].z; hi.y = w[q][i].w; v[i][0] = unpack4(lo); v[i][1] = unpack4(hi);
#pragma unroll
        for (int h = 0; h < 2; ++h) ss += v[i][h][0] * v[i][h][0] + v[i][h][1] * v[i][h][1] + v[i][h][2] * v[i][h][2] + v[i][h][3] * v[i][h][3]; }
      ss = wave_sum(ss, lane);
      const float rstd = rsqrtf(ss * (1.0f / 1024.0f) + 1e-6f);
#pragma unroll
      for (int i = 0; i < 2; ++i)
#pragma unroll
        for (int h = 0; h < 2; ++h) *(f32x4*)(out + (size_t)(rb + q) * D + i * 512 + lane * 8 + h * 4) = v[i][h] * rstd * gv[i][h]; }
  }
}

constexpr int VSTR = 648;
__device__ __forceinline__ void attn_unit(PK pk, int u, LAS unsigned char* lds) { const int tid_l = launder_v((int)threadIdx.x);
  const bf16_t* Q = (const bf16_t*)(pk->ws + OFF_Q); const bf16_t* Kb = (const bf16_t*)(pk->ws + OFF_K); const bf16_t* Vb = (const bf16_t*)(pk->ws + OFF_V);
  bf16_t* MIX = (bf16_t*)(pk->ws + OFF_MIXE);
  const int tid = tid_l, wv = tid >> 6, lane = tid & 63, fr = lane & 15, fq = lane >> 4;
  const bool is_ctx = u >= 512;
  int b, qb, kvh;
  if (!is_ctx) { b = u >> 8; qb = (u >> 1) & 127; kvh = u & 1; } else { const int j = u - 512; b = j >> 2; qb = (j >> 1) & 1; kvh = j & 1; }
  const int qrow0 = is_ctx ? MX + b * CTXL + qb * 128 : b * SEQ + qb * 128;
  LAS bf16_t* VT = (LAS bf16_t*)lds;
#pragma unroll 1
  for (int c = 0; c < 5; ++c) {
    const bool active = c >= 3 ? true : (is_ctx ? false : (c == 0 ? qb > 0 : (c == 2 ? qb < 127 : true)));
    if (!active) continue;
    const int base = c >= 3 ? MX + b * CTXL + (c - 3) * 128 : qrow0 + (c - 1) * 128;
    const int kp = tid & 63, oc = tid >> 6;
    const bf16_t* vsrc = Vb + (size_t)(base + 2 * kp) * 128 + kvh * 64 + oc * 8;
    const u32x4 v0 = *(const u32x4*)(vsrc), v1 = *(const u32x4*)(vsrc + 128);
    LAS unsigned* vdst = (LAS unsigned*)(VT + (oc * 8) * VSTR + c * 128 + 2 * kp);
    vdst[0 * (VSTR / 2)] = (v0.x & 0xffffu) | (v1.x << 16); vdst[1 * (VSTR / 2)] = (v0.x >> 16) | (v1.x & 0xffff0000u);
    vdst[2 * (VSTR / 2)] = (v0.y & 0xffffu) | (v1.y << 16); vdst[3 * (VSTR / 2)] = (v0.y >> 16) | (v1.y & 0xffff0000u);
    vdst[4 * (VSTR / 2)] = (v0.z & 0xffffu) | (v1.z << 16); vdst[5 * (VSTR / 2)] = (v0.z >> 16) | (v1.z & 0xffff0000u);
    vdst[6 * (VSTR / 2)] = (v0.w & 0xffffu) | (v1.w << 16); vdst[7 * (VSTR / 2)] = (v0.w >> 16) | (v1.w & 0xffff0000u);
  }
  __syncthreads();
  const int head = kvh * 4 + (wv >> 1);
  const float LOG2E = 1.4426950408889634f;
  const float sink2 = pk->in[I_SINK][head] * LOG2E;
  LAS unsigned char* KB0 = lds + 83968;
  constexpr int KROW = 144, KBUF = 128 * KROW;
  const int skey = tid >> 2, sseg = (tid & 3) * 2;
#define ATT_ACTIVE(c_) ((c_) >= 3 ? true : (is_ctx ? false : ((c_) == 0 ? qb > 0 : ((c_) == 2 ? qb < 127 : true))))
#define ATT_BASE(c_) ((c_) >= 3 ? MX + b * CTXL + ((c_) - 3) * 128 : qrow0 + ((c_) - 1) * 128)
  int par = 0;
#pragma unroll 1
  for (int hq = 0; hq < 2; ++hq) {
    const int qoff = (wv & 1) * 64 + hq * 32;
    float mrun[2], lrun[2]; f32x4 o[2][4];
#pragma unroll
    for (int qt = 0; qt < 2; ++qt) { mrun[qt] = sink2; lrun[qt] = 0.25f;
#pragma unroll
      for (int dt = 0; dt < 4; ++dt) o[qt][dt] = (f32x4){0.f, 0.f, 0.f, 0.f}; }
    int c = is_ctx ? 3 : (qb > 0 ? 0 : 1);
    { const bf16_t* ks = Kb + (size_t)(ATT_BASE(c) + skey) * 128 + kvh * 64 + sseg * 8;
      const u32x4 a0 = *(const u32x4*)(ks), a1 = *(const u32x4*)(ks + 8);
      LAS unsigned char* kd = KB0 + par * KBUF + skey * KROW + sseg * 16;
      *(LAS u32x4*)(kd) = a0; *(LAS u32x4*)(kd + 16) = a1; }
    __syncthreads();
#pragma unroll 1
    while (c < 5) {
      int cn = c + 1; while (cn < 5 && !ATT_ACTIVE(cn)) ++cn;
      u32x4 n0 = {0u, 0u, 0u, 0u}, n1 = {0u, 0u, 0u, 0u};
      if (cn < 5) { const bf16_t* ks = Kb + (size_t)(ATT_BASE(cn) + skey) * 128 + kvh * 64 + sseg * 8; n0 = *(const u32x4*)(ks); n1 = *(const u32x4*)(ks + 8); }
      const int dlo = c == 0 ? 0 : -100000, dhi = c == 2 ? 0 : 100000;
      const LAS unsigned char* kcur = KB0 + par * KBUF + fr * KROW + fq * 16;
#pragma unroll
      for (int qt = 0; qt < 2; ++qt) {
        const int iq = qoff + qt * 16 + fr; const int dq = 4 * fq - iq;
        const bf16_t* qp = Q + (size_t)(qrow0 + iq) * 512 + head * 64 + fq * 8;
        const bf16x8 q0 = *(const bf16x8*)(qp), q1 = *(const bf16x8*)(qp + 32);
        f32x4 st[8];
#pragma unroll
        for (int kt = 0; kt < 8; ++kt) {
          const bf16x8 k0 = *(const LAS bf16x8*)(kcur + kt * 16 * KROW), k1 = *(const LAS bf16x8*)(kcur + kt * 16 * KROW + 64);
          f32x4 sx = __builtin_amdgcn_mfma_f32_16x16x32_bf16(k0, q0, (f32x4){0.f, 0.f, 0.f, 0.f}, 0, 0, 0);
          st[kt] = __builtin_amdgcn_mfma_f32_16x16x32_bf16(k1, q1, sx, 0, 0, 0);
        }
        float mx = -1e30f;
#pragma unroll
        for (int kt = 0; kt < 8; ++kt)
#pragma unroll
          for (int j = 0; j < 4; ++j) {
            const int df = kt * 16 + j + dq;
            float sv = st[kt][j];
            if (df < dlo || df > dhi) sv = -1e30f;
            st[kt][j] = sv; mx = fmaxf(mx, sv);
          }
        mx = fmaxf(mx, shx(mx, 16, lane)); mx = fmaxf(mx, shx(mx, 32, lane));
        const float mnew = fmaxf(mrun[qt], mx), alpha = exp2f(mrun[qt] - mnew);
        mrun[qt] = mnew;
        float ls = 0.f;
#pragma unroll
        for (int kt = 0; kt < 8; ++kt)
#pragma unroll
          for (int j = 0; j < 4; ++j) { const float pv = exp2f(st[kt][j] - mnew); st[kt][j] = pv; ls += pv; }
        lrun[qt] = lrun[qt] * alpha + ls;
#pragma unroll
        for (int dt = 0; dt < 4; ++dt) o[qt][dt] = o[qt][dt] * alpha;
#pragma unroll
        for (int kk = 0; kk < 4; ++kk) {
          u32x4 pw; pw.x = cvt_pk_bf16(st[2 * kk][0], st[2 * kk][1]); pw.y = cvt_pk_bf16(st[2 * kk][2], st[2 * kk][3]);
          pw.z = cvt_pk_bf16(st[2 * kk + 1][0], st[2 * kk + 1][1]); pw.w = cvt_pk_bf16(st[2 * kk + 1][2], st[2 * kk + 1][3]);
          const bf16x8 pf = __builtin_bit_cast(bf16x8, pw);
#pragma unroll
          for (int dt = 0; dt < 4; ++dt) {
            const LAS bf16_t* vp = VT + (dt * 16 + fr) * VSTR + c * 128 + kk * 32 + 4 * fq;
            u32x4 vw; const u32x2 va = *(const LAS u32x2*)(vp), vb = *(const LAS u32x2*)(vp + 16);
            vw.x = va.x; vw.y = va.y; vw.z = vb.x; vw.w = vb.y;
            o[qt][dt] = __builtin_amdgcn_mfma_f32_16x16x32_bf16(__builtin_bit_cast(bf16x8, vw), pf, o[qt][dt], 0, 0, 0);
          }
        }
      }
      if (cn < 5) { LAS unsigned char* kd = KB0 + (par ^ 1) * KBUF + skey * KROW + sseg * 16; *(LAS u32x4*)(kd) = n0; *(LAS u32x4*)(kd + 16) = n1; }
      __syncthreads();
      c = cn; par ^= 1;
    }
#pragma unroll
    for (int qt = 0; qt < 2; ++qt) {
      float l = lrun[qt]; l += shx(l, 16, lane); l += shx(l, 32, lane);
      const float inv = 1.0f / l;
      bf16_t* op = MIX + (size_t)(qrow0 + qoff + qt * 16 + fr) * D + 512 + head * 64 + 4 * fq;
#pragma unroll
      for (int dt = 0; dt < 4; ++dt) *(u32x2*)(op + dt * 16) = pack4(o[qt][dt] * inv);
    }
  }
  __syncthreads();
}
__device__ __forceinline__ void gate_unit(PK pk, int u, LAS unsigned char* lds) { const int tid_l = launder_v((int)threadIdx.x);
  const bf16_t* UZ = (const bf16_t*)(pk->ws + OFF_UZ); bf16_t* MIX = (bf16_t*)(pk->ws + OFF_MIXE); const bf16_t* WS = (const bf16_t*)(pk->ws + OFF_GMWS);
  const int tid = tid_l, wv = tid >> 6, lane = tid & 63, fr = lane & 15, fq = lane >> 4;
  const int n = u >> 2, g = u & 3, row0 = n * 128;
  LAS float* rstd = (LAS float*)lds; LAS bf16_t* ZT = (LAS bf16_t*)(lds + 512);
  { u32x4 w[16];
#pragma unroll
    for (int i = 0; i < 16; ++i) w[i] = *(const u32x4*)(UZ + (size_t)(row0 + wv * 16 + i) * D + 512 + lane * 8);
#pragma unroll
    for (int i = 0; i < 16; ++i) {
      float ss = bflo(w[i].x) * bflo(w[i].x) + bfhi(w[i].x) * bfhi(w[i].x) + bflo(w[i].y) * bflo(w[i].y) + bfhi(w[i].y) * bfhi(w[i].y) + bflo(w[i].z) * bflo(w[i].z) + bfhi(w[i].z) * bfhi(w[i].z) + bflo(w[i].w) * bflo(w[i].w) + bfhi(w[i].w) * bfhi(w[i].w);
      ss = wave_sum(ss, lane);
      if (lane == 0) rstd[wv * 16 + i] = rsqrtf(ss * (1.0f / 512.0f) + 1e-6f); } }
  __syncthreads();
#pragma unroll
  for (int i = 0; i < 2; ++i) { const int tp = lane, oc = wv + 8 * i;
    const bf16_t* zsrc = UZ + (size_t)(row0 + 2 * tp) * D + 512 + g * 128 + oc * 8;
    const u32x4 z0 = *(const u32x4*)(zsrc), z1 = *(const u32x4*)(zsrc + D);
    const float r0 = rstd[2 * tp], r1 = rstd[2 * tp + 1]; const float* gn = pk->in[I_GMG] + g * 128 + oc * 8;
    const f32x4 g0 = *(const f32x4*)(gn), g1 = *(const f32x4*)(gn + 4);
    LAS unsigned* zd = (LAS unsigned*)(ZT + (oc * 8) * 136 + 2 * tp);
    zd[0 * 68] = cvt_pk_bf16(bflo(z0.x) * r0 * g0[0], bflo(z1.x) * r1 * g0[0]); zd[1 * 68] = cvt_pk_bf16(bfhi(z0.x) * r0 * g0[1], bfhi(z1.x) * r1 * g0[1]);
    zd[2 * 68] = cvt_pk_bf16(bflo(z0.y) * r0 * g0[2], bflo(z1.y) * r1 * g0[2]); zd[3 * 68] = cvt_pk_bf16(bfhi(z0.y) * r0 * g0[3], bfhi(z1.y) * r1 * g0[3]);
    zd[4 * 68] = cvt_pk_bf16(bflo(z0.z) * r0 * g1[0], bflo(z1.z) * r1 * g1[0]); zd[5 * 68] = cvt_pk_bf16(bfhi(z0.z) * r0 * g1[1], bfhi(z1.z) * r1 * g1[1]);
    zd[6 * 68] = cvt_pk_bf16(bflo(z0.w) * r0 * g1[2], bflo(z1.w) * r1 * g1[2]); zd[7 * 68] = cvt_pk_bf16(bfhi(z0.w) * r0 * g1[3], bfhi(z1.w) * r1 * g1[3]); }
  __syncthreads();
  bf16x8 bw[4];
#pragma unroll
  for (int kk = 0; kk < 4; ++kk) bw[kk] = *(const bf16x8*)(WS + (size_t)(g * 128 + wv * 16 + fr) * 128 + kk * 32 + fq * 8);
  const int row = row0 + wv * 16 + fr;
  const float bsv = pk->in[I_GMBS][g * 128 + wv * 16 + fr];
#pragma unroll
  for (int ct = 0; ct < 8; ++ct) {
    f32x4 acc = {0.f, 0.f, 0.f, 0.f};
#pragma unroll
    for (int kk = 0; kk < 4; ++kk) { const bf16x8 a = *(const LAS bf16x8*)(ZT + (ct * 16 + fr) * 136 + kk * 32 + fq * 8); acc = __builtin_amdgcn_mfma_f32_16x16x32_bf16(a, bw[kk], acc, 0, 0, 0); }
    const int col = g * 128 + ct * 16 + 4 * fq;
    const f32x4 uu = unpack4(*(const u32x2*)(UZ + (size_t)row * D + col));
    *(u32x2*)(MIX + (size_t)row * D + col) = pack4(uu * (acc + bsv));
  }
  __syncthreads();
}

__device__ __forceinline__ void phase_conv(PK pk, const int bid, const int nb) { const int tid_l = launder_v((int)threadIdx.x);
  const bf16_t* __restrict__ XX = (const bf16_t*)(pk->ws + OFF_XX); bf16_t* __restrict__ XC = (bf16_t*)(pk->ws + OFF_XC);
  const float* __restrict__ cw = pk->in[I_CONVW]; const float* __restrict__ cb = pk->in[I_CONVB];
#pragma unroll 4
  for (int idx = bid * 512 + tid_l; idx < MR * 128; idx += nb * 512) {
    const int r = idx >> 7, c = (idx & 127) * 8;
    int pos, len; if (r < MX) { pos = r & (SEQ - 1); len = SEQ; } else { pos = (r - MX) & (CTXL - 1); len = CTXL; }
    float a[8];
#pragma unroll
    for (int e = 0; e < 8; ++e) a[e] = cb[c + e];
#pragma unroll
    for (int j = 0; j < 4; ++j) { const int pp = pos - 1 + j;
      if (pp >= 0 && pp < len) { const u32x4 w = *(const u32x4*)(XX + (size_t)(r - 1 + j) * D + c); const float* cwj = cw + j * 1024 + c;
        a[0] += cwj[0] * bflo(w.x); a[1] += cwj[1] * bfhi(w.x); a[2] += cwj[2] * bflo(w.y); a[3] += cwj[3] * bfhi(w.y);
        a[4] += cwj[4] * bflo(w.z); a[5] += cwj[5] * bfhi(w.z); a[6] += cwj[6] * bflo(w.w); a[7] += cwj[7] * bfhi(w.w); } }
    u32x4 o; o.x = cvt_pk_bf16(a[0], a[1]); o.y = cvt_pk_bf16(a[2], a[3]); o.z = cvt_pk_bf16(a[4], a[5]); o.w = cvt_pk_bf16(a[6], a[7]);
    *(u32x4*)(XC + (size_t)r * D + c) = o;
  }
}
__device__ __forceinline__ void scan_item(int it, int& b, int& ci, int& row0, int& len) {
  if (it < 1024) { b = it >> 9; const int lc = it & 511; ci = 32 + lc; row0 = b * SEQ + lc * 32; len = 32; }
  else { const int j = it - 1024; b = j >> 5; ci = j & 31; row0 = MX + b * CTXL + ci * 8; len = 8; }
}
#define SCAN_STEP(H, LAW, BW) do { \
    H[0] = __expf(bflo(LAW.x)) * H[0] + bflo(BW.x); H[1] = __expf(bfhi(LAW.x)) * H[1] + bfhi(BW.x); \
    H[2] = __expf(bflo(LAW.y)) * H[2] + bflo(BW.y); H[3] = __expf(bfhi(LAW.y)) * H[3] + bfhi(BW.y); \
    H[4] = __expf(bflo(LAW.z)) * H[4] + bflo(BW.z); H[5] = __expf(bfhi(LAW.z)) * H[5] + bfhi(BW.z); \
    H[6] = __expf(bflo(LAW.w)) * H[6] + bflo(BW.w); H[7] = __expf(bfhi(LAW.w)) * H[7] + bfhi(BW.w); } while (0)
#define SCAN_ACCP(P, LAW) do { P[0] += bflo(LAW.x); P[1] += bfhi(LAW.x); P[2] += bflo(LAW.y); P[3] += bfhi(LAW.y); P[4] += bflo(LAW.z); P[5] += bfhi(LAW.z); P[6] += bflo(LAW.w); P[7] += bfhi(LAW.w); } while (0)
__device__ __forceinline__ void phase_scan1(PK pk, const int bid, const int nb) { const int tid_l = launder_v((int)threadIdx.x);
  const bf16_t* __restrict__ LAB = (const bf16_t*)(pk->ws + OFF_LAB); float* __restrict__ PE = (float*)(pk->ws + OFF_PE);
  const int ch = (tid_l & 127) * 8;
  for (int it = bid * 4 + (tid_l >> 7); it < 1088; it += nb * 4) {
    int b, ci, row0, len; scan_item(it, b, ci, row0, len);
#pragma unroll
    for (int d = 0; d < 2; ++d) {
      const bf16_t* __restrict__ LA = LAB + (size_t)(2 * d) * MR * D + ch; const bf16_t* __restrict__ BB = LAB + (size_t)(2 * d + 1) * MR * D + ch;
      float H[8], P[8];
#pragma unroll
      for (int e = 0; e < 8; ++e) { H[e] = 0.f; P[e] = 0.f; }
#pragma unroll 1
      for (int t0 = 0; t0 < len; t0 += 8) {
        u32x4 lw[8], bw[8];
#pragma unroll
        for (int k = 0; k < 8; ++k) { const int r = row0 + (d == 0 ? t0 + k : len - 1 - t0 - k); lw[k] = *(const u32x4*)(LA + (size_t)r * D); bw[k] = *(const u32x4*)(BB + (size_t)r * D); }
#pragma unroll
        for (int k = 0; k < 8; ++k) { SCAN_STEP(H, lw[k], bw[k]); SCAN_ACCP(P, lw[k]); }
      }
      float* pp = PE + ((size_t)(d * 2 + b) * NCH + ci) * 1024 + ch; float* ep = pp + (size_t)2 * 2 * NCH * 1024;
      *(f32x4*)(pp) = (f32x4){P[0], P[1], P[2], P[3]}; *(f32x4*)(pp + 4) = (f32x4){P[4], P[5], P[6], P[7]};
      *(f32x4*)(ep) = (f32x4){H[0], H[1], H[2], H[3]}; *(f32x4*)(ep + 4) = (f32x4){H[4], H[5], H[6], H[7]};
    }
  }
}
__device__ __forceinline__ void phase_scan2(PK pk, const int bid, const int nb) { const int tid_l = launder_v((int)threadIdx.x);
  const float* PE = (const float*)(pk->ws + OFF_PE); float* HIN = (float*)(pk->ws + OFF_HIN);
  if (bid >= 64 || tid_l >= 64) return;
  const int id = bid * 64 + tid_l, d = id >> 11, b = (id >> 10) & 1, ch = id & 1023;
  const float* pp = PE + (size_t)(d * 2 + b) * NCH * 1024 + ch; const float* ep = pp + (size_t)2 * 2 * NCH * 1024;
  float* hp = HIN + (size_t)(d * 2 + b) * NCH * 1024 + ch;
  float H = 0.f;
#pragma unroll 1
  for (int s0 = 0; s0 < NCH; s0 += 32) {
    float pv[32], ev[32];
#pragma unroll
    for (int k = 0; k < 32; ++k) { const int s = s0 + k; const int ci = d == 0 ? s : (s < 32 ? 31 - s : 575 - s); pv[k] = pp[(size_t)ci * 1024]; ev[k] = ep[(size_t)ci * 1024]; }
#pragma unroll
    for (int k = 0; k < 32; ++k) { const int s = s0 + k; const int ci = d == 0 ? s : (s < 32 ? 31 - s : 575 - s); hp[(size_t)ci * 1024] = H; H = __expf(pv[k]) * H + ev[k]; }
  }
}
__device__ __forceinline__ void phase_scan3(PK pk, LAS unsigned char* lds, const int bid, const int nb) { const int tid_l = launder_v((int)threadIdx.x);
  const bf16_t* __restrict__ LAB = (const bf16_t*)(pk->ws + OFF_LAB); const float* __restrict__ HIN = (const float*)(pk->ws + OFF_HIN);
  const bf16_t* __restrict__ G = (const bf16_t*)(pk->ws + OFF_G); bf16_t* MIX = (bf16_t*)(pk->ws + OFF_MIXO);
  const int ch = (tid_l & 127) * 8;
  LAS u32x4* slot = (LAS u32x4*)lds + tid_l;
#define S3_FWD_BATCH(T0, SINK) do { u32x4 lw[8], bw[8]; \
        _Pragma("unroll") for (int k = 0; k < 8; ++k) { const int r = row0 + (T0) + k; lw[k] = *(const u32x4*)(LA + (size_t)r * D); bw[k] = *(const u32x4*)(BB + (size_t)r * D); } \
        _Pragma("unroll") for (int k = 0; k < 8; ++k) { SCAN_STEP(H, lw[k], bw[k]); \
          u32x4 o; o.x = cvt_pk_bf16(H[0], H[1]); o.y = cvt_pk_bf16(H[2], H[3]); o.z = cvt_pk_bf16(H[4], H[5]); o.w = cvt_pk_bf16(H[6], H[7]); SINK; } } while (0)
#define S3_BWD_BATCH(T0, SRC) do { u32x4 lw[8], bw[8], gw[8]; \
        _Pragma("unroll") for (int k = 0; k < 8; ++k) { const int r = row0 + (T0) + 7 - k; lw[k] = *(const u32x4*)(LA + (size_t)r * D); bw[k] = *(const u32x4*)(BB + (size_t)r * D); gw[k] = *(const u32x4*)(G + (size_t)r * D + ch); } \
        _Pragma("unroll") for (int k = 0; k < 8; ++k) { const int r = row0 + (T0) + 7 - k; SCAN_STEP(H, lw[k], bw[k]); const u32x4 hf = SRC, gg = gw[k]; u32x4 o_; \
          o_.x = cvt_pk_bf16((bflo(hf.x) + H[0]) * bflo(gg.x), (bfhi(hf.x) + H[1]) * bfhi(gg.x)); \
          o_.y = cvt_pk_bf16((bflo(hf.y) + H[2]) * bflo(gg.y), (bfhi(hf.y) + H[3]) * bfhi(gg.y)); \
          o_.z = cvt_pk_bf16((bflo(hf.z) + H[4]) * bflo(gg.z), (bfhi(hf.z) + H[5]) * bfhi(gg.z)); \
          o_.w = cvt_pk_bf16((bflo(hf.w) + H[6]) * bflo(gg.w), (bfhi(hf.w) + H[7]) * bfhi(gg.w)); \
          *(u32x4*)(MIX + (size_t)r * D + ch) = o_; } } while (0)
  for (int it = bid * 4 + (tid_l >> 7); it < 1024  ; it += nb * 4) {
    int b, ci, row0, len; scan_item(it, b, ci, row0, len);
    u32x4 hfr[8];
    { const bf16_t* LA = LAB + ch; const bf16_t* __restrict__ BB = LAB + (size_t)MR * D + ch;
      const float* hp = HIN + ((size_t)(0 * 2 + b) * NCH + ci) * 1024 + ch;
      const f32x4 h0 = *(const f32x4*)(hp), h1 = *(const f32x4*)(hp + 4);
      float H[8] = {h0[0], h0[1], h0[2], h0[3], h1[0], h1[1], h1[2], h1[3]};
#pragma unroll 1
      for (int t0 = 0; t0 < 16; t0 += 8) S3_FWD_BATCH(t0, slot[(t0 + k) * 512] = o);
      S3_FWD_BATCH(16, *(u32x4*)(MIX + (size_t)(row0 + 16 + k) * D + ch) = o);
      S3_FWD_BATCH(24, hfr[k] = o);
    }
    { const bf16_t* __restrict__ LA = LAB + (size_t)2 * MR * D + ch; const bf16_t* __restrict__ BB = LAB + (size_t)3 * MR * D + ch;
      const float* hp = HIN + ((size_t)(1 * 2 + b) * NCH + ci) * 1024 + ch;
      const f32x4 h0 = *(const f32x4*)(hp), h1 = *(const f32x4*)(hp + 4);
      float H[8] = {h0[0], h0[1], h0[2], h0[3], h1[0], h1[1], h1[2], h1[3]};
      S3_BWD_BATCH(24, hfr[7 - k]);
      { u32x4 hfw[8];
#pragma unroll
        for (int k = 0; k < 8; ++k) hfw[k] = *(const u32x4*)(MIX + (size_t)(row0 + 23 - k) * D + ch);
        S3_BWD_BATCH(16, hfw[k]); }
#pragma unroll 1
      for (int t0 = 8; t0 >= 0; t0 -= 8) S3_BWD_BATCH(t0, slot[(t0 + 7 - k) * 512]);
    }
  }
#undef S3_FWD_BATCH
#undef S3_BWD_BATCH
}

#define XB_TMO      128
#define XB_XCNT(j)  (256  + 64 * (j))
#define XB_XSUB(j)  (1280 + 64 * (j))
#define XB_XGEN(j)  (2304 + 64 * (j))
#define XB_TOP      3328
#define XB_TOPGEN   3392
#define XCD_BAR_WORDS 3456
#define XB_SPIN_CAP (1u << 22)
__device__ __forceinline__ unsigned xb_ld(unsigned* p)              { return __hip_atomic_load(p, __ATOMIC_RELAXED, __HIP_MEMORY_SCOPE_AGENT); }
__device__ __forceinline__ unsigned xb_add(unsigned* p, unsigned v) { return __hip_atomic_fetch_add(p, v, __ATOMIC_RELAXED, __HIP_MEMORY_SCOPE_AGENT); }
__device__ __forceinline__ unsigned xb_xcc_id() { return (unsigned)__builtin_amdgcn_s_getreg((3 << 11) | 20) & 0xFu; }
#define XB_SPIN(cond, bar) do { unsigned _sp = 0; while (cond) { __builtin_amdgcn_s_sleep(1); \
    if ((++_sp & 255u) == 0u) { if (xb_ld(&(bar)[XB_TMO])) break; if (_sp > XB_SPIN_CAP) { atomicAdd(&(bar)[XB_TMO], 1u); break; } } } } while (0)
__device__ __forceinline__ void xcd_barrier_complete(unsigned* bar, unsigned x, unsigned& nloc, unsigned& nx) {
    const unsigned G = gridDim.x * gridDim.y * gridDim.z;
    unsigned sum, cnt, mine, sp = 0u;
    for (;;) {
        sum = 0u; cnt = 0u; mine = 0u;
#pragma unroll
        for (unsigned j = 0; j < 16; ++j) { const unsigned c = xb_ld(&bar[XB_XCNT(j)]); sum += c; cnt += (c > 0u) ? 1u : 0u; mine = (j == x) ? c : mine; }
        if (sum == G) break;
        __builtin_amdgcn_s_sleep(1);
        if ((++sp & 255u) == 0u) { if (xb_ld(&bar[XB_TMO])) break; if (sp > XB_SPIN_CAP) { atomicAdd(&bar[XB_TMO], 1u); break; } }
    }
    nloc = mine > 0u ? mine : 1u; nx = cnt > 0u ? cnt : 1u;
}
__device__ __forceinline__ void xcd_barrier(LAS unsigned char* lds) {
    asm volatile("s_waitcnt vmcnt(0)" ::: "memory");
    __syncthreads();
    if (threadIdx.x == 0) {
        PK pk_ = get_pk(); unsigned* bar = (unsigned*)(pk_->ws + OFF_BAR);
        volatile LAS unsigned* st = (volatile LAS unsigned*)(lds + 131072);
        const unsigned x = xb_xcc_id();
        __builtin_amdgcn_s_waitcnt(0);
        unsigned nloc = st[0], nx = st[1];
        if (nloc == 0u) { xcd_barrier_complete(bar, x, nloc, nx); st[0] = nloc; st[1] = nx; }
        const unsigned old = xb_add(&bar[XB_XSUB(x)], 1u);
        const unsigned gen = old / nloc;
        if (old + 1u == (gen + 1u) * nloc) {
            __builtin_amdgcn_fence(__ATOMIC_RELEASE, "agent");
            asm volatile("s_waitcnt vmcnt(0)" ::: "memory");
            const unsigned og = xb_add(&bar[XB_TOP], 1u);
            const unsigned tg = og / nx;
            if (og + 1u == (tg + 1u) * nx) xb_add(&bar[XB_TOPGEN], 1u);
            else XB_SPIN(xb_ld(&bar[XB_TOPGEN]) == tg, bar);
            __builtin_amdgcn_fence(__ATOMIC_ACQUIRE, "agent");
            xb_add(&bar[XB_XGEN(x)], 1u);
            asm volatile("s_waitcnt vmcnt(0)" ::: "memory");
        } else {
            XB_SPIN(xb_ld(&bar[XB_XGEN(x)]) == gen, bar);
            __builtin_amdgcn_fence(__ATOMIC_ACQUIRE, "agent");
            asm volatile("s_waitcnt vmcnt(0)" ::: "memory");
        }
    }
    __syncthreads();
}

#ifdef TPROBE
#define TSTAMP(k) do { PK pk_ = get_pk(); unsigned long long* ta_ = (unsigned long long*)(pk_->ws + OFF_PE); if (blockIdx.x == 0 && threadIdx.x == 0) { const unsigned long long now_ = wall_clock64(); ta_[k] += now_ - ta_[15]; ta_[15] = now_; } } while (0)
#else
#define TSTAMP(k) do {} while (0)
#endif
#define PHASE_VARS PK pk = get_pk(); const int bid = launder_i(cid), G = launder_i((int)gridDim.x); unsigned char* ws = pk->ws; (void)ws; (void)bid; (void)G
#define ZERO_RS(buf) do { float* z_ = (float*)(ws + OFF_RS) + (size_t)(buf) * MR; for (int i_ = bid * 512 + (int)threadIdx.x; i_ < MX; i_ += G * 512) z_[i_] = 0.f; } while (0)
__global__ void __launch_bounds__(512, 2) fwd_mega(Params p_unused) {
  extern __shared__ __attribute__((aligned(16))) unsigned char shm[];
  LAS unsigned char* lds = (LAS unsigned char*)shm;
  cg::grid_group grid = cg::this_grid();
  const int cid = (int)blockIdx.x;
  { PK pk_ = get_pk();
    if (threadIdx.x == 0) { const unsigned x = xb_xcc_id();
      ((volatile LAS unsigned*)(lds + 131072))[0] = 0u; ((volatile LAS unsigned*)(lds + 131072))[1] = 0u;
      (void)xb_add((unsigned*)(pk_->ws + OFF_BAR) + XB_XCNT(x), 1u); }
    __syncthreads(); }
#ifdef TPROBE
  { PK pk_ = get_pk(); unsigned long long* ta_ = (unsigned long long*)(pk_->ws + OFF_PE); if (blockIdx.x == 0 && threadIdx.x < 16) ta_[threadIdx.x] = threadIdx.x == 15 ? (unsigned long long)wall_clock64() : 0ull; }
#endif

  { PHASE_VARS; prologue(pk, lds, bid, G); }
  grid.sync();
#ifdef REP_PRO2
  { PHASE_VARS; prologue(pk, lds, bid, G); }
  xcd_barrier(lds);
#endif
#pragma unroll 1
  for (int l = 0; l < 2; ++l) {
#pragma unroll 1
    for (int s3 = 0; s3 < 3; ++s3) {
      const bool first = (l == 0 && s3 == 0);
      const bool lastp = (l == 1 && s3 == 2);
      const int q = l * 3 + s3, rb = q & 1;
      if (first) { PHASE_VARS; prologue2(pk, bid, G); }
      { PHASE_VARS;
        phase_prep(pk->in[I_X], (float*)(ws + OFF_CTXR), (const float*)(ws + OFF_GS) + (size_t)q * 3072, (bf16_t*)(ws + OFF_H), (float*)(ws + OFF_RS) + (size_t)rb * MR, first ? 0 : (lastp ? MR : MX),
                   (const float*)(ws + (s3 == 2 ? OFF_BIG : OFF_EXTRA)), first ? 0 : (s3 == 2 ? 4 : 11), (const float*)(ws + OFF_RSP), !first,
                   first ? pk->in[I_NORMG] : (const float*)nullptr, first ? (const float*)(ws + OFF_MOD) + 1024 : (const float*)nullptr, bid, G); }
      xcd_barrier(lds); TSTAMP(1);
      if (s3 != 1) {
        const int f = s3 >> 1, j = l * 2 + f;
        { PHASE_VARS;
          pg8::Gemm g{(const bf16_t*)(ws + OFF_H), (const bf16_t*)(ws + OFF_W1 + j * SZ_W1), MR, 2 * FF, D, D, 0, 0};
          pg8::StaticOrder S; S.init(lastp ? MX : g.M, g.N, g.K, G, bid);
          EpiSwiglu e{(bf16_t*)(ws + OFF_BIG), (const float*)(ws + OFF_RS) + (size_t)rb * MR, (const float*)(ws + OFF_BIASF) + (size_t)j * 3 * 5632};
          pg8::gemm_phase(lds, g, S, e); }
        xcd_barrier(lds); TSTAMP(2);
        { PHASE_VARS;
          pg8::Gemm g{(const bf16_t*)(ws + OFF_BIG), (const bf16_t*)(ws + OFF_W2 + j * SZ_W2), MR, D, FF, FF, 0, 1};
          pg8::StaticOrder S; if (lastp) S.init(MX, g.N, g.K, G, bid); else S.init_split(g.N, g.K, G, bid, 11);
          if (first) { EpiResid<true, true> e{pk->in[I_X], (bf16_t*)pk->out, ws, q}; pg8::gemm_phase(lds, g, S, e); }
          else { EpiResid<false, true> e{pk->in[I_X], (bf16_t*)pk->out, ws, q}; pg8::gemm_phase(lds, g, S, e); } }
        xcd_barrier(lds); TSTAMP(3);
      } else if (l == 0) {
        { PHASE_VARS;
          pg8::Gemm g{(const bf16_t*)(ws + OFF_H), (const bf16_t*)(ws + OFF_EVIN), MR, EVIN_N, D, D, 0, 0};
          pg8::StaticOrder S; S.init(g.M, g.N, g.K, G, bid);
          EpiEvenIn e{(bf16_t*)(ws + OFF_UZ), (bf16_t*)(ws + OFF_Q), (bf16_t*)(ws + OFF_K), (bf16_t*)(ws + OFF_V), (const float*)(ws + OFF_ROPE), (const float*)(ws + OFF_ROPE) + 4096,
                      (const float*)(ws + OFF_RS) + (size_t)rb * MR, (const float*)(ws + OFF_BIASE)};
          pg8::gemm_phase(lds, g, S, e); }
        xcd_barrier(lds); TSTAMP(4);
#ifndef REP_ATT
#define REP_ATT 1
#endif
#ifndef ATT_LO
#define ATT_LO 0
#define ATT_HI 1560
#endif
        for (int rep = 0; rep < REP_ATT; ++rep) {
        { PHASE_VARS;
          for (int u = bid + (rep ? ATT_LO : 0); u < (rep ? ATT_HI : 520 + 1040); u += G) { if (u < 520) attn_unit(pk, u, lds); else gate_unit(pk, u - 520, lds); } }
        xcd_barrier(lds); } TSTAMP(5);
        { PHASE_VARS;
          pg8::Gemm g{(const bf16_t*)(ws + OFF_MIXE), (const bf16_t*)(ws + OFF_EVOUT), MR, D, D, D, 0, 0};
          pg8::StaticOrder S; S.init_split(g.N, g.K, G, bid, 4);
          EpiResid<false, false> e{pk->in[I_X], (bf16_t*)pk->out, ws, q};
          pg8::gemm_phase(lds, g, S, e); }
        xcd_barrier(lds); TSTAMP(6);
      } else {
        { PHASE_VARS;
          pg8::Gemm g{(const bf16_t*)(ws + OFF_H), (const bf16_t*)(ws + OFF_ODIN), MR, 2048, D, D, 0, 0};
          pg8::StaticOrder S; S.init(g.M, g.N, g.K, G, bid);
          EpiOddIn e{(bf16_t*)(ws + OFF_G), (bf16_t*)(ws + OFF_XX), (const float*)(ws + OFF_RS) + (size_t)rb * MR, (const float*)(ws + OFF_BIASO)};
          pg8::gemm_phase(lds, g, S, e); }
        xcd_barrier(lds); TSTAMP(7);
        { PHASE_VARS; phase_conv(pk, bid, G); }
        xcd_barrier(lds); TSTAMP(8);
        { PHASE_VARS;
          pg8::Gemm g{(const bf16_t*)(ws + OFF_XC), (const bf16_t*)(ws + OFF_RGW), MR, 4096, 256, D, 1, 0};
          pg8::StaticOrder S; S.init(g.M, g.N, g.K, G, bid);
          EpiRG e{(const bf16_t*)(ws + OFF_XC), (bf16_t*)(ws + OFF_LAB), pk->in[I_RGBA], pk->in[I_RGBX], (const float*)(ws + OFF_SP)};
          pg8::gemm_phase(lds, g, S, e); }
        xcd_barrier(lds); TSTAMP(9);
        { PHASE_VARS; phase_scan1(pk, bid, G); }
        xcd_barrier(lds); TSTAMP(10);
        { PHASE_VARS; phase_scan2(pk, bid, G); }
        xcd_barrier(lds); TSTAMP(11);
        { PHASE_VARS; phase_scan3(pk, lds, bid, G); }
        xcd_barrier(lds); TSTAMP(12);
        { PHASE_VARS;
          pg8::Gemm g{(const bf16_t*)(ws + OFF_MIXO), (const bf16_t*)(ws + OFF_ODOUT), MR, D, D, D, 0, 0};
          pg8::StaticOrder S; S.init(MX, g.N, g.K, G, bid);
          EpiResid<false, false> e{pk->in[I_X], (bf16_t*)pk->out, ws, q};
          pg8::gemm_phase(lds, g, S, e); }
        xcd_barrier(lds); TSTAMP(13);
      }
    }
  }
  { PHASE_VARS; phase_final_norm(pk->out, (const bf16_t*)(ws + OFF_H), pk->in[I_FNG], bid, G); }
}

extern "C" void kernel_launch(void* const* d_in, const int* in_sizes, int n_in, void* d_out, int out_size,
                              void* d_ws, size_t ws_size, hipStream_t stream) {
  static int grid_blocks = 0;
  if (!grid_blocks) {
    int dev = 0, cus = 0, per_cu = 0;
    (void)hipGetDevice(&dev);
    (void)hipDeviceGetAttribute(&cus, hipDeviceAttributeMultiprocessorCount, dev);
    (void)hipFuncSetAttribute((const void*)fwd_mega, hipFuncAttributeMaxDynamicSharedMemorySize, LDS_BYTES);
    (void)hipOccupancyMaxActiveBlocksPerMultiprocessor(&per_cu, (const void*)fwd_mega, 512, LDS_BYTES);
    (void)hipGetLastError();
    grid_blocks = cus > 0 ? cus : 256;
    if (ws_size < WS_NEED2 || n_in != 26) { fprintf(stderr, "kernel_launch: ws_size %zu < %zu or n_in %d != 26\n", ws_size, (size_t)WS_NEED, n_in); grid_blocks = -1; }
  }
  if (grid_blocks < 0) return;
  Params p{};
  for (int i = 0; i < 26; ++i) p.in[i] = (const float*)d_in[i];
  p.out = (float*)d_out; p.ws = (unsigned char*)d_ws;
  (void)hipMemsetAsync((unsigned char*)d_ws + OFF_CNT, 0, 256 + 3456 * 4, stream);
  void* args[] = {&p};
  hipError_t e = hipLaunchCooperativeKernel((const void*)fwd_mega, dim3(grid_blocks), dim3(512), args, LDS_BYTES, stream);
  if (e != hipSuccess) fprintf(stderr, "cooperative launch failed: %s (grid %d)\n", hipGetErrorString(e), grid_blocks);
}
```

```cpp
#include <hip/hip_runtime.h>
#include <hip/hip_cooperative_groups.h>
#include <cstdio>
namespace cg = cooperative_groups;

#define LAS __attribute__((address_space(3)))
typedef unsigned short bf16_t;
typedef short bf16x8 __attribute__((ext_vector_type(8)));
typedef short bf16x4 __attribute__((ext_vector_type(4)));
typedef float f32x4 __attribute__((ext_vector_type(4)));
typedef unsigned u32x2 __attribute__((ext_vector_type(2)));
typedef unsigned u32x4 __attribute__((ext_vector_type(4)));

constexpr int D = 1024, FF = 2816, SEQ = 16384, MX = 32768, MC = 512, MR = MX + MC, CTXL = 256;
constexpr int NMOD = 9216;
constexpr int EVIN_N = 1792;
constexpr int LDS_BYTES = 131072 + 64;
constexpr int NCH = 544;

constexpr size_t SZ_W1 = (size_t)2 * FF * D * 2;
constexpr size_t SZ_W2 = (size_t)D * FF * 2;
constexpr size_t OFF_W1 = 0;
constexpr size_t OFF_W2 = OFF_W1 + 4 * SZ_W1;
constexpr size_t OFF_EVIN = OFF_W2 + 4 * SZ_W2;
constexpr size_t OFF_EVOUT = OFF_EVIN + (size_t)EVIN_N * D * 2;
constexpr size_t OFF_ODIN = OFF_EVOUT + (size_t)D * D * 2;
constexpr size_t OFF_ODOUT = OFF_ODIN + (size_t)2048 * D * 2;
constexpr size_t OFF_RGW = OFF_ODOUT + (size_t)D * D * 2;
constexpr size_t OFF_GMWS = OFF_RGW + (size_t)4096 * 256 * 2;
constexpr size_t OFF_MOD = OFF_GMWS + (size_t)4 * 128 * 128 * 2;
constexpr size_t OFF_ROPE = OFF_MOD + (size_t)2 * 3 * NMOD * 4;
constexpr size_t OFF_SP = OFF_ROPE + (size_t)256 * 16 * 2 * 4;
constexpr size_t OFF_GS = OFF_SP + (size_t)2 * 1024 * 4;
constexpr size_t OFF_BIASF = OFF_GS + (size_t)2 * 3 * 3 * 1024 * 4;
constexpr size_t OFF_BIASE = OFF_BIASF + (size_t)4 * 3 * 5632 * 4;
constexpr size_t OFF_BIASO = OFF_BIASE + (size_t)3 * 1792 * 4;
constexpr size_t OFF_RS = OFF_BIASO + (size_t)3 * 2048 * 4;
constexpr size_t OFF_CNT = OFF_RS + (size_t)2 * MR * 4;
constexpr size_t OFF_BAR = OFF_CNT + 256;
constexpr size_t OFF_CTXR = OFF_BAR + 3456 * 4;
constexpr size_t OFF_PE = OFF_CTXR + (size_t)MC * D * 4;
constexpr size_t SZ_CARRY = (size_t)2 * 2 * NCH * 1024 * 4;
constexpr size_t OFF_HIN = OFF_PE + 2 * SZ_CARRY;
constexpr size_t OFF_H = OFF_HIN + SZ_CARRY;
constexpr size_t SZ_ROWS = (size_t)MR * D * 2;
constexpr size_t OFF_BIG = OFF_H + SZ_ROWS;
constexpr size_t SZ_ACT = (size_t)MR * FF * 2;
constexpr size_t OFF_EXTRA = OFF_BIG + SZ_ACT;
constexpr size_t OFF_UZ = OFF_BIG;
constexpr size_t OFF_Q = OFF_UZ + SZ_ROWS;
constexpr size_t OFF_K = OFF_Q + SZ_ROWS / 2;
constexpr size_t OFF_V = OFF_K + SZ_ROWS / 8;
constexpr size_t OFF_MIXE = OFF_EXTRA;
constexpr size_t OFF_G = OFF_BIG;
constexpr size_t OFF_XX = OFF_G + SZ_ROWS;
constexpr size_t OFF_XC = OFF_H;
constexpr size_t OFF_LAB = OFF_XX;
constexpr size_t OFF_MIXO = OFF_LAB;
constexpr size_t WS_NEED = OFF_LAB + 4 * SZ_ROWS;
constexpr size_t OFF_RSP = OFF_LAB + 4 * SZ_ROWS;
constexpr size_t WS_NEED2 = OFF_RSP + (size_t)MR * 16 * 4;
static_assert(OFF_MIXE + SZ_ROWS <= WS_NEED, "ws");
static_assert(WS_NEED2 <= (size_t)536870912, "workspace budget 2");
static_assert(WS_NEED <= (size_t)536870912, "workspace budget");

struct Params { const float* in[26]; float* out; unsigned char* ws; };
typedef const Params __attribute__((address_space(4))) * PK;
__device__ __forceinline__ PK get_pk() { PK pk = (PK)__builtin_amdgcn_kernarg_segment_ptr(); asm volatile("" : "+s"(pk)); return pk; }
__device__ __forceinline__ int launder_i(int v) { asm volatile("" : "+s"(v)); return v; }
__device__ __forceinline__ float launder_f(float v) { asm volatile("" : "+s"(v)); return v; }
__device__ __forceinline__ int launder_v(int v) { asm volatile("" : "+v"(v)); return v; }
#define TID_X tid_l
enum { I_X = 0, I_C, I_CTX, I_CCTX, I_ADAW, I_ADAB, I_NORMG, I_WG, I_WU, I_WD, I_EVIN, I_EVOUT, I_GMG, I_GMWS, I_GMBS, I_SINK,
       I_ODIN, I_ODOUT, I_CONVW, I_CONVB, I_RGWA, I_RGBA, I_RGWX, I_RGBX, I_LAM, I_FNG };

__device__ __forceinline__ unsigned cvt_pk_bf16(float lo, float hi) { unsigned r; asm volatile("v_cvt_pk_bf16_f32 %0, %1, %2" : "=v"(r) : "v"(lo), "v"(hi)); return r; }
__device__ __forceinline__ bf16_t f2bf(float f) { return (bf16_t)(cvt_pk_bf16(f, 0.f) & 0xffffu); }
__device__ __forceinline__ float bf2f(bf16_t b) { return __uint_as_float(((unsigned)b) << 16); }
__device__ __forceinline__ float bflo(unsigned w) { return __uint_as_float(w << 16); }
__device__ __forceinline__ float bfhi(unsigned w) { return __uint_as_float(w & 0xffff0000u); }
__device__ __forceinline__ u32x2 pack4(f32x4 v) { u32x2 r; r.x = cvt_pk_bf16(v[0], v[1]); r.y = cvt_pk_bf16(v[2], v[3]); return r; }
__device__ __forceinline__ f32x4 unpack4(u32x2 w) { f32x4 r; r[0] = bflo(w.x); r[1] = bfhi(w.x); r[2] = bflo(w.y); r[3] = bfhi(w.y); return r; }
__device__ __forceinline__ float fast_sigmoid(float x) { return __fdividef(1.0f, 1.0f + __expf(-x)); }
__device__ __forceinline__ float gelu_tanh(float x) { const float t = 1.5957691216f * (x + 0.044715f * x * x * x); return x * fast_sigmoid(t); }
__device__ __forceinline__ float shx(float v, int o, int lane) { return __int_as_float(__builtin_amdgcn_ds_bpermute((lane ^ o) << 2, __float_as_int(v))); }
__device__ __forceinline__ float wave_sum(float v, int lane) {
#pragma unroll
  for (int o = 32; o >= 1; o >>= 1) v += shx(v, o, lane);
  return v;
}

namespace pg8 {
constexpr int BM = 256, BK = 64, HALF = 128, HTB = HALF * BK * 2, NXCD = 8, WGM = 8;
__device__ __forceinline__ int lds_byte(int r, int c) { const int st = (r >> 4) * 2 + (c >> 5), rr = r & 15, cc = c & 31, ob = rr * 64 + cc * 2; return st * 1024 + (ob ^ (((ob >> 9) & 1) << 5)); }
__device__ __forceinline__ void stage_rc(int b, int& R, int& C) { const int st = b / 1024, sb = b % 1024, swz = sb ^ (((sb >> 9) & 1) << 5); R = (st >> 1) * 16 + swz / 64; C = (st & 1) * 32 + (swz % 64) / 2; }
__device__ __forceinline__ int perm32(int rho) { const int n = rho >> 4, i = rho & 15; return 8 * (i >> 2) + 4 * n + (i & 3); }
struct Unit { int pm, pn, k0, nk; };
struct Gemm { const bf16_t* A; const bf16_t* Bt; int M, N, K, lda; int bd; int ablk; };
struct StaticOrder {
  int nM, nN, nwg, G, c, ntfull, nslice, nkslice;
  __device__ void init(int M, int N, int K, int G_, int c_) { nM = M / BM; nN = N / BM; nwg = nM * nN; G = G_; c = c_; ntfull = K / BK; nslice = 0; nkslice = 0; }
  __device__ void init_split(int N, int K, int G_, int c_, int S) { nM = 128; nN = N / BM; nwg = nM * nN; G = G_; c = c_; ntfull = K / BK; nslice = S; nkslice = ntfull / S; }
  __device__ bool next(int i, Unit& u) const {
    const long L = (long)i * G + c;
    if (L >= nwg) {
      const int e = (int)(L - nwg);
      if (e >= 2 * nN * nslice) return false;
      const int sl = e % nslice, tl = e / nslice;
      u.pm = 128 + tl / nN; u.pn = tl % nN; u.k0 = sl * nkslice; u.nk = nkslice; return true;
    }
    int wgid = (int)L; { const int q = nwg / NXCD, r = nwg % NXCD, xcd = wgid % NXCD, off = wgid / NXCD; wgid = (xcd < r ? xcd * (q + 1) : r * (q + 1) + (xcd - r) * q) + off; }
    const int nig = WGM * nN, gid = wgid / nig, fm = gid * WGM, gsz = (nM - fm) < WGM ? (nM - fm) : WGM;
    u.pm = fm + ((wgid % nig) % gsz); u.pn = (wgid % nig) / gsz; u.k0 = 0; u.nk = ntfull; return true;
  }
};

template <class Epi>
__device__ __forceinline__ void gemm_phase(LAS unsigned char* lds, const Gemm g, const StaticOrder& S, const Epi& E) { const int tid_l = launder_v((int)threadIdx.x);
  const int tid = tid_l, wid = __builtin_amdgcn_readfirstlane(tid >> 6), lane = tid & 63, wr = wid >> 2, wc = wid & 3, fr = lane & 15, fq = lane >> 4;
  const int K = g.K;
  unsigned voffA[2], voffB[2];
#pragma unroll
  for (int i = 0; i < 2; ++i) { int R, C; stage_rc(tid * 16 + i * 8192, R, C); const int Rb = Epi::PERM ? ((R & ~31) + perm32(R & 31)) : R;
    voffA[i] = (unsigned)(R * (g.ablk ? 64 : g.lda) + C) * 2u; voffB[i] = (unsigned)(Rb * K + C) * 2u; }
  const size_t kstep = (size_t)(BK * 2), kstepA = g.ablk ? (size_t)32768 : kstep;
  const size_t hstepA = g.ablk ? (size_t)16384 : (size_t)HALF * g.lda * 2, hstepB = (size_t)HALF * K * 2;
  const size_t tstepA = g.ablk ? (size_t)(K / BK) * 32768 : 2 * hstepA, tstepB = 2 * hstepB;
  const unsigned ldsw = (unsigned)wid * 1024u;
  const int aoff = lds_byte(wr * 64 + fr, fq * 8), boff = lds_byte(wc * 32 + fr, fq * 8);
#define PG8_SA(b, h) (((b) * 2 + (h)) * HTB)
#define PG8_SB(b, h) ((4 + (b) * 2 + (h)) * HTB)
#define PG8_STAGE(bufoff, gbase, voff) do { _Pragma("unroll") for (int _i = 0; _i < 2; ++_i) \
        __builtin_amdgcn_global_load_lds((const unsigned*)((const char*)(gbase) + (voff)[_i]), (LAS unsigned*)(lds + (bufoff) + ldsw + _i * 8192), 16, 0, 0); } while (0)
#define PG8_LDA(dst, b, h) do { _Pragma("unroll") for (int m = 0; m < 4; ++m) _Pragma("unroll") for (int k = 0; k < 2; ++k) dst[m][k] = *(const LAS bf16x8*)(lds + PG8_SA(b, h) + aoff + m * 2048 + k * 1024); } while (0)
#define PG8_LDB(dst, b, h) do { _Pragma("unroll") for (int n = 0; n < 2; ++n) _Pragma("unroll") for (int k = 0; k < 2; ++k) dst[n][k] = *(const LAS bf16x8*)(lds + PG8_SB(b, h) + boff + n * 2048 + k * 1024); } while (0)
#define PG8_MMA(ai, bj, At, Bt) do { __builtin_amdgcn_s_setprio(1); _Pragma("unroll") for (int m = 0; m < 4; ++m) _Pragma("unroll") for (int n = 0; n < 2; ++n) _Pragma("unroll") for (int k = 0; k < 2; ++k) \
        acc[ai][bj][m][n] = __builtin_amdgcn_mfma_f32_16x16x32_bf16(Bt[n][k], At[m][k], acc[ai][bj][m][n], 0, 0, 0); __builtin_amdgcn_s_setprio(0); } while (0)
#define PG8_WAIT_V(n) asm volatile("s_waitcnt vmcnt(" #n ")" ::: "memory")
#define PG8_WAIT_L(n) asm volatile("s_waitcnt lgkmcnt(" #n ")" ::: "memory")
#define PG8_BAR __builtin_amdgcn_s_barrier()
#define PG8_SCHED __builtin_amdgcn_sched_barrier(0)
#define PG8_ABASE(u) ((const char*)g.A + (size_t)(u).pm * tstepA + (size_t)(u).k0 * kstepA + (g.bd ? (size_t)((((u).pn >> 1) & 3) * 512) : (size_t)0))
#define PG8_BBASE(u) ((const char*)g.Bt + (size_t)(u).pn * tstepB + (size_t)(u).k0 * kstep)
  Unit cur, nxt; int ui = 0;
  if (!S.next(0, cur)) return;
  f32x4 acc[2][2][4][2];
#pragma unroll
  for (int a = 0; a < 2; ++a)
#pragma unroll
    for (int b = 0; b < 2; ++b)
#pragma unroll
      for (int m = 0; m < 4; ++m)
#pragma unroll
        for (int n = 0; n < 2; ++n) acc[a][b][m][n] = (f32x4){0.f, 0.f, 0.f, 0.f};
  bf16x8 At[4][2], B0[2][2], B1[2][2];
  const char* cA = PG8_ABASE(cur); const char* cB = PG8_BBASE(cur);
  PG8_STAGE(PG8_SB(0, 0), cB, voffB); PG8_STAGE(PG8_SA(0, 0), cA, voffA); PG8_STAGE(PG8_SB(0, 1), cB + hstepB, voffB); PG8_STAGE(PG8_SA(0, 1), cA + hstepA, voffA);
  if (wr == 1) PG8_BAR;
  PG8_WAIT_V(4); PG8_BAR;
  PG8_STAGE(PG8_SB(1, 0), cB + kstep, voffB); PG8_STAGE(PG8_SA(1, 0), cA + kstepA, voffA); PG8_STAGE(PG8_SB(1, 1), cB + hstepB + kstep, voffB);
  PG8_WAIT_V(6); PG8_BAR;
  for (;;) {
    const bool has_next = S.next(ui + 1, nxt);
    const char* nA = has_next ? PG8_ABASE(nxt) : cA; const char* nB = has_next ? PG8_BBASE(nxt) : cB;
    const int nt = cur.nk;
#pragma unroll 1
    for (int t = 0; t < nt; t += 2) {
      const bool last = (t == nt - 2);
      const char* a1 = cA + (size_t)(t + 1) * kstepA;
      const char* a2 = last ? nA : cA + (size_t)(t + 2) * kstepA; const char* b2 = last ? nB : cB + (size_t)(t + 2) * kstep;
      const char* a3 = a2 + kstepA; const char* b3 = b2 + kstep;
      PG8_LDB(B0, 0, 0); PG8_SCHED; PG8_LDA(At, 0, 0); PG8_STAGE(PG8_SA(1, 1), a1 + hstepA, voffA);
      PG8_WAIT_L(8); PG8_BAR; PG8_WAIT_L(0); PG8_MMA(0, 0, At, B0); PG8_BAR; PG8_SCHED;
      PG8_LDB(B1, 0, 1); PG8_STAGE(PG8_SB(0, 0), b2, voffB);
      PG8_BAR; PG8_WAIT_L(0); PG8_MMA(0, 1, At, B1); PG8_BAR;
      PG8_LDA(At, 0, 1); PG8_STAGE(PG8_SA(0, 0), a2, voffA);
      PG8_BAR; PG8_WAIT_L(0); PG8_MMA(1, 0, At, B0); PG8_BAR; PG8_SCHED;
      PG8_STAGE(PG8_SB(0, 1), b2 + hstepB, voffB);
      PG8_WAIT_V(6); PG8_BAR; PG8_MMA(1, 1, At, B1); PG8_BAR;
      PG8_LDB(B0, 1, 0); PG8_SCHED; PG8_LDA(At, 1, 0); PG8_STAGE(PG8_SA(0, 1), a2 + hstepA, voffA);
      PG8_WAIT_L(8); PG8_BAR; PG8_WAIT_L(0); PG8_MMA(0, 0, At, B0); PG8_BAR; PG8_SCHED;
      PG8_LDB(B1, 1, 1); PG8_STAGE(PG8_SB(1, 0), b3, voffB);
      PG8_BAR; PG8_WAIT_L(0); PG8_MMA(0, 1, At, B1); PG8_BAR;
      PG8_LDA(At, 1, 1); PG8_STAGE(PG8_SA(1, 0), a3, voffA);
      PG8_BAR; PG8_WAIT_L(0); PG8_MMA(1, 0, At, B0); PG8_BAR; PG8_SCHED;
      PG8_STAGE(PG8_SB(1, 1), b3 + hstepB, voffB);
      PG8_WAIT_V(6); PG8_BAR; PG8_MMA(1, 1, At, B1); PG8_BAR;
    }
    E(acc, cur, wr, wc, fr, fq);
    if (!has_next) break;
#pragma unroll
    for (int a = 0; a < 2; ++a)
#pragma unroll
      for (int b = 0; b < 2; ++b)
#pragma unroll
        for (int m = 0; m < 4; ++m)
#pragma unroll
          for (int n = 0; n < 2; ++n) acc[a][b][m][n] = (f32x4){0.f, 0.f, 0.f, 0.f};
    cur = nxt; cA = nA; cB = nB; ++ui;
  }
  PG8_WAIT_V(0);
  if (wr == 0) PG8_BAR;
  PG8_BAR;
#undef PG8_SA
#undef PG8_SB
#undef PG8_STAGE
#undef PG8_LDA
#undef PG8_LDB
#undef PG8_MMA
#undef PG8_WAIT_V
#undef PG8_WAIT_L
#undef PG8_BAR
#undef PG8_SCHED
#undef PG8_ABASE
#undef PG8_BBASE
}
}
using pg8::Unit;
typedef f32x4 AccT[2][2][4][2];

struct EpiSwiglu {
  static constexpr bool PERM = true;
  bf16_t* act; const float* rs; const float* bias;
  __device__ __forceinline__ void operator()(const AccT& acc, const Unit& u, int wr, int wc, int fr, int fq) const {
    const int row0 = u.pm * 256 + wr * 64 + fr, col0 = u.pn * 128 + wc * 32 + 8 * fq;
    const int mi = u.pm < 64 ? 0 : (u.pm < 128 ? 1 : 2);
    const float* bp = bias + (size_t)mi * (2 * FF) + u.pn * 256 + wc * 32 + 8 * fq;
    f32x4 bg[2], bu[2]; float rv[2][4];
#pragma unroll
    for (int n = 0; n < 2; ++n) { bg[n] = *(const f32x4*)(bp + n * 4); bu[n] = *(const f32x4*)(bp + 128 + n * 4); }
#pragma unroll
    for (int ai = 0; ai < 2; ++ai)
#pragma unroll
      for (int m = 0; m < 4; ++m) rv[ai][m] = rs[row0 + ai * 128 + m * 16];
#pragma unroll
    for (int ai = 0; ai < 2; ++ai)
#pragma unroll
      for (int m = 0; m < 4; ++m) rv[ai][m] = rsqrtf(rv[ai][m] * (1.0f / 1024.0f) + 1e-6f);
#pragma unroll
    for (int ai = 0; ai < 2; ++ai)
#pragma unroll
      for (int m = 0; m < 4; ++m) {
        const int r = row0 + ai * 128 + m * 16;
        bf16_t* rowp = act + ((size_t)(r >> 8) * (FF / 64) + (col0 >> 6)) * 16384 + (size_t)(r & 255) * 64 + (col0 & 63);
        u32x4 ow;
#pragma unroll
        for (int n = 0; n < 2; ++n) {
          const f32x4 gg = acc[ai][0][m][n] * rv[ai][m] + bg[n], uu = acc[ai][1][m][n] * rv[ai][m] + bu[n]; f32x4 v;
#pragma unroll
          for (int j = 0; j < 4; ++j) v[j] = gg[j] * fast_sigmoid(gg[j]) * uu[j];
          const u32x2 pk2 = pack4(v);
          if (n == 0) { ow.x = pk2.x; ow.y = pk2.y; } else { ow.z = pk2.x; ow.w = pk2.y; }
        }
        *(u32x4*)(rowp) = ow;
      }
  }
};
template <bool SRCF32, bool HALF>
struct EpiResid {
  static constexpr bool PERM = true;
  const float* src_f32; bf16_t* xbuf; unsigned char* wsb; int qi;
  __device__ __forceinline__ void operator()(const AccT& acc, const Unit& u, int wr, int wc, int fr, int fq) const {
    unsigned char* w2 = wsb; asm volatile("" : "+s"(w2));
    const int q = qi, l = q / 3, s3 = q - 3 * l;
    const float* gate = (const float*)(w2 + OFF_MOD) + l * 3 * NMOD + (HALF ? 3 * s3 + 2 : 5) * 1024;
    bf16_t* anext = q < 5 ? (bf16_t*)(w2 + OFF_H) : (bf16_t*)nullptr; const float* gsn = (const float*)(w2 + OFF_GS) + (q + 1) * 3072; float* rsp = (float*)(w2 + OFF_RSP);
    const size_t slab_off = HALF ? OFF_EXTRA : OFF_BIG;
    bf16_t* xdst = q < 5 ? xbuf : (bf16_t*)(w2 + OFF_H);
    const int row0 = u.pm * 256 + wr * 64 + fr, col0 = u.pn * 256 + wc * 32 + 8 * fq;
    const int mi = u.pm < 64 ? 0 : (u.pm < 128 ? 1 : 2);
    const float* gp = gate + (size_t)mi * NMOD + col0;
    f32x4 gv[2][2];
#pragma unroll
    for (int bj = 0; bj < 2; ++bj)
#pragma unroll
      for (int n = 0; n < 2; ++n) gv[bj][n] = *(const f32x4*)(gp + bj * 128 + n * 4) * (HALF ? 0.5f : 1.0f);
    if (u.pm < 128) {
      const size_t e0 = (size_t)row0 * D + col0;
      const float* gsp = gsn + mi * 1024 + col0;
      f32x4 gsv[2][2];
#pragma unroll
      for (int bj = 0; bj < 2; ++bj)
#pragma unroll
        for (int n = 0; n < 2; ++n) gsv[bj][n] = anext ? *(const f32x4*)(gsp + bj * 128 + n * 4) : (f32x4){0.f, 0.f, 0.f, 0.f};
      f32x4 xb[2][2][2];
#define RES_LOAD(dst, eoff) do { _Pragma("unroll") for (int bj = 0; bj < 2; ++bj) { \
          if (SRCF32) { dst[bj][0] = *(const f32x4*)(src_f32 + (eoff) + bj * 128); dst[bj][1] = *(const f32x4*)(src_f32 + (eoff) + bj * 128 + 4); } \
          else { const u32x4 w_ = *(const u32x4*)(xbuf + (eoff) + bj * 128); u32x2 lo_, hi_; lo_.x = w_.x; lo_.y = w_.y; hi_.x = w_.z; hi_.y = w_.w; dst[bj][0] = unpack4(lo_); dst[bj][1] = unpack4(hi_); } } } while (0)
      RES_LOAD(xb[0], e0);
#pragma unroll
      for (int st = 0; st < 8; ++st) {
        const int ai = st >> 2, m = st & 3, cur = st & 1, rr = ai * 128 + m * 16;
        if (st < 7) { const int rn = ((st + 1) >> 2) * 128 + ((st + 1) & 3) * 16; RES_LOAD(xb[cur ^ 1], e0 + (size_t)rn * D); }
        float ss = 0.f;
#pragma unroll
        for (int bj = 0; bj < 2; ++bj) {
          const f32x4 x0 = xb[cur][bj][0] + gv[bj][0] * acc[ai][bj][m][0], x1 = xb[cur][bj][1] + gv[bj][1] * acc[ai][bj][m][1];
          const u32x2 p0 = pack4(x0), p1 = pack4(x1);
          u32x4 ow; ow.x = p0.x; ow.y = p0.y; ow.z = p1.x; ow.w = p1.y;
          *(u32x4*)(xdst + e0 + (size_t)rr * D + bj * 128) = ow;
          if (anext) {
            const u32x2 q0 = pack4(x0 * gsv[bj][0]), q1 = pack4(x1 * gsv[bj][1]);
            u32x4 aw; aw.x = q0.x; aw.y = q0.y; aw.z = q1.x; aw.w = q1.y;
            *(u32x4*)(anext + e0 + (size_t)rr * D + bj * 128) = aw;
            ss += x0[0] * x0[0] + x0[1] * x0[1] + x0[2] * x0[2] + x0[3] * x0[3] + x1[0] * x1[0] + x1[1] * x1[1] + x1[2] * x1[2] + x1[3] * x1[3];
          }
        }
        if (anext) { ss += shx(ss, 16, fr + 16 * fq); ss += shx(ss, 32, fr + 16 * fq); if (fq == 0) rsp[(size_t)(row0 + rr) * 16 + u.pn * 4 + wc] = ss; }
      }
#undef RES_LOAD
    } else {
#pragma unroll
      for (int ai = 0; ai < 2; ++ai)
#pragma unroll
        for (int m = 0; m < 4; ++m) {
          float* d = (float*)(w2 + slab_off) + (size_t)(u.k0 / u.nk) * MC * D + (size_t)(row0 + ai * 128 + m * 16 - MX) * D + col0;
#pragma unroll
          for (int bj = 0; bj < 2; ++bj)
#pragma unroll
            for (int n = 0; n < 2; ++n) *(f32x4*)(d + bj * 128 + n * 4) = gv[bj][n] * acc[ai][bj][m][n];
        }
    }
  }
};
struct EpiEvenIn {
  static constexpr bool PERM = false;
  bf16_t* UZ; bf16_t* Q; bf16_t* Kb; bf16_t* Vb; const float* ropeC; const float* ropeS; const float* rs; const float* bias;
  __device__ __forceinline__ void operator()(const AccT& acc, const Unit& u, int wr, int wc, int fr, int fq) const {
    const int row0 = u.pm * 256 + wr * 64 + fr;
    const int mi = u.pm < 64 ? 0 : (u.pm < 128 ? 1 : 2);
    const float* bp = bias + (size_t)mi * EVIN_N + u.pn * 256 + wc * 32 + 4 * fq;
    f32x4 bv[2][2]; float rv[2][4];
#pragma unroll
    for (int bj = 0; bj < 2; ++bj)
#pragma unroll
      for (int n = 0; n < 2; ++n) bv[bj][n] = *(const f32x4*)(bp + bj * 128 + n * 16);
#pragma unroll
    for (int ai = 0; ai < 2; ++ai)
#pragma unroll
      for (int m = 0; m < 4; ++m) rv[ai][m] = rs[row0 + ai * 128 + m * 16];
#pragma unroll
    for (int ai = 0; ai < 2; ++ai)
#pragma unroll
      for (int m = 0; m < 4; ++m) rv[ai][m] = rsqrtf(rv[ai][m] * (1.0f / 1024.0f) + 1e-6f);
    if (u.pn < 4) {
      const int col0 = u.pn * 256 + wc * 32 + 4 * fq;
#pragma unroll
      for (int ai = 0; ai < 2; ++ai)
#pragma unroll
        for (int m = 0; m < 4; ++m) {
          const int r = row0 + ai * 128 + m * 16;
          bf16_t* rowp = UZ + (size_t)r * D + col0;
#pragma unroll
          for (int bj = 0; bj < 2; ++bj)
#pragma unroll
            for (int n = 0; n < 2; ++n) { f32x4 v = acc[ai][bj][m][n] * rv[ai][m] + bv[bj][n];
#pragma unroll
              for (int j = 0; j < 4; ++j) v[j] = gelu_tanh(v[j]);
              *(u32x2*)(rowp + bj * 128 + n * 16) = pack4(v); }
        }
    } else {
      const bool rope_on = u.pm < 128;
      const bool by_col = (wc & 1) != 0;
      f32x4 csb[2], snb[2];
      { const int pos = row0 & (SEQ - 1); const int pidx = by_col ? (pos & 63) : (pos >> 6);
        csb[0] = *(const f32x4*)(ropeC + pidx * 16 + 4 * fq); snb[0] = *(const f32x4*)(ropeS + pidx * 16 + 4 * fq); }
#pragma unroll
      for (int st = 0; st < 8; ++st) {
        const int ai = st >> 2, m = st & 3, cur = st & 1;
        const int r = row0 + ai * 128 + m * 16;
        if (st < 7) { const int rn = row0 + ((st + 1) >> 2) * 128 + ((st + 1) & 3) * 16; const int pos = rn & (SEQ - 1); const int pidx = by_col ? (pos & 63) : (pos >> 6);
          csb[cur ^ 1] = *(const f32x4*)(ropeC + pidx * 16 + 4 * fq); snb[cur ^ 1] = *(const f32x4*)(ropeS + pidx * 16 + 4 * fq); }
        f32x4 cs = csb[cur], sn = snb[cur];
        if (!rope_on) { cs = (f32x4){1.f, 1.f, 1.f, 1.f}; sn = (f32x4){0.f, 0.f, 0.f, 0.f}; }
#pragma unroll
        for (int bj = 0; bj < 2; ++bj) {
          const f32x4 x1 = acc[ai][bj][m][0] * rv[ai][m] + bv[bj][0], x2 = acc[ai][bj][m][1] * rv[ai][m] + bv[bj][1];
          if (u.pn < 6) {
            const f32x4 o1 = (x1 * cs - x2 * sn) * 0.18033688011112042f, o2 = (x1 * sn + x2 * cs) * 0.18033688011112042f;
            bf16_t* qp = Q + (size_t)r * 512 + (u.pn - 4) * 256 + bj * 128 + wc * 32 + 4 * fq;
            *(u32x2*)(qp) = pack4(o1); *(u32x2*)(qp + 16) = pack4(o2);
          } else if (bj == 0) {
            const f32x4 o1 = x1 * cs - x2 * sn, o2 = x1 * sn + x2 * cs;
            bf16_t* kp = Kb + (size_t)r * 128 + wc * 32 + 4 * fq;
            *(u32x2*)(kp) = pack4(o1); *(u32x2*)(kp + 16) = pack4(o2);
          } else {
            bf16_t* vp = Vb + (size_t)r * 128 + wc * 32 + 4 * fq;
            *(u32x2*)(vp) = pack4(x1); *(u32x2*)(vp + 16) = pack4(x2);
          }
        }
      }
    }
  }
};
struct EpiOddIn {
  static constexpr bool PERM = false;
  bf16_t* G; bf16_t* XX; const float* rs; const float* bias;
  __device__ __forceinline__ void operator()(const AccT& acc, const Unit& u, int wr, int wc, int fr, int fq) const {
    const int row0 = u.pm * 256 + wr * 64 + fr;
    const int mi = u.pm < 64 ? 0 : (u.pm < 128 ? 1 : 2);
    const float* bp = bias + (size_t)mi * 2048 + u.pn * 256 + wc * 32 + 4 * fq;
    f32x4 bv[2][2];
#pragma unroll
    for (int bj = 0; bj < 2; ++bj)
#pragma unroll
      for (int n = 0; n < 2; ++n) bv[bj][n] = *(const f32x4*)(bp + bj * 128 + n * 16);
    float rvv[2][4];
#pragma unroll
    for (int ai = 0; ai < 2; ++ai)
#pragma unroll
      for (int m = 0; m < 4; ++m) rvv[ai][m] = rs[row0 + ai * 128 + m * 16];
#pragma unroll
    for (int ai = 0; ai < 2; ++ai)
#pragma unroll
      for (int m = 0; m < 4; ++m) rvv[ai][m] = rsqrtf(rvv[ai][m] * (1.0f / 1024.0f) + 1e-6f);
    const bool isg = u.pn < 4;
    bf16_t* base = isg ? G : XX;
    const int col0 = (u.pn & 3) * 256 + wc * 32 + 4 * fq;
#pragma unroll
    for (int ai = 0; ai < 2; ++ai)
#pragma unroll
      for (int m = 0; m < 4; ++m) {
        const int r = row0 + ai * 128 + m * 16;
        const float rv = rvv[ai][m];
        bf16_t* rowp = base + (size_t)r * D + col0;
#pragma unroll
        for (int bj = 0; bj < 2; ++bj)
#pragma unroll
          for (int n = 0; n < 2; ++n) { f32x4 v = acc[ai][bj][m][n] * rv + bv[bj][n];
            if (isg) {
#pragma unroll
              for (int j = 0; j < 4; ++j) v[j] = gelu_tanh(v[j]); }
            *(u32x2*)(rowp + bj * 128 + n * 16) = pack4(v); }
      }
  }
};
struct EpiRG {
  static constexpr bool PERM = false;
  const bf16_t* XC; bf16_t* LAB; const float* ba; const float* bx; const float* sp;
  __device__ __forceinline__ void operator()(const AccT& acc, const Unit& u, int wr, int wc, int fr, int fq) const {
    const int row0 = u.pm * 256 + wr * 64 + fr;
    const int d = u.pn >> 3, h = (u.pn >> 1) & 3, cb = u.pn & 1;
    const int ch0 = h * 256 + cb * 128 + wc * 32 + 4 * fq;
    bf16_t* LA = LAB + (size_t)(2 * d) * MR * D; bf16_t* BB = LA + (size_t)MR * D;
    f32x4 bav[2], bxv[2], spv[2]; u32x2 xw[2][2][4];
#pragma unroll
    for (int n = 0; n < 2; ++n) { bav[n] = *(const f32x4*)(ba + d * 1024 + ch0 + n * 16); bxv[n] = *(const f32x4*)(bx + d * 1024 + ch0 + n * 16); spv[n] = *(const f32x4*)(sp + d * 1024 + ch0 + n * 16); }
#pragma unroll
    for (int ai = 0; ai < 2; ++ai)
#pragma unroll
      for (int m = 0; m < 4; ++m) xw[0][ai][m] = *(const u32x2*)(XC + (size_t)(row0 + ai * 128 + m * 16) * D + ch0);
#pragma unroll
    for (int n = 0; n < 2; ++n)
#pragma unroll
      for (int ai = 0; ai < 2; ++ai)
#pragma unroll
        for (int m = 0; m < 4; ++m) {
          const size_t ro = (size_t)(row0 + ai * 128 + m * 16) * D + ch0 + n * 16;
          if (n == 0) xw[1][ai][m] = *(const u32x2*)(XC + ro + 16);
          const f32x4 xv = unpack4(xw[n][ai][m]);
          f32x4 la, bb;
#pragma unroll
          for (int j = 0; j < 4; ++j) {
            const float rr = fast_sigmoid(acc[ai][0][m][n][j] + bav[n][j]), ii = fast_sigmoid(acc[ai][1][m][n][j] + bxv[n][j]);
            const float l = rr * spv[n][j];
            la[j] = l; bb[j] = __fsqrt_rn(fmaxf(1.0f - __expf(2.0f * l), 0.f)) * ii * xv[j];
          }
          *(u32x2*)(LA + ro) = pack4(la); *(u32x2*)(BB + ro) = pack4(bb);
        }
  }
};

__device__ __forceinline__ void cvt_tile(const float* src, int ld, bf16_t* dst, int ldd, LAS float* tile) { const int tid_l = launder_v((int)threadIdx.x);
  const int t = tid_l, a = t >> 6, b = t & 63;
#pragma unroll
  for (int i = 0; i < 8; ++i) tile[(i * 8 + a) * 65 + b] = src[(size_t)(i * 8 + a) * ld + b];
  __syncthreads();
#pragma unroll
  for (int i = 0; i < 8; ++i) dst[(size_t)(i * 8 + a) * ldd + b] = f2bf(tile[b * 65 + i * 8 + a]);
  __syncthreads();
}
__device__ __forceinline__ void sincos_taylor(double r, double& s, double& c) {
  const double r2 = r * r; double ts = r, tc = 1.0; s = r; c = 1.0;
  for (int i = 1; i <= 15; ++i) { tc = -tc * r2 / (double)((2 * i - 1) * (2 * i)); ts = -ts * r2 / (double)((2 * i) * (2 * i + 1)); c += tc; s += ts; }
}
__device__ __forceinline__ void prologue(PK pk, LAS unsigned char* lds, const int bid, const int nb) { const int tid_l = launder_v((int)threadIdx.x);
  unsigned char* ws = pk->ws;
  const int tid = tid_l;
  LAS float* tile = (LAS float*)lds;
  LAS float* sc = (LAS float*)(lds + 16640);
  LAS float* red = (LAS float*)(lds + 16640 + 12288);
  for (int i = tid; i < 3072; i += 512) { const int v = i >> 10, k = i & 1023; const float x = v < 2 ? pk->in[I_C][v * 1024 + k] : pk->in[I_CCTX][k]; sc[i] = x * fast_sigmoid(x); }
  __syncthreads();
  float* mod = (float*)(ws + OFF_MOD);
  for (int it = bid; it < 288; it += nb) {
    const int l = it / 144, cb = it % 144, kg = tid >> 6, j = tid & 63;
    const float* w = pk->in[I_ADAW] + (size_t)l * D * NMOD + (size_t)(kg * 128) * NMOD + cb * 64 + j;
    float a0 = 0.f, a1 = 0.f, a2 = 0.f;
    for (int k = 0; k < 128; ++k) { const float wv = w[(size_t)k * NMOD]; a0 += sc[kg * 128 + k] * wv; a1 += sc[1024 + kg * 128 + k] * wv; a2 += sc[2048 + kg * 128 + k] * wv; }
    red[(kg * 3 + 0) * 64 + j] = a0; red[(kg * 3 + 1) * 64 + j] = a1; red[(kg * 3 + 2) * 64 + j] = a2;
    __syncthreads();
    if (tid < 192) { const int v = tid >> 6, jj = tid & 63; float s = pk->in[I_ADAB][l * NMOD + cb * 64 + jj];
      for (int q = 0; q < 8; ++q) s += red[(q * 3 + v) * 64 + jj];
      mod[((size_t)l * 3 + v) * NMOD + cb * 64 + jj] = s; }
    __syncthreads();
  }
  { float* rc = (float*)(ws + OFF_ROPE); float* rs = rc + 4096;
    for (int i = bid * 512 + tid; i < 4096; i += nb * 512) { const int pp = i >> 4, f = i & 15;
      const float inv = powf(10000.0f, -(float)f / 16.0f); const float ang = (float)pp * inv;
      const double ad = (double)ang; const double kq = rint(ad * 0.15915494309189535); const double r = ad - kq * 6.283185307179586477;
      double s, c; sincos_taylor(r, s, c); rc[i] = (float)c; rs[i] = (float)s; } }
  { float* sp = (float*)(ws + OFF_SP); for (int i = bid * 512 + tid; i < 2048; i += nb * 512) sp[i] = -8.0f * log1pf(expf(-pk->in[I_LAM][i])); }
  { float* cr = (float*)(ws + OFF_CTXR); const float* ci = pk->in[I_CTX]; for (int i = bid * 512 + tid_l; i < MC * D / 4; i += nb * 512) *(f32x4*)(cr + 4 * (size_t)i) = *(const f32x4*)(ci + 4 * (size_t)i); }
  { bf16_t* o = (bf16_t*)(ws + OFF_GMWS); for (int i = bid * 512 + tid; i < 65536; i += nb * 512) o[i] = f2bf(pk->in[I_GMWS][i]); }
  for (int ti = bid; ti < 10176; ti += nb) {
    int r = ti;
    if (r < 5632) { const int j = r / 1408, rem = r % 1408, nbk = rem >> 4, kb = rem & 15, pn = nbk >> 2, sub = nbk & 3;
      const float* src = (sub < 2 ? pk->in[I_WG] : pk->in[I_WU]) + (size_t)j * D * FF + (size_t)(kb * 64) * FF + pn * 128 + (sub & 1) * 64;
      cvt_tile(src, FF, (bf16_t*)(ws + OFF_W1 + j * SZ_W1) + (size_t)(nbk * 64) * D + kb * 64, D, tile); continue; }
    r -= 5632;
    if (r < 2816) { const int j = r / 704, rem = r % 704, nbk = rem / 44, kb = rem % 44;
      const float* src = pk->in[I_WD] + (size_t)j * FF * D + (size_t)(kb * 64) * D + nbk * 64;
      cvt_tile(src, D, (bf16_t*)(ws + OFF_W2 + j * SZ_W2) + (size_t)(nbk * 64) * FF + kb * 64, FF, tile); continue; }
    r -= 2816;
    if (r < 448) { const int nbk = r >> 4, kb = r & 15;
      cvt_tile(pk->in[I_EVIN] + (size_t)(kb * 64) * EVIN_N + nbk * 64, EVIN_N, (bf16_t*)(ws + OFF_EVIN) + (size_t)(nbk * 64) * D + kb * 64, D, tile); continue; }
    r -= 448;
    if (r < 256) { const int nbk = r >> 4, kb = r & 15;
      cvt_tile(pk->in[I_EVOUT] + (size_t)(kb * 64) * D + nbk * 64, D, (bf16_t*)(ws + OFF_EVOUT) + (size_t)(nbk * 64) * D + kb * 64, D, tile); continue; }
    r -= 256;
    if (r < 512) { const int nbk = r >> 4, kb = r & 15;
      cvt_tile(pk->in[I_ODIN] + (size_t)(kb * 64) * 2048 + nbk * 64, 2048, (bf16_t*)(ws + OFF_ODIN) + (size_t)(nbk * 64) * D + kb * 64, D, tile); continue; }
    r -= 512;
    if (r < 256) { const int nbk = r >> 4, kb = r & 15;
      cvt_tile(pk->in[I_ODOUT] + (size_t)(kb * 64) * D + nbk * 64, D, (bf16_t*)(ws + OFF_ODOUT) + (size_t)(nbk * 64) * D + kb * 64, D, tile); continue; }
    r -= 256;
    { const int nbk = r >> 2, kb = r & 3, t = nbk >> 2, sub = nbk & 3, d = t >> 3, h = (t >> 1) & 3, cb = t & 1;
      const float* src = (sub < 2 ? pk->in[I_RGWA] : pk->in[I_RGWX]) + (size_t)(d * 4 + h) * 65536 + (size_t)(kb * 64) * 256 + cb * 128 + (sub & 1) * 64;
      cvt_tile(src, 256, (bf16_t*)(ws + OFF_RGW) + (size_t)(nbk * 64) * 256 + kb * 64, 256, tile); }
  }
}

__device__ __forceinline__ void phase_prep(const float* src_lat, float* src_ctx, const float* gs, bf16_t* h, float* rs, int r0, const float* slab, int nslab, const float* rsp, bool reduce_lat, const int bid, const int nb) { const int tid_l = launder_v((int)threadIdx.x);
  const int lane = tid_l & 63, wv = tid_l >> 6;
  for (int rb = r0 + (bid * 8 + wv) * 2; rb < MR; rb += nb * 16) {
    f32x4 v[2][4];
#pragma unroll
    for (int q = 0; q < 2; ++q) { const int r = rb + q; const float* xr = r < MX ? src_lat + (size_t)r * D : src_ctx + (size_t)(r - MX) * D;
#pragma unroll
      for (int i = 0; i < 4; ++i) v[q][i] = *(const f32x4*)(xr + i * 256 + lane * 4); }
    if (rb >= MX && nslab > 0) {
      for (int sl = 0; sl < nslab; ++sl)
#pragma unroll
        for (int q = 0; q < 2; ++q)
#pragma unroll
          for (int i = 0; i < 4; ++i) v[q][i] = v[q][i] + *(const f32x4*)(slab + ((size_t)sl * MC + (rb + q - MX)) * D + i * 256 + lane * 4);
#pragma unroll
      for (int q = 0; q < 2; ++q)
#pragma unroll
        for (int i = 0; i < 4; ++i) *(f32x4*)(src_ctx + (size_t)(rb + q - MX) * D + i * 256 + lane * 4) = v[q][i];
    }
#pragma unroll
    for (int q = 0; q < 2; ++q) { const int r = rb + q; const int mi = r < SEQ ? 0 : (r < MX ? 1 : 2);
      float ss = 0.f;
#pragma unroll
      for (int i = 0; i < 4; ++i) { ss += v[q][i][0] * v[q][i][0] + v[q][i][1] * v[q][i][1] + v[q][i][2] * v[q][i][2] + v[q][i][3] * v[q][i][3];
        const f32x4 g4 = *(const f32x4*)(gs + mi * 1024 + i * 256 + lane * 4);
        *(u32x2*)(h + (size_t)r * D + i * 256 + lane * 4) = pack4(v[q][i] * g4); }
      ss = wave_sum(ss, lane);
      if (lane == 0) rs[r] = ss; }
  }
  if (reduce_lat) {
    for (int r = bid * 512 + tid_l; r < MX; r += nb * 512) {
      const f32x4 a = *(const f32x4*)(rsp + (size_t)r * 16), b = *(const f32x4*)(rsp + (size_t)r * 16 + 4), c = *(const f32x4*)(rsp + (size_t)r * 16 + 8), d = *(const f32x4*)(rsp + (size_t)r * 16 + 12);
      rs[r] = ((((a[0] + a[1]) + (a[2] + a[3])) + ((b[0] + b[1]) + (b[2] + b[3]))) + (((c[0] + c[1]) + (c[2] + c[3])) + ((d[0] + d[1]) + (d[2] + d[3]))));
    }
  }
}
__device__ __forceinline__ void prologue2(PK pk, const int bid, const int nb) { const int tid_l = launder_v((int)threadIdx.x);
  unsigned char* ws = pk->ws; const float* mod = (const float*)(ws + OFF_MOD);
  { float* gs = (float*)(ws + OFF_GS);
    for (int i = bid * 512 + tid_l; i < 2 * 3 * 3 * 1024; i += nb * 512) { const int c = i & 1023, mi = (i >> 10) % 3, lj = i / 3072, l = lj / 3, j = lj % 3;
      gs[i] = pk->in[I_NORMG][(size_t)(l * 3 + j) * D + c] * (1.0f + mod[(size_t)(l * 3 + mi) * NMOD + (3 * j + 1) * 1024 + c]); } }
  const int lane = tid_l & 63, wv = tid_l >> 6;
  for (int t = bid * 8 + wv; t < 4 * 5632 + 1792 + 2048; t += nb * 8) {
    const bf16_t* wrow; float* bo; int l, j, n, ncols;
    if (t < 4 * 5632) { const int j4 = t / 5632; n = t % 5632; l = j4 >> 1; j = (j4 & 1) * 2; ncols = 5632; wrow = (const bf16_t*)(ws + OFF_W1 + j4 * SZ_W1) + (size_t)n * D; bo = (float*)(ws + OFF_BIASF) + (size_t)j4 * 3 * 5632; }
    else if (t < 4 * 5632 + 1792) { n = t - 4 * 5632; l = 0; j = 1; ncols = 1792; wrow = (const bf16_t*)(ws + OFF_EVIN) + (size_t)n * D; bo = (float*)(ws + OFF_BIASE); }
    else { n = t - 4 * 5632 - 1792; l = 1; j = 1; ncols = 2048; wrow = (const bf16_t*)(ws + OFF_ODIN) + (size_t)n * D; bo = (float*)(ws + OFF_BIASO); }
    const u32x4 w0 = *(const u32x4*)(wrow + lane * 16), w1 = *(const u32x4*)(wrow + lane * 16 + 8);
    const float wf[16] = {bflo(w0.x), bfhi(w0.x), bflo(w0.y), bfhi(w0.y), bflo(w0.z), bfhi(w0.z), bflo(w0.w), bfhi(w0.w), bflo(w1.x), bfhi(w1.x), bflo(w1.y), bfhi(w1.y), bflo(w1.z), bfhi(w1.z), bflo(w1.w), bfhi(w1.w)};
#pragma unroll
    for (int mi = 0; mi < 3; ++mi) { const float* sh = mod + (size_t)(l * 3 + mi) * NMOD + (3 * j) * 1024 + lane * 16; float a = 0.f;
#pragma unroll
      for (int q = 0; q < 4; ++q) { const f32x4 s4 = *(const f32x4*)(sh + 4 * q); a += s4[0] * wf[4 * q] + s4[1] * wf[4 * q + 1] + s4[2] * wf[4 * q + 2] + s4[3] * wf[4 * q + 3]; }
      a = wave_sum(a, lane);
      if (lane == 0) bo[(size_t)mi * ncols + n] = a; }
  }
}
__device__ __forceinline__ void phase_final_norm(float* out, const bf16_t* xb, const float* g, const int bid, const int nb) { const int tid_l = launder_v((int)threadIdx.x);
  const int lane = tid_l & 63, wv = tid_l >> 6;
  f32x4 gv[2][2];
#pragma unroll
  for (int i = 0; i < 2; ++i) { gv[i][0] = *(const f32x4*)(g + i * 512 + lane * 8); gv[i][1] = *(const f32x4*)(g + i * 512 + lane * 8 + 4); }
  for (int rb = (bid * 8 + wv) * 8; rb < MX; rb += nb * 64) {
    u32x4 w[8][2];
#pragma unroll
    for (int q = 0; q < 8; ++q)
#pragma unroll
      for (int i = 0; i < 2; ++i) w[q][i] = *(const u32x4*)(xb + (size_t)(rb + q) * D + i * 512 + lane * 8);
#pragma unroll
    for (int q = 0; q < 8; ++q) {
      f32x4 v[2][2]; float ss = 0.f;
#pragma unroll
      for (int i = 0; i < 2; ++i) { u32x2 lo, hi; lo.x = w[q][i].x; lo.y = w[q][i].y; hi.x = w[q][i].z; hi.y = w[q][i].w; v[i][0] = unpack4(lo); v[i][1] = unpack4(hi);
#pragma unroll
        for (int h = 0; h < 2; ++h) ss += v[i][h][0] * v[i][h][0] + v[i][h][1] * v[i][h][1] + v[i][h][2] * v[i][h][2] + v[i][h][3] * v[i][h][3]; }
      ss = wave_sum(ss, lane);
      const float rstd = rsqrtf(ss * (1.0f / 1024.0f) + 1e-6f);
#pragma unroll
      for (int i = 0; i < 2; ++i)
#pragma unroll
        for (int h = 0; h < 2; ++h) *(f32x4*)(out + (size_t)(rb + q) * D + i * 512 + lane * 8 + h * 4) = v[i][h] * rstd * gv[i][h]; }
  }
}

constexpr int VSTR = 648;
__device__ __forceinline__ void attn_unit(PK pk, int u, LAS unsigned char* lds) { const int tid_l = launder_v((int)threadIdx.x);
  const bf16_t* Q = (const bf16_t*)(pk->ws + OFF_Q); const bf16_t* Kb = (const bf16_t*)(pk->ws + OFF_K); const bf16_t* Vb = (const bf16_t*)(pk->ws + OFF_V);
  bf16_t* MIX = (bf16_t*)(pk->ws + OFF_MIXE);
  const int tid = tid_l, wv = tid >> 6, lane = tid & 63, fr = lane & 15, fq = lane >> 4;
  const bool is_ctx = u >= 512;
  int b, qb, kvh;
  if (!is_ctx) { b = u >> 8; qb = (u >> 1) & 127; kvh = u & 1; } else { const int j = u - 512; b = j >> 2; qb = (j >> 1) & 1; kvh = j & 1; }
  const int qrow0 = is_ctx ? MX + b * CTXL + qb * 128 : b * SEQ + qb * 128;
  LAS bf16_t* VT = (LAS bf16_t*)lds;
#pragma unroll 1
  for (int c = 0; c < 5; ++c) {
    const bool active = c >= 3 ? true : (is_ctx ? false : (c == 0 ? qb > 0 : (c == 2 ? qb < 127 : true)));
    if (!active) continue;
    const int base = c >= 3 ? MX + b * CTXL + (c - 3) * 128 : qrow0 + (c - 1) * 128;
    const int kp = tid & 63, oc = tid >> 6;
    const bf16_t* vsrc = Vb + (size_t)(base + 2 * kp) * 128 + kvh * 64 + oc * 8;
    const u32x4 v0 = *(const u32x4*)(vsrc), v1 = *(const u32x4*)(vsrc + 128);
    LAS unsigned* vdst = (LAS unsigned*)(VT + (oc * 8) * VSTR + c * 128 + 2 * kp);
    vdst[0 * (VSTR / 2)] = (v0.x & 0xffffu) | (v1.x << 16); vdst[1 * (VSTR / 2)] = (v0.x >> 16) | (v1.x & 0xffff0000u);
    vdst[2 * (VSTR / 2)] = (v0.y & 0xffffu) | (v1.y << 16); vdst[3 * (VSTR / 2)] = (v0.y >> 16) | (v1.y & 0xffff0000u);
    vdst[4 * (VSTR / 2)] = (v0.z & 0xffffu) | (v1.z << 16); vdst[5 * (VSTR / 2)] = (v0.z >> 16) | (v1.z & 0xffff0000u);
    vdst[6 * (VSTR / 2)] = (v0.w & 0xffffu) | (v1.w << 16); vdst[7 * (VSTR / 2)] = (v0.w >> 16) | (v1.w & 0xffff0000u);
  }
  __syncthreads();
  const int head = kvh * 4 + (wv >> 1);
  const float LOG2E = 1.4426950408889634f;
  const float sink2 = pk->in[I_SINK][head] * LOG2E;
  LAS unsigned char* KB0 = lds + 83968;
  constexpr int KROW = 144, KBUF = 128 * KROW;
  const int skey = tid >> 2, sseg = (tid & 3) * 2;
#define ATT_ACTIVE(c_) ((c_) >= 3 ? true : (is_ctx ? false : ((c_) == 0 ? qb > 0 : ((c_) == 2 ? qb < 127 : true))))
#define ATT_BASE(c_) ((c_) >= 3 ? MX + b * CTXL + ((c_) - 3) * 128 : qrow0 + ((c_) - 1) * 128)
  int par = 0;
#pragma unroll 1
  for (int hq = 0; hq < 2; ++hq) {
    const int qoff = (wv & 1) * 64 + hq * 32;
    float mrun[2], lrun[2]; f32x4 o[2][4];
#pragma unroll
    for (int qt = 0; qt < 2; ++qt) { mrun[qt] = sink2; lrun[qt] = 0.25f;
#pragma unroll
      for (int dt = 0; dt < 4; ++dt) o[qt][dt] = (f32x4){0.f, 0.f, 0.f, 0.f}; }
    int c = is_ctx ? 3 : (qb > 0 ? 0 : 1);
    { const bf16_t* ks = Kb + (size_t)(ATT_BASE(c) + skey) * 128 + kvh * 64 + sseg * 8;
      const u32x4 a0 = *(const u32x4*)(ks), a1 = *(const u32x4*)(ks + 8);
      LAS unsigned char* kd = KB0 + par * KBUF + skey * KROW + sseg * 16;
      *(LAS u32x4*)(kd) = a0; *(LAS u32x4*)(kd + 16) = a1; }
    __syncthreads();
#pragma unroll 1
    while (c < 5) {
      int cn = c + 1; while (cn < 5 && !ATT_ACTIVE(cn)) ++cn;
      u32x4 n0 = {0u, 0u, 0u, 0u}, n1 = {0u, 0u, 0u, 0u};
      if (cn < 5) { const bf16_t* ks = Kb + (size_t)(ATT_BASE(cn) + skey) * 128 + kvh * 64 + sseg * 8; n0 = *(const u32x4*)(ks); n1 = *(const u32x4*)(ks + 8); }
      const int dlo = c == 0 ? 0 : -100000, dhi = c == 2 ? 0 : 100000;
      const LAS unsigned char* kcur = KB0 + par * KBUF + fr * KROW + fq * 16;
#pragma unroll
      for (int qt = 0; qt < 2; ++qt) {
        const int iq = qoff + qt * 16 + fr; const int dq = 4 * fq - iq;
        const bf16_t* qp = Q + (size_t)(qrow0 + iq) * 512 + head * 64 + fq * 8;
        const bf16x8 q0 = *(const bf16x8*)(qp), q1 = *(const bf16x8*)(qp + 32);
        f32x4 st[8];
        __builtin_amdgcn_s_setprio(1);
#pragma unroll
        for (int kt = 0; kt < 8; ++kt) {
          const bf16x8 k0 = *(const LAS bf16x8*)(kcur + kt * 16 * KROW), k1 = *(const LAS bf16x8*)(kcur + kt * 16 * KROW + 64);
          f32x4 sx = __builtin_amdgcn_mfma_f32_16x16x32_bf16(k0, q0, (f32x4){0.f, 0.f, 0.f, 0.f}, 0, 0, 0);
          st[kt] = __builtin_amdgcn_mfma_f32_16x16x32_bf16(k1, q1, sx, 0, 0, 0);
        }
        __builtin_amdgcn_s_setprio(0);
        float mx = -1e30f;
#pragma unroll
        for (int kt = 0; kt < 8; ++kt)
#pragma unroll
          for (int j = 0; j < 4; ++j) {
            const int df = kt * 16 + j + dq;
            float sv = st[kt][j];
            if (df < dlo || df > dhi) sv = -1e30f;
            st[kt][j] = sv; mx = fmaxf(mx, sv);
          }
        mx = fmaxf(mx, shx(mx, 16, lane)); mx = fmaxf(mx, shx(mx, 32, lane));
        const float mnew = fmaxf(mrun[qt], mx), alpha = exp2f(mrun[qt] - mnew);
        mrun[qt] = mnew;
        float ls = 0.f;
#pragma unroll
        for (int kt = 0; kt < 8; ++kt)
#pragma unroll
          for (int j = 0; j < 4; ++j) { const float pv = exp2f(st[kt][j] - mnew); st[kt][j] = pv; ls += pv; }
        lrun[qt] = lrun[qt] * alpha + ls;
#pragma unroll
        for (int dt = 0; dt < 4; ++dt) o[qt][dt] = o[qt][dt] * alpha;
        __builtin_amdgcn_s_setprio(1);
#pragma unroll
        for (int kk = 0; kk < 4; ++kk) {
          u32x4 pw; pw.x = cvt_pk_bf16(st[2 * kk][0], st[2 * kk][1]); pw.y = cvt_pk_bf16(st[2 * kk][2], st[2 * kk][3]);
          pw.z = cvt_pk_bf16(st[2 * kk + 1][0], st[2 * kk + 1][1]); pw.w = cvt_pk_bf16(st[2 * kk + 1][2], st[2 * kk + 1][3]);
          const bf16x8 pf = __builtin_bit_cast(bf16x8, pw);
#pragma unroll
          for (int dt = 0; dt < 4; ++dt) {
            const LAS bf16_t* vp = VT + (dt * 16 + fr) * VSTR + c * 128 + kk * 32 + 4 * fq;
            u32x4 vw; const u32x2 va = *(const LAS u32x2*)(vp), vb = *(const LAS u32x2*)(vp + 16);
            vw.x = va.x; vw.y = va.y; vw.z = vb.x; vw.w = vb.y;
            o[qt][dt] = __builtin_amdgcn_mfma_f32_16x16x32_bf16(__builtin_bit_cast(bf16x8, vw), pf, o[qt][dt], 0, 0, 0);
          }
        }
        __builtin_amdgcn_s_setprio(0);
      }
      if (cn < 5) { LAS unsigned char* kd = KB0 + (par ^ 1) * KBUF + skey * KROW + sseg * 16; *(LAS u32x4*)(kd) = n0; *(LAS u32x4*)(kd + 16) = n1; }
      __syncthreads();
      c = cn; par ^= 1;
    }
#pragma unroll
    for (int qt = 0; qt < 2; ++qt) {
      float l = lrun[qt]; l += shx(l, 16, lane); l += shx(l, 32, lane);
      const float inv = 1.0f / l;
      bf16_t* op = MIX + (size_t)(qrow0 + qoff + qt * 16 + fr) * D + 512 + head * 64 + 4 * fq;
#pragma unroll
      for (int dt = 0; dt < 4; ++dt) *(u32x2*)(op + dt * 16) = pack4(o[qt][dt] * inv);
    }
  }
  __syncthreads();
}
__device__ __forceinline__ void gate_unit(PK pk, int u, LAS unsigned char* lds) { const int tid_l = launder_v((int)threadIdx.x);
  const bf16_t* UZ = (const bf16_t*)(pk->ws + OFF_UZ); bf16_t* MIX = (bf16_t*)(pk->ws + OFF_MIXE); const bf16_t* WS = (const bf16_t*)(pk->ws + OFF_GMWS);
  const int tid = tid_l, wv = tid >> 6, lane = tid & 63, fr = lane & 15, fq = lane >> 4;
  const int n = u >> 2, g = u & 3, row0 = n * 128;
  LAS float* rstd = (LAS float*)lds; LAS bf16_t* ZT = (LAS bf16_t*)(lds + 512);
  { u32x4 w[16];
#pragma unroll
    for (int i = 0; i < 16; ++i) w[i] = *(const u32x4*)(UZ + (size_t)(row0 + wv * 16 + i) * D + 512 + lane * 8);
#pragma unroll
    for (int i = 0; i < 16; ++i) {
      float ss = bflo(w[i].x) * bflo(w[i].x) + bfhi(w[i].x) * bfhi(w[i].x) + bflo(w[i].y) * bflo(w[i].y) + bfhi(w[i].y) * bfhi(w[i].y) + bflo(w[i].z) * bflo(w[i].z) + bfhi(w[i].z) * bfhi(w[i].z) + bflo(w[i].w) * bflo(w[i].w) + bfhi(w[i].w) * bfhi(w[i].w);
      ss = wave_sum(ss, lane);
      if (lane == 0) rstd[wv * 16 + i] = rsqrtf(ss * (1.0f / 512.0f) + 1e-6f); } }
  __syncthreads();
#pragma unroll
  for (int i = 0; i < 2; ++i) { const int tp = lane, oc = wv + 8 * i;
    const bf16_t* zsrc = UZ + (size_t)(row0 + 2 * tp) * D + 512 + g * 128 + oc * 8;
    const u32x4 z0 = *(const u32x4*)(zsrc), z1 = *(const u32x4*)(zsrc + D);
    const float r0 = rstd[2 * tp], r1 = rstd[2 * tp + 1]; const float* gn = pk->in[I_GMG] + g * 128 + oc * 8;
    const f32x4 g0 = *(const f32x4*)(gn), g1 = *(const f32x4*)(gn + 4);
    LAS unsigned* zd = (LAS unsigned*)(ZT + (oc * 8) * 136 + 2 * tp);
    zd[0 * 68] = cvt_pk_bf16(bflo(z0.x) * r0 * g0[0], bflo(z1.x) * r1 * g0[0]); zd[1 * 68] = cvt_pk_bf16(bfhi(z0.x) * r0 * g0[1], bfhi(z1.x) * r1 * g0[1]);
    zd[2 * 68] = cvt_pk_bf16(bflo(z0.y) * r0 * g0[2], bflo(z1.y) * r1 * g0[2]); zd[3 * 68] = cvt_pk_bf16(bfhi(z0.y) * r0 * g0[3], bfhi(z1.y) * r1 * g0[3]);
    zd[4 * 68] = cvt_pk_bf16(bflo(z0.z) * r0 * g1[0], bflo(z1.z) * r1 * g1[0]); zd[5 * 68] = cvt_pk_bf16(bfhi(z0.z) * r0 * g1[1], bfhi(z1.z) * r1 * g1[1]);
    zd[6 * 68] = cvt_pk_bf16(bflo(z0.w) * r0 * g1[2], bflo(z1.w) * r1 * g1[2]); zd[7 * 68] = cvt_pk_bf16(bfhi(z0.w) * r0 * g1[3], bfhi(z1.w) * r1 * g1[3]); }
  __syncthreads();
  bf16x8 bw[4];
#pragma unroll
  for (int kk = 0; kk < 4; ++kk) bw[kk] = *(const bf16x8*)(WS + (size_t)(g * 128 + wv * 16 + fr) * 128 + kk * 32 + fq * 8);
  const int row = row0 + wv * 16 + fr;
  const float bsv = pk->in[I_GMBS][g * 128 + wv * 16 + fr];
#pragma unroll
  for (int ct = 0; ct < 8; ++ct) {
    f32x4 acc = {0.f, 0.f, 0.f, 0.f};
#pragma unroll
    for (int kk = 0; kk < 4; ++kk) { const bf16x8 a = *(const LAS bf16x8*)(ZT + (ct * 16 + fr) * 136 + kk * 32 + fq * 8); acc = __builtin_amdgcn_mfma_f32_16x16x32_bf16(a, bw[kk], acc, 0, 0, 0); }
    const int col = g * 128 + ct * 16 + 4 * fq;
    const f32x4 uu = unpack4(*(const u32x2*)(UZ + (size_t)row * D + col));
    *(u32x2*)(MIX + (size_t)row * D + col) = pack4(uu * (acc + bsv));
  }
  __syncthreads();
}

__device__ __forceinline__ void phase_conv(PK pk, const int bid, const int nb) { const int tid_l = launder_v((int)threadIdx.x);
  const bf16_t* __restrict__ XX = (const bf16_t*)(pk->ws + OFF_XX); bf16_t* __restrict__ XC = (bf16_t*)(pk->ws + OFF_XC);
  const float* __restrict__ cw = pk->in[I_CONVW]; const float* __restrict__ cb = pk->in[I_CONVB];
#pragma unroll 4
  for (int idx = bid * 512 + tid_l; idx < MR * 128; idx += nb * 512) {
    const int r = idx >> 7, c = (idx & 127) * 8;
    int pos, len; if (r < MX) { pos = r & (SEQ - 1); len = SEQ; } else { pos = (r - MX) & (CTXL - 1); len = CTXL; }
    float a[8];
#pragma unroll
    for (int e = 0; e < 8; ++e) a[e] = cb[c + e];
#pragma unroll
    for (int j = 0; j < 4; ++j) { const int pp = pos - 1 + j;
      if (pp >= 0 && pp < len) { const u32x4 w = *(const u32x4*)(XX + (size_t)(r - 1 + j) * D + c); const float* cwj = cw + j * 1024 + c;
        a[0] += cwj[0] * bflo(w.x); a[1] += cwj[1] * bfhi(w.x); a[2] += cwj[2] * bflo(w.y); a[3] += cwj[3] * bfhi(w.y);
        a[4] += cwj[4] * bflo(w.z); a[5] += cwj[5] * bfhi(w.z); a[6] += cwj[6] * bflo(w.w); a[7] += cwj[7] * bfhi(w.w); } }
    u32x4 o; o.x = cvt_pk_bf16(a[0], a[1]); o.y = cvt_pk_bf16(a[2], a[3]); o.z = cvt_pk_bf16(a[4], a[5]); o.w = cvt_pk_bf16(a[6], a[7]);
    *(u32x4*)(XC + (size_t)r * D + c) = o;
  }
}
__device__ __forceinline__ void scan_item(int it, int& b, int& ci, int& row0, int& len) {
  if (it < 1024) { b = it >> 9; const int lc = it & 511; ci = 32 + lc; row0 = b * SEQ + lc * 32; len = 32; }
  else { const int j = it - 1024; b = j >> 5; ci = j & 31; row0 = MX + b * CTXL + ci * 8; len = 8; }
}
#define SCAN_STEP(H, LAW, BW) do { \
    H[0] = __expf(bflo(LAW.x)) * H[0] + bflo(BW.x); H[1] = __expf(bfhi(LAW.x)) * H[1] + bfhi(BW.x); \
    H[2] = __expf(bflo(LAW.y)) * H[2] + bflo(BW.y); H[3] = __expf(bfhi(LAW.y)) * H[3] + bfhi(BW.y); \
    H[4] = __expf(bflo(LAW.z)) * H[4] + bflo(BW.z); H[5] = __expf(bfhi(LAW.z)) * H[5] + bfhi(BW.z); \
    H[6] = __expf(bflo(LAW.w)) * H[6] + bflo(BW.w); H[7] = __expf(bfhi(LAW.w)) * H[7] + bfhi(BW.w); } while (0)
#define SCAN_ACCP(P, LAW) do { P[0] += bflo(LAW.x); P[1] += bfhi(LAW.x); P[2] += bflo(LAW.y); P[3] += bfhi(LAW.y); P[4] += bflo(LAW.z); P[5] += bfhi(LAW.z); P[6] += bflo(LAW.w); P[7] += bfhi(LAW.w); } while (0)
__device__ __forceinline__ void phase_scan1(PK pk, const int bid, const int nb) { const int tid_l = launder_v((int)threadIdx.x);
  const bf16_t* __restrict__ LAB = (const bf16_t*)(pk->ws + OFF_LAB); float* __restrict__ PE = (float*)(pk->ws + OFF_PE);
  const int ch = (tid_l & 127) * 8;
  for (int it = bid * 4 + (tid_l >> 7); it < 1088; it += nb * 4) {
    int b, ci, row0, len; scan_item(it, b, ci, row0, len);
#pragma unroll
    for (int d = 0; d < 2; ++d) {
      const bf16_t* __restrict__ LA = LAB + (size_t)(2 * d) * MR * D + ch; const bf16_t* __restrict__ BB = LAB + (size_t)(2 * d + 1) * MR * D + ch;
      float H[8], P[8];
#pragma unroll
      for (int e = 0; e < 8; ++e) { H[e] = 0.f; P[e] = 0.f; }
#pragma unroll 1
      for (int t0 = 0; t0 < len; t0 += 8) {
        u32x4 lw[8], bw[8];
#pragma unroll
        for (int k = 0; k < 8; ++k) { const int r = row0 + (d == 0 ? t0 + k : len - 1 - t0 - k); lw[k] = *(const u32x4*)(LA + (size_t)r * D); bw[k] = *(const u32x4*)(BB + (size_t)r * D); }
#pragma unroll
        for (int k = 0; k < 8; ++k) { SCAN_STEP(H, lw[k], bw[k]); SCAN_ACCP(P, lw[k]); }
      }
      float* pp = PE + ((size_t)(d * 2 + b) * NCH + ci) * 1024 + ch; float* ep = pp + (size_t)2 * 2 * NCH * 1024;
      *(f32x4*)(pp) = (f32x4){P[0], P[1], P[2], P[3]}; *(f32x4*)(pp + 4) = (f32x4){P[4], P[5], P[6], P[7]};
      *(f32x4*)(ep) = (f32x4){H[0], H[1], H[2], H[3]}; *(f32x4*)(ep + 4) = (f32x4){H[4], H[5], H[6], H[7]};
    }
  }
}
__device__ __forceinline__ void phase_scan2(PK pk, const int bid, const int nb) { const int tid_l = launder_v((int)threadIdx.x);
  const float* PE = (const float*)(pk->ws + OFF_PE); float* HIN = (float*)(pk->ws + OFF_HIN);
  if (bid >= 64 || tid_l >= 64) return;
  const int id = bid * 64 + tid_l, d = id >> 11, b = (id >> 10) & 1, ch = id & 1023;
  const float* pp = PE + (size_t)(d * 2 + b) * NCH * 1024 + ch; const float* ep = pp + (size_t)2 * 2 * NCH * 1024;
  float* hp = HIN + (size_t)(d * 2 + b) * NCH * 1024 + ch;
  float H = 0.f;
#pragma unroll 1
  for (int s0 = 0; s0 < NCH; s0 += 32) {
    float pv[32], ev[32];
#pragma unroll
    for (int k = 0; k < 32; ++k) { const int s = s0 + k; const int ci = d == 0 ? s : (s < 32 ? 31 - s : 575 - s); pv[k] = pp[(size_t)ci * 1024]; ev[k] = ep[(size_t)ci * 1024]; }
#pragma unroll
    for (int k = 0; k < 32; ++k) { const int s = s0 + k; const int ci = d == 0 ? s : (s < 32 ? 31 - s : 575 - s); hp[(size_t)ci * 1024] = H; H = __expf(pv[k]) * H + ev[k]; }
  }
}
__device__ __forceinline__ void phase_scan3(PK pk, LAS unsigned char* lds, const int bid, const int nb) { const int tid_l = launder_v((int)threadIdx.x);
  const bf16_t* __restrict__ LAB = (const bf16_t*)(pk->ws + OFF_LAB); const float* __restrict__ HIN = (const float*)(pk->ws + OFF_HIN);
  const bf16_t* __restrict__ G = (const bf16_t*)(pk->ws + OFF_G); bf16_t* MIX = (bf16_t*)(pk->ws + OFF_MIXO);
  const int ch = (tid_l & 127) * 8;
  LAS u32x4* slot = (LAS u32x4*)lds + tid_l;
#define S3_FWD_BATCH(T0, SINK) do { u32x4 lw[8], bw[8]; \
        _Pragma("unroll") for (int k = 0; k < 8; ++k) { const int r = row0 + (T0) + k; lw[k] = *(const u32x4*)(LA + (size_t)r * D); bw[k] = *(const u32x4*)(BB + (size_t)r * D); } \
        _Pragma("unroll") for (int k = 0; k < 8; ++k) { SCAN_STEP(H, lw[k], bw[k]); \
          u32x4 o; o.x = cvt_pk_bf16(H[0], H[1]); o.y = cvt_pk_bf16(H[2], H[3]); o.z = cvt_pk_bf16(H[4], H[5]); o.w = cvt_pk_bf16(H[6], H[7]); SINK; } } while (0)
#define S3_BWD_BATCH(T0, SRC) do { u32x4 lw[8], bw[8], gw[8]; \
        _Pragma("unroll") for (int k = 0; k < 8; ++k) { const int r = row0 + (T0) + 7 - k; lw[k] = *(const u32x4*)(LA + (size_t)r * D); bw[k] = *(const u32x4*)(BB + (size_t)r * D); gw[k] = *(const u32x4*)(G + (size_t)r * D + ch); } \
        _Pragma("unroll") for (int k = 0; k < 8; ++k) { const int r = row0 + (T0) + 7 - k; SCAN_STEP(H, lw[k], bw[k]); const u32x4 hf = SRC, gg = gw[k]; u32x4 o_; \
          o_.x = cvt_pk_bf16((bflo(hf.x) + H[0]) * bflo(gg.x), (bfhi(hf.x) + H[1]) * bfhi(gg.x)); \
          o_.y = cvt_pk_bf16((bflo(hf.y) + H[2]) * bflo(gg.y), (bfhi(hf.y) + H[3]) * bfhi(gg.y)); \
          o_.z = cvt_pk_bf16((bflo(hf.z) + H[4]) * bflo(gg.z), (bfhi(hf.z) + H[5]) * bfhi(gg.z)); \
          o_.w = cvt_pk_bf16((bflo(hf.w) + H[6]) * bflo(gg.w), (bfhi(hf.w) + H[7]) * bfhi(gg.w)); \
          *(u32x4*)(MIX + (size_t)r * D + ch) = o_; } } while (0)
  for (int it = bid * 4 + (tid_l >> 7); it < 1024  ; it += nb * 4) {
    int b, ci, row0, len; scan_item(it, b, ci, row0, len);
    u32x4 hfr[8];
    { const bf16_t* LA = LAB + ch; const bf16_t* __restrict__ BB = LAB + (size_t)MR * D + ch;
      const float* hp = HIN + ((size_t)(0 * 2 + b) * NCH + ci) * 1024 + ch;
      const f32x4 h0 = *(const f32x4*)(hp), h1 = *(const f32x4*)(hp + 4);
      float H[8] = {h0[0], h0[1], h0[2], h0[3], h1[0], h1[1], h1[2], h1[3]};
#pragma unroll 1
      for (int t0 = 0; t0 < 16; t0 += 8) S3_FWD_BATCH(t0, slot[(t0 + k) * 512] = o);
      S3_FWD_BATCH(16, *(u32x4*)(MIX + (size_t)(row0 + 16 + k) * D + ch) = o);
      S3_FWD_BATCH(24, hfr[k] = o);
    }
    { const bf16_t* __restrict__ LA = LAB + (size_t)2 * MR * D + ch; const bf16_t* __restrict__ BB = LAB + (size_t)3 * MR * D + ch;
      const float* hp = HIN + ((size_t)(1 * 2 + b) * NCH + ci) * 1024 + ch;
      const f32x4 h0 = *(const f32x4*)(hp), h1 = *(const f32x4*)(hp + 4);
      float H[8] = {h0[0], h0[1], h0[2], h0[3], h1[0], h1[1], h1[2], h1[3]};
      S3_BWD_BATCH(24, hfr[7 - k]);
      { u32x4 hfw[8];
#pragma unroll
        for (int k = 0; k < 8; ++k) hfw[k] = *(const u32x4*)(MIX + (size_t)(row0 + 23 - k) * D + ch);
        S3_BWD_BATCH(16, hfw[k]); }
#pragma unroll 1
      for (int t0 = 8; t0 >= 0; t0 -= 8) S3_BWD_BATCH(t0, slot[(t0 + 7 - k) * 512]);
    }
  }
#undef S3_FWD_BATCH
#undef S3_BWD_BATCH
}

#define XB_TMO      128
#define XB_XCNT(j)  (256  + 64 * (j))
#define XB_XSUB(j)  (1280 + 64 * (j))
#define XB_XGEN(j)  (2304 + 64 * (j))
#define XB_TOP      3328
#define XB_TOPGEN   3392
#define XCD_BAR_WORDS 3456
#define XB_SPIN_CAP (1u << 22)
__device__ __forceinline__ unsigned xb_ld(unsigned* p)              { return __hip_atomic_load(p, __ATOMIC_RELAXED, __HIP_MEMORY_SCOPE_AGENT); }
__device__ __forceinline__ unsigned xb_add(unsigned* p, unsigned v) { return __hip_atomic_fetch_add(p, v, __ATOMIC_RELAXED, __HIP_MEMORY_SCOPE_AGENT); }
__device__ __forceinline__ unsigned xb_xcc_id() { return (unsigned)__builtin_amdgcn_s_getreg((3 << 11) | 20) & 0xFu; }
#define XB_SPIN(cond, bar) do { unsigned _sp = 0; while (cond) { __builtin_amdgcn_s_sleep(1); \
    if ((++_sp & 255u) == 0u) { if (xb_ld(&(bar)[XB_TMO])) break; if (_sp > XB_SPIN_CAP) { atomicAdd(&(bar)[XB_TMO], 1u); break; } } } } while (0)
__device__ __forceinline__ void xcd_barrier_complete(unsigned* bar, unsigned x, unsigned& nloc, unsigned& nx) {
    const unsigned G = gridDim.x * gridDim.y * gridDim.z;
    unsigned sum, cnt, mine, sp = 0u;
    for (;;) {
        sum = 0u; cnt = 0u; mine = 0u;
#pragma unroll
        for (unsigned j = 0; j < 16; ++j) { const unsigned c = xb_ld(&bar[XB_XCNT(j)]); sum += c; cnt += (c > 0u) ? 1u : 0u; mine = (j == x) ? c : mine; }
        if (sum == G) break;
        __builtin_amdgcn_s_sleep(1);
        if ((++sp & 255u) == 0u) { if (xb_ld(&bar[XB_TMO])) break; if (sp > XB_SPIN_CAP) { atomicAdd(&bar[XB_TMO], 1u); break; } }
    }
    nloc = mine > 0u ? mine : 1u; nx = cnt > 0u ? cnt : 1u;
}
__device__ __forceinline__ void xcd_barrier(LAS unsigned char* lds) {
    asm volatile("s_waitcnt vmcnt(0)" ::: "memory");
    __syncthreads();
    if (threadIdx.x == 0) {
        PK pk_ = get_pk(); unsigned* bar = (unsigned*)(pk_->ws + OFF_BAR);
        volatile LAS unsigned* st = (volatile LAS unsigned*)(lds + 131072);
        const unsigned x = xb_xcc_id();
        __builtin_amdgcn_s_waitcnt(0);
        unsigned nloc = st[0], nx = st[1];
        if (nloc == 0u) { xcd_barrier_complete(bar, x, nloc, nx); st[0] = nloc; st[1] = nx; }
        const unsigned old = xb_add(&bar[XB_XSUB(x)], 1u);
        const unsigned gen = old / nloc;
        if (old + 1u == (gen + 1u) * nloc) {
            __builtin_amdgcn_fence(__ATOMIC_RELEASE, "agent");
            asm volatile("s_waitcnt vmcnt(0)" ::: "memory");
            const unsigned og = xb_add(&bar[XB_TOP], 1u);
            const unsigned tg = og / nx;
            if (og + 1u == (tg + 1u) * nx) xb_add(&bar[XB_TOPGEN], 1u);
            else XB_SPIN(xb_ld(&bar[XB_TOPGEN]) == tg, bar);
            __builtin_amdgcn_fence(__ATOMIC_ACQUIRE, "agent");
            xb_add(&bar[XB_XGEN(x)], 1u);
            asm volatile("s_waitcnt vmcnt(0)" ::: "memory");
        } else {
            XB_SPIN(xb_ld(&bar[XB_XGEN(x)]) == gen, bar);
            __builtin_amdgcn_fence(__ATOMIC_ACQUIRE, "agent");
            asm volatile("s_waitcnt vmcnt(0)" ::: "memory");
        }
    }
    __syncthreads();
}

#ifdef TPROBE
#define TSTAMP(k) do { PK pk_ = get_pk(); unsigned long long* ta_ = (unsigned long long*)(pk_->ws + OFF_PE); if (blockIdx.x == 0 && threadIdx.x == 0) { const unsigned long long now_ = wall_clock64(); ta_[k] += now_ - ta_[15]; ta_[15] = now_; } } while (0)
#else
#define TSTAMP(k) do {} while (0)
#endif
#define PHASE_VARS PK pk = get_pk(); const int bid = launder_i(cid), G = launder_i((int)gridDim.x); unsigned char* ws = pk->ws; (void)ws; (void)bid; (void)G
#define ZERO_RS(buf) do { float* z_ = (float*)(ws + OFF_RS) + (size_t)(buf) * MR; for (int i_ = bid * 512 + (int)threadIdx.x; i_ < MX; i_ += G * 512) z_[i_] = 0.f; } while (0)
__global__ void __launch_bounds__(512, 2) fwd_mega(Params p_unused) {
  extern __shared__ __attribute__((aligned(16))) unsigned char shm[];
  LAS unsigned char* lds = (LAS unsigned char*)shm;
  cg::grid_group grid = cg::this_grid();
  const int cid = (int)blockIdx.x;
  { PK pk_ = get_pk();
    if (threadIdx.x == 0) { const unsigned x = xb_xcc_id();
      ((volatile LAS unsigned*)(lds + 131072))[0] = 0u; ((volatile LAS unsigned*)(lds + 131072))[1] = 0u;
      (void)xb_add((unsigned*)(pk_->ws + OFF_BAR) + XB_XCNT(x), 1u); }
    __syncthreads(); }
#ifdef TPROBE
  { PK pk_ = get_pk(); unsigned long long* ta_ = (unsigned long long*)(pk_->ws + OFF_PE); if (blockIdx.x == 0 && threadIdx.x < 16) ta_[threadIdx.x] = threadIdx.x == 15 ? (unsigned long long)wall_clock64() : 0ull; }
#endif

  { PHASE_VARS; prologue(pk, lds, bid, G); }
  grid.sync();
#ifdef REP_PRO2
  { PHASE_VARS; prologue(pk, lds, bid, G); }
  xcd_barrier(lds);
#endif
  { PHASE_VARS; prologue2(pk, bid, G); }
  xcd_barrier(lds); TSTAMP(0);
#pragma unroll 1
  for (int l = 0; l < 2; ++l) {
#pragma unroll 1
    for (int s3 = 0; s3 < 3; ++s3) {
      const bool first = (l == 0 && s3 == 0);
      const bool lastp = (l == 1 && s3 == 2);
      const int q = l * 3 + s3, rb = q & 1;
      { PHASE_VARS;
        phase_prep(pk->in[I_X], (float*)(ws + OFF_CTXR), (const float*)(ws + OFF_GS) + (size_t)q * 3072, (bf16_t*)(ws + OFF_H), (float*)(ws + OFF_RS) + (size_t)rb * MR, first ? 0 : (lastp ? MR : MX),
                   (const float*)(ws + (s3 == 2 ? OFF_BIG : OFF_EXTRA)), first ? 0 : (s3 == 2 ? 4 : 11), (const float*)(ws + OFF_RSP), !first, bid, G); }
      xcd_barrier(lds); TSTAMP(1);
      if (s3 != 1) {
        const int f = s3 >> 1, j = l * 2 + f;
        { PHASE_VARS;
          pg8::Gemm g{(const bf16_t*)(ws + OFF_H), (const bf16_t*)(ws + OFF_W1 + j * SZ_W1), MR, 2 * FF, D, D, 0, 0};
          pg8::StaticOrder S; S.init(lastp ? MX : g.M, g.N, g.K, G, bid);
          EpiSwiglu e{(bf16_t*)(ws + OFF_BIG), (const float*)(ws + OFF_RS) + (size_t)rb * MR, (const float*)(ws + OFF_BIASF) + (size_t)j * 3 * 5632};
          pg8::gemm_phase(lds, g, S, e); }
        xcd_barrier(lds); TSTAMP(2);
        { PHASE_VARS;
          pg8::Gemm g{(const bf16_t*)(ws + OFF_BIG), (const bf16_t*)(ws + OFF_W2 + j * SZ_W2), MR, D, FF, FF, 0, 1};
          pg8::StaticOrder S; if (lastp) S.init(MX, g.N, g.K, G, bid); else S.init_split(g.N, g.K, G, bid, 11);
          if (first) { EpiResid<true, true> e{pk->in[I_X], (bf16_t*)pk->out, ws, q}; pg8::gemm_phase(lds, g, S, e); }
          else { EpiResid<false, true> e{pk->in[I_X], (bf16_t*)pk->out, ws, q}; pg8::gemm_phase(lds, g, S, e); } }
        xcd_barrier(lds); TSTAMP(3);
      } else if (l == 0) {
        { PHASE_VARS;
          pg8::Gemm g{(const bf16_t*)(ws + OFF_H), (const bf16_t*)(ws + OFF_EVIN), MR, EVIN_N, D, D, 0, 0};
          pg8::StaticOrder S; S.init(g.M, g.N, g.K, G, bid);
          EpiEvenIn e{(bf16_t*)(ws + OFF_UZ), (bf16_t*)(ws + OFF_Q), (bf16_t*)(ws + OFF_K), (bf16_t*)(ws + OFF_V), (const float*)(ws + OFF_ROPE), (const float*)(ws + OFF_ROPE) + 4096,
                      (const float*)(ws + OFF_RS) + (size_t)rb * MR, (const float*)(ws + OFF_BIASE)};
          pg8::gemm_phase(lds, g, S, e); }
        xcd_barrier(lds); TSTAMP(4);
#ifndef REP_ATT
#define REP_ATT 1
#endif
#ifndef ATT_LO
#define ATT_LO 0
#define ATT_HI 1560
#endif
        for (int rep = 0; rep < REP_ATT; ++rep) {
        { PHASE_VARS;
          for (int u = bid + (rep ? ATT_LO : 0); u < (rep ? ATT_HI : 520 + 1040); u += G) { if (u < 520) attn_unit(pk, u, lds); else gate_unit(pk, u - 520, lds); } }
        xcd_barrier(lds); } TSTAMP(5);
        { PHASE_VARS;
          pg8::Gemm g{(const bf16_t*)(ws + OFF_MIXE), (const bf16_t*)(ws + OFF_EVOUT), MR, D, D, D, 0, 0};
          pg8::StaticOrder S; S.init_split(g.N, g.K, G, bid, 4);
          EpiResid<false, false> e{pk->in[I_X], (bf16_t*)pk->out, ws, q};
          pg8::gemm_phase(lds, g, S, e); }
        xcd_barrier(lds); TSTAMP(6);
      } else {
        { PHASE_VARS;
          pg8::Gemm g{(const bf16_t*)(ws + OFF_H), (const bf16_t*)(ws + OFF_ODIN), MR, 2048, D, D, 0, 0};
          pg8::StaticOrder S; S.init(g.M, g.N, g.K, G, bid);
          EpiOddIn e{(bf16_t*)(ws + OFF_G), (bf16_t*)(ws + OFF_XX), (const float*)(ws + OFF_RS) + (size_t)rb * MR, (const float*)(ws + OFF_BIASO)};
          pg8::gemm_phase(lds, g, S, e); }
        xcd_barrier(lds); TSTAMP(7);
        { PHASE_VARS; phase_conv(pk, bid, G); }
        xcd_barrier(lds); TSTAMP(8);
        { PHASE_VARS;
          pg8::Gemm g{(const bf16_t*)(ws + OFF_XC), (const bf16_t*)(ws + OFF_RGW), MR, 4096, 256, D, 1, 0};
          pg8::StaticOrder S; S.init(g.M, g.N, g.K, G, bid);
          EpiRG e{(const bf16_t*)(ws + OFF_XC), (bf16_t*)(ws + OFF_LAB), pk->in[I_RGBA], pk->in[I_RGBX], (const float*)(ws + OFF_SP)};
          pg8::gemm_phase(lds, g, S, e); }
        xcd_barrier(lds); TSTAMP(9);
        { PHASE_VARS; phase_scan1(pk, bid, G); }
        xcd_barrier(lds); TSTAMP(10);
        { PHASE_VARS; phase_scan2(pk, bid, G); }
        xcd_barrier(lds); TSTAMP(11);
        { PHASE_VARS; phase_scan3(pk, lds, bid, G); }
        xcd_barrier(lds); TSTAMP(12);
        { PHASE_VARS;
          pg8::Gemm g{(const bf16_t*)(ws + OFF_MIXO), (const bf16_t*)(ws + OFF_ODOUT), MR, D, D, D, 0, 0};
          pg8::StaticOrder S; S.init(MX, g.N, g.K, G, bid);
          EpiResid<false, false> e{pk->in[I_X], (bf16_t*)pk->out, ws, q};
          pg8::gemm_phase(lds, g, S, e); }
        xcd_barrier(lds); TSTAMP(13);
      }
    }
  }
  { PHASE_VARS; phase_final_norm(pk->out, (const bf16_t*)(ws + OFF_H), pk->in[I_FNG], bid, G); }
}

extern "C" void kernel_launch(void* const* d_in, const int* in_sizes, int n_in, void* d_out, int out_size,
                              void* d_ws, size_t ws_size, hipStream_t stream) {
  static int grid_blocks = 0;
  if (!grid_blocks) {
    int dev = 0, cus = 0, per_cu = 0;
    (void)hipGetDevice(&dev);
    (void)hipDeviceGetAttribute(&cus, hipDeviceAttributeMultiprocessorCount, dev);
    (void)hipFuncSetAttribute((const void*)fwd_mega, hipFuncAttributeMaxDynamicSharedMemorySize, LDS_BYTES);
    (void)hipOccupancyMaxActiveBlocksPerMultiprocessor(&per_cu, (const void*)fwd_mega, 512, LDS_BYTES);
    (void)hipGetLastError();
    grid_blocks = cus > 0 ? cus : 256;
    if (ws_size < WS_NEED2 || n_in != 26) { fprintf(stderr, "kernel_launch: ws_size %zu < %zu or n_in %d != 26\n", ws_size, (size_t)WS_NEED, n_in); grid_blocks = -1; }
  }
  if (grid_blocks < 0) return;
  Params p{};
  for (int i = 0; i < 26; ++i) p.in[i] = (const float*)d_in[i];
  p.out = (float*)d_out; p.ws = (unsigned char*)d_ws;
  (void)hipMemsetAsync((unsigned char*)d_ws + OFF_CNT, 0, 256 + 3456 * 4, stream);
  void* args[] = {&p};
  hipError_t e = hipLaunchCooperativeKernel((const void*)fwd_mega, dim3(grid_blocks), dim3(512), args, LDS_BYTES, stream);
  if (e != hipSuccess) fprintf(stderr, "cooperative launch failed: %s (grid %d)\n", hipGetErrorString(e), grid_blocks);
}
```

```cpp
#include <hip/hip_runtime.h>
#include <hip/hip_cooperative_groups.h>
#include <cstdio>
namespace cg = cooperative_groups;

#define LAS __attribute__((address_space(3)))
typedef unsigned short bf16_t;
typedef short bf16x8 __attribute__((ext_vector_type(8)));
typedef short bf16x4 __attribute__((ext_vector_type(4)));
typedef float f32x4 __attribute__((ext_vector_type(4)));
typedef unsigned u32x2 __attribute__((ext_vector_type(2)));
typedef unsigned u32x4 __attribute__((ext_vector_type(4)));

constexpr int D = 1024, FF = 2816, SEQ = 16384, MX = 32768, MC = 512, MR = MX + MC, CTXL = 256;
constexpr int NMOD = 9216;
constexpr int EVIN_N = 1792;
constexpr int LDS_BYTES = 131072 + 64;
constexpr int NCH = 544;

constexpr size_t SZ_W1 = (size_t)2 * FF * D * 2;
constexpr size_t SZ_W2 = (size_t)D * FF * 2;
constexpr size_t OFF_W1 = 0;
constexpr size_t OFF_W2 = OFF_W1 + 4 * SZ_W1;
constexpr size_t OFF_EVIN = OFF_W2 + 4 * SZ_W2;
constexpr size_t OFF_EVOUT = OFF_EVIN + (size_t)EVIN_N * D * 2;
constexpr size_t OFF_ODIN = OFF_EVOUT + (size_t)D * D * 2;
constexpr size_t OFF_ODOUT = OFF_ODIN + (size_t)2048 * D * 2;
constexpr size_t OFF_RGW = OFF_ODOUT + (size_t)D * D * 2;
constexpr size_t OFF_GMWS = OFF_RGW + (size_t)4096 * 256 * 2;
constexpr size_t OFF_MOD = OFF_GMWS + (size_t)4 * 128 * 128 * 2;
constexpr size_t OFF_ROPE = OFF_MOD + (size_t)2 * 3 * NMOD * 4;
constexpr size_t OFF_SP = OFF_ROPE + (size_t)256 * 16 * 2 * 4;
constexpr size_t OFF_GS = OFF_SP + (size_t)2 * 1024 * 4;
constexpr size_t OFF_BIASF = OFF_GS + (size_t)2 * 3 * 3 * 1024 * 4;
constexpr size_t OFF_BIASE = OFF_BIASF + (size_t)4 * 3 * 5632 * 4;
constexpr size_t OFF_BIASO = OFF_BIASE + (size_t)3 * 1792 * 4;
constexpr size_t OFF_RS = OFF_BIASO + (size_t)3 * 2048 * 4;
constexpr size_t OFF_CNT = OFF_RS + (size_t)2 * MR * 4;
constexpr size_t OFF_BAR = OFF_CNT + 256;
constexpr size_t OFF_CTXR = OFF_BAR + 3456 * 4;
constexpr size_t OFF_PE = OFF_CTXR + (size_t)MC * D * 4;
constexpr size_t SZ_CARRY = (size_t)2 * 2 * NCH * 1024 * 4;
constexpr size_t OFF_HIN = OFF_PE + 2 * SZ_CARRY;
constexpr size_t OFF_H = OFF_HIN + SZ_CARRY;
constexpr size_t SZ_ROWS = (size_t)MR * D * 2;
constexpr size_t OFF_BIG = OFF_H + SZ_ROWS;
constexpr size_t SZ_ACT = (size_t)MR * FF * 2;
constexpr size_t OFF_EXTRA = OFF_BIG + SZ_ACT;
constexpr size_t OFF_UZ = OFF_BIG;
constexpr size_t OFF_Q = OFF_UZ + SZ_ROWS;
constexpr size_t OFF_K = OFF_Q + SZ_ROWS / 2;
constexpr size_t OFF_V = OFF_K + SZ_ROWS / 8;
constexpr size_t OFF_MIXE = OFF_EXTRA;
constexpr size_t OFF_G = OFF_BIG;
constexpr size_t OFF_XX = OFF_G + SZ_ROWS;
constexpr size_t OFF_XC = OFF_H;
constexpr size_t OFF_LAB = OFF_XX;
constexpr size_t OFF_MIXO = OFF_LAB;
constexpr size_t WS_NEED = OFF_LAB + 4 * SZ_ROWS;
constexpr size_t OFF_RSP = OFF_LAB + 4 * SZ_ROWS;
constexpr size_t WS_NEED2 = OFF_RSP + (size_t)MR * 16 * 4;
static_assert(OFF_MIXE + SZ_ROWS <= WS_NEED, "ws");
static_assert(WS_NEED2 <= (size_t)536870912, "workspace budget 2");
static_assert(WS_NEED <= (size_t)536870912, "workspace budget");

struct Params { const float* in[26]; float* out; unsigned char* ws; };
typedef const Params __attribute__((address_space(4))) * PK;
__device__ __forceinline__ PK get_pk() { PK pk = (PK)__builtin_amdgcn_kernarg_segment_ptr(); asm volatile("" : "+s"(pk)); return pk; }
__device__ __forceinline__ int launder_i(int v) { asm volatile("" : "+s"(v)); return v; }
__device__ __forceinline__ float launder_f(float v) { asm volatile("" : "+s"(v)); return v; }
__device__ __forceinline__ int launder_v(int v) { asm volatile("" : "+v"(v)); return v; }
#define TID_X tid_l
enum { I_X = 0, I_C, I_CTX, I_CCTX, I_ADAW, I_ADAB, I_NORMG, I_WG, I_WU, I_WD, I_EVIN, I_EVOUT, I_GMG, I_GMWS, I_GMBS, I_SINK,
       I_ODIN, I_ODOUT, I_CONVW, I_CONVB, I_RGWA, I_RGBA, I_RGWX, I_RGBX, I_LAM, I_FNG };

__device__ __forceinline__ unsigned cvt_pk_bf16(float lo, float hi) { unsigned r; asm volatile("v_cvt_pk_bf16_f32 %0, %1, %2" : "=v"(r) : "v"(lo), "v"(hi)); return r; }
__device__ __forceinline__ bf16_t f2bf(float f) { return (bf16_t)(cvt_pk_bf16(f, 0.f) & 0xffffu); }
__device__ __forceinline__ float bf2f(bf16_t b) { return __uint_as_float(((unsigned)b) << 16); }
__device__ __forceinline__ float bflo(unsigned w) { return __uint_as_float(w << 16); }
__device__ __forceinline__ float bfhi(unsigned w) { return __uint_as_float(w & 0xffff0000u); }
__device__ __forceinline__ u32x2 pack4(f32x4 v) { u32x2 r; r.x = cvt_pk_bf16(v[0], v[1]); r.y = cvt_pk_bf16(v[2], v[3]); return r; }
__device__ __forceinline__ f32x4 unpack4(u32x2 w) { f32x4 r; r[0] = bflo(w.x); r[1] = bfhi(w.x); r[2] = bflo(w.y); r[3] = bfhi(w.y); return r; }
__device__ __forceinline__ float fast_sigmoid(float x) { return __fdividef(1.0f, 1.0f + __expf(-x)); }
__device__ __forceinline__ float gelu_tanh(float x) { const float t = 1.5957691216f * (x + 0.044715f * x * x * x); return x * fast_sigmoid(t); }
__device__ __forceinline__ float shx(float v, int o, int lane) { return __int_as_float(__builtin_amdgcn_ds_bpermute((lane ^ o) << 2, __float_as_int(v))); }
__device__ __forceinline__ float wave_sum(float v, int lane) {
#pragma unroll
  for (int o = 32; o >= 1; o >>= 1) v += shx(v, o, lane);
  return v;
}

namespace pg8 {
constexpr int BM = 256, BK = 64, HALF = 128, HTB = HALF * BK * 2, NXCD = 8, WGM = 8;
__device__ __forceinline__ int lds_byte(int r, int c) { const int st = (r >> 4) * 2 + (c >> 5), rr = r & 15, cc = c & 31, ob = rr * 64 + cc * 2; return st * 1024 + (ob ^ (((ob >> 9) & 1) << 5)); }
__device__ __forceinline__ void stage_rc(int b, int& R, int& C) { const int st = b / 1024, sb = b % 1024, swz = sb ^ (((sb >> 9) & 1) << 5); R = (st >> 1) * 16 + swz / 64; C = (st & 1) * 32 + (swz % 64) / 2; }
__device__ __forceinline__ int perm32(int rho) { const int n = rho >> 4, i = rho & 15; return 8 * (i >> 2) + 4 * n + (i & 3); }
struct Unit { int pm, pn, k0, nk; };
struct Gemm { const bf16_t* A; const bf16_t* Bt; int M, N, K, lda; int bd; int ablk; };
struct StaticOrder {
  int nM, nN, nwg, G, c, ntfull, nslice, nkslice;
  __device__ void init(int M, int N, int K, int G_, int c_) { nM = M / BM; nN = N / BM; nwg = nM * nN; G = G_; c = c_; ntfull = K / BK; nslice = 0; nkslice = 0; }
  __device__ void init_split(int N, int K, int G_, int c_, int S) { nM = 128; nN = N / BM; nwg = nM * nN; G = G_; c = c_; ntfull = K / BK; nslice = S; nkslice = ntfull / S; }
  __device__ bool next(int i, Unit& u) const {
    const long L = (long)i * G + c;
    if (L >= nwg) {
      const int e = (int)(L - nwg);
      if (e >= 2 * nN * nslice) return false;
      const int sl = e % nslice, tl = e / nslice;
      u.pm = 128 + tl / nN; u.pn = tl % nN; u.k0 = sl * nkslice; u.nk = nkslice; return true;
    }
    int wgid = (int)L; { const int q = nwg / NXCD, r = nwg % NXCD, xcd = wgid % NXCD, off = wgid / NXCD; wgid = (xcd < r ? xcd * (q + 1) : r * (q + 1) + (xcd - r) * q) + off; }
    const int nig = WGM * nN, gid = wgid / nig, fm = gid * WGM, gsz = (nM - fm) < WGM ? (nM - fm) : WGM;
    u.pm = fm + ((wgid % nig) % gsz); u.pn = (wgid % nig) / gsz; u.k0 = 0; u.nk = ntfull; return true;
  }
};

template <class Epi>
__device__ __forceinline__ void gemm_phase(LAS unsigned char* lds, const Gemm g, const StaticOrder& S, const Epi& E) { const int tid_l = launder_v((int)threadIdx.x);
  const int tid = tid_l, wid = __builtin_amdgcn_readfirstlane(tid >> 6), lane = tid & 63, wr = wid >> 2, wc = wid & 3, fr = lane & 15, fq = lane >> 4;
  const int K = g.K;
  unsigned voffA[2], voffB[2];
#pragma unroll
  for (int i = 0; i < 2; ++i) { int R, C; stage_rc(tid * 16 + i * 8192, R, C); const int Rb = Epi::PERM ? ((R & ~31) + perm32(R & 31)) : R;
    voffA[i] = (unsigned)(R * (g.ablk ? 64 : g.lda) + C) * 2u; voffB[i] = (unsigned)(Rb * K + C) * 2u; }
  const size_t kstep = (size_t)(BK * 2), kstepA = g.ablk ? (size_t)32768 : kstep;
  const size_t hstepA = g.ablk ? (size_t)16384 : (size_t)HALF * g.lda * 2, hstepB = (size_t)HALF * K * 2;
  const size_t tstepA = g.ablk ? (size_t)(K / BK) * 32768 : 2 * hstepA, tstepB = 2 * hstepB;
  const unsigned ldsw = (unsigned)wid * 1024u;
  const int aoff = lds_byte(wr * 64 + fr, fq * 8), boff = lds_byte(wc * 32 + fr, fq * 8);
#define PG8_SA(b, h) (((b) * 2 + (h)) * HTB)
#define PG8_SB(b, h) ((4 + (b) * 2 + (h)) * HTB)
#define PG8_STAGE(bufoff, gbase, voff) do { _Pragma("unroll") for (int _i = 0; _i < 2; ++_i) \
        __builtin_amdgcn_global_load_lds((const unsigned*)((const char*)(gbase) + (voff)[_i]), (LAS unsigned*)(lds + (bufoff) + ldsw + _i * 8192), 16, 0, 0); } while (0)
#define PG8_LDA(dst, b, h) do { _Pragma("unroll") for (int m = 0; m < 4; ++m) _Pragma("unroll") for (int k = 0; k < 2; ++k) dst[m][k] = *(const LAS bf16x8*)(lds + PG8_SA(b, h) + aoff + m * 2048 + k * 1024); } while (0)
#define PG8_LDB(dst, b, h) do { _Pragma("unroll") for (int n = 0; n < 2; ++n) _Pragma("unroll") for (int k = 0; k < 2; ++k) dst[n][k] = *(const LAS bf16x8*)(lds + PG8_SB(b, h) + boff + n * 2048 + k * 1024); } while (0)
#define PG8_MMA(ai, bj, At, Bt) do { __builtin_amdgcn_s_setprio(1); _Pragma("unroll") for (int m = 0; m < 4; ++m) _Pragma("unroll") for (int n = 0; n < 2; ++n) _Pragma("unroll") for (int k = 0; k < 2; ++k) \
        acc[ai][bj][m][n] = __builtin_amdgcn_mfma_f32_16x16x32_bf16(Bt[n][k], At[m][k], acc[ai][bj][m][n], 0, 0, 0); __builtin_amdgcn_s_setprio(0); } while (0)
#define PG8_WAIT_V(n) asm volatile("s_waitcnt vmcnt(" #n ")" ::: "memory")
#define PG8_WAIT_L(n) asm volatile("s_waitcnt lgkmcnt(" #n ")" ::: "memory")
#define PG8_BAR __builtin_amdgcn_s_barrier()
#define PG8_SCHED __builtin_amdgcn_sched_barrier(0)
#define PG8_ABASE(u) ((const char*)g.A + (size_t)(u).pm * tstepA + (size_t)(u).k0 * kstepA + (g.bd ? (size_t)((((u).pn >> 1) & 3) * 512) : (size_t)0))
#define PG8_BBASE(u) ((const char*)g.Bt + (size_t)(u).pn * tstepB + (size_t)(u).k0 * kstep)
  Unit cur, nxt; int ui = 0;
  if (!S.next(0, cur)) return;
  f32x4 acc[2][2][4][2];
#pragma unroll
  for (int a = 0; a < 2; ++a)
#pragma unroll
    for (int b = 0; b < 2; ++b)
#pragma unroll
      for (int m = 0; m < 4; ++m)
#pragma unroll
        for (int n = 0; n < 2; ++n) acc[a][b][m][n] = (f32x4){0.f, 0.f, 0.f, 0.f};
  bf16x8 At[4][2], B0[2][2], B1[2][2];
  const char* cA = PG8_ABASE(cur); const char* cB = PG8_BBASE(cur);
  PG8_STAGE(PG8_SB(0, 0), cB, voffB); PG8_STAGE(PG8_SA(0, 0), cA, voffA); PG8_STAGE(PG8_SB(0, 1), cB + hstepB, voffB); PG8_STAGE(PG8_SA(0, 1), cA + hstepA, voffA);
  if (wr == 1) PG8_BAR;
  PG8_WAIT_V(4); PG8_BAR;
  PG8_STAGE(PG8_SB(1, 0), cB + kstep, voffB); PG8_STAGE(PG8_SA(1, 0), cA + kstepA, voffA); PG8_STAGE(PG8_SB(1, 1), cB + hstepB + kstep, voffB);
  PG8_WAIT_V(6); PG8_BAR;
  for (;;) {
    const bool has_next = S.next(ui + 1, nxt);
    const char* nA = has_next ? PG8_ABASE(nxt) : cA; const char* nB = has_next ? PG8_BBASE(nxt) : cB;
    const int nt = cur.nk;
#pragma unroll 1
    for (int t = 0; t < nt; t += 2) {
      const bool last = (t == nt - 2);
      const char* a1 = cA + (size_t)(t + 1) * kstepA;
      const char* a2 = last ? nA : cA + (size_t)(t + 2) * kstepA; const char* b2 = last ? nB : cB + (size_t)(t + 2) * kstep;
      const char* a3 = a2 + kstepA; const char* b3 = b2 + kstep;
      PG8_LDB(B0, 0, 0); PG8_SCHED; PG8_LDA(At, 0, 0); PG8_STAGE(PG8_SA(1, 1), a1 + hstepA, voffA);
      PG8_WAIT_L(8); PG8_BAR; PG8_WAIT_L(0); PG8_MMA(0, 0, At, B0); PG8_BAR; PG8_SCHED;
      PG8_LDB(B1, 0, 1); PG8_STAGE(PG8_SB(0, 0), b2, voffB);
      PG8_BAR; PG8_WAIT_L(0); PG8_MMA(0, 1, At, B1); PG8_BAR;
      PG8_LDA(At, 0, 1); PG8_STAGE(PG8_SA(0, 0), a2, voffA);
      PG8_BAR; PG8_WAIT_L(0); PG8_MMA(1, 0, At, B0); PG8_BAR; PG8_SCHED;
      PG8_STAGE(PG8_SB(0, 1), b2 + hstepB, voffB);
      PG8_WAIT_V(6); PG8_BAR; PG8_MMA(1, 1, At, B1); PG8_BAR;
      PG8_LDB(B0, 1, 0); PG8_SCHED; PG8_LDA(At, 1, 0); PG8_STAGE(PG8_SA(0, 1), a2 + hstepA, voffA);
      PG8_WAIT_L(8); PG8_BAR; PG8_WAIT_L(0); PG8_MMA(0, 0, At, B0); PG8_BAR; PG8_SCHED;
      PG8_LDB(B1, 1, 1); PG8_STAGE(PG8_SB(1, 0), b3, voffB);
      PG8_BAR; PG8_WAIT_L(0); PG8_MMA(0, 1, At, B1); PG8_BAR;
      PG8_LDA(At, 1, 1); PG8_STAGE(PG8_SA(1, 0), a3, voffA);
      PG8_BAR; PG8_WAIT_L(0); PG8_MMA(1, 0, At, B0); PG8_BAR; PG8_SCHED;
      PG8_STAGE(PG8_SB(1, 1), b3 + hstepB, voffB);
      PG8_WAIT_V(6); PG8_BAR; PG8_MMA(1, 1, At, B1); PG8_BAR;
    }
    E(acc, cur, wr, wc, fr, fq);
    if (!has_next) break;
#pragma unroll
    for (int a = 0; a < 2; ++a)
#pragma unroll
      for (int b = 0; b < 2; ++b)
#pragma unroll
        for (int m = 0; m < 4; ++m)
#pragma unroll
          for (int n = 0; n < 2; ++n) acc[a][b][m][n] = (f32x4){0.f, 0.f, 0.f, 0.f};
    cur = nxt; cA = nA; cB = nB; ++ui;
  }
  PG8_WAIT_V(0);
  if (wr == 0) PG8_BAR;
  PG8_BAR;
#undef PG8_SA
#undef PG8_SB
#undef PG8_STAGE
#undef PG8_LDA
#undef PG8_LDB
#undef PG8_MMA
#undef PG8_WAIT_V
#undef PG8_WAIT_L
#undef PG8_BAR
#undef PG8_SCHED
#undef PG8_ABASE
#undef PG8_BBASE
}
}
using pg8::Unit;
typedef f32x4 AccT[2][2][4][2];

struct EpiSwiglu {
  static constexpr bool PERM = true;
  bf16_t* act; const float* rs; const float* bias;
  __device__ __forceinline__ void operator()(const AccT& acc, const Unit& u, int wr, int wc, int fr, int fq) const {
    const int row0 = u.pm * 256 + wr * 64 + fr, col0 = u.pn * 128 + wc * 32 + 8 * fq;
    const int mi = u.pm < 64 ? 0 : (u.pm < 128 ? 1 : 2);
    const float* bp = bias + (size_t)mi * (2 * FF) + u.pn * 256 + wc * 32 + 8 * fq;
    f32x4 bg[2], bu[2]; float rv[2][4];
#pragma unroll
    for (int n = 0; n < 2; ++n) { bg[n] = *(const f32x4*)(bp + n * 4); bu[n] = *(const f32x4*)(bp + 128 + n * 4); }
#pragma unroll
    for (int ai = 0; ai < 2; ++ai)
#pragma unroll
      for (int m = 0; m < 4; ++m) rv[ai][m] = rs[row0 + ai * 128 + m * 16];
#pragma unroll
    for (int ai = 0; ai < 2; ++ai)
#pragma unroll
      for (int m = 0; m < 4; ++m) rv[ai][m] = rsqrtf(rv[ai][m] * (1.0f / 1024.0f) + 1e-6f);
#pragma unroll
    for (int ai = 0; ai < 2; ++ai)
#pragma unroll
      for (int m = 0; m < 4; ++m) {
        const int r = row0 + ai * 128 + m * 16;
        bf16_t* rowp = act + ((size_t)(r >> 8) * (FF / 64) + (col0 >> 6)) * 16384 + (size_t)(r & 255) * 64 + (col0 & 63);
        u32x4 ow;
#pragma unroll
        for (int n = 0; n < 2; ++n) {
          const f32x4 gg = acc[ai][0][m][n] * rv[ai][m] + bg[n], uu = acc[ai][1][m][n] * rv[ai][m] + bu[n]; f32x4 v;
#pragma unroll
          for (int j = 0; j < 4; ++j) v[j] = gg[j] * fast_sigmoid(gg[j]) * uu[j];
          const u32x2 pk2 = pack4(v);
          if (n == 0) { ow.x = pk2.x; ow.y = pk2.y; } else { ow.z = pk2.x; ow.w = pk2.y; }
        }
        *(u32x4*)(rowp) = ow;
      }
  }
};
template <bool SRCF32, bool HALF>
struct EpiResid {
  static constexpr bool PERM = true;
  const float* src_f32; bf16_t* xbuf; unsigned char* wsb; int qi;
  __device__ __forceinline__ void operator()(const AccT& acc, const Unit& u, int wr, int wc, int fr, int fq) const {
    unsigned char* w2 = wsb; asm volatile("" : "+s"(w2));
    const int q = qi, l = q / 3, s3 = q - 3 * l;
    const float* gate = (const float*)(w2 + OFF_MOD) + l * 3 * NMOD + (HALF ? 3 * s3 + 2 : 5) * 1024;
    bf16_t* anext = q < 5 ? (bf16_t*)(w2 + OFF_H) : (bf16_t*)nullptr; const float* gsn = (const float*)(w2 + OFF_GS) + (q + 1) * 3072; float* rsp = (float*)(w2 + OFF_RSP);
    const size_t slab_off = HALF ? OFF_EXTRA : OFF_BIG;
    bf16_t* xdst = q < 5 ? xbuf : (bf16_t*)(w2 + OFF_H);
    const int row0 = u.pm * 256 + wr * 64 + fr, col0 = u.pn * 256 + wc * 32 + 8 * fq;
    const int mi = u.pm < 64 ? 0 : (u.pm < 128 ? 1 : 2);
    const float* gp = gate + (size_t)mi * NMOD + col0;
    f32x4 gv[2][2];
#pragma unroll
    for (int bj = 0; bj < 2; ++bj)
#pragma unroll
      for (int n = 0; n < 2; ++n) gv[bj][n] = *(const f32x4*)(gp + bj * 128 + n * 4) * (HALF ? 0.5f : 1.0f);
    if (u.pm < 128) {
      const size_t e0 = (size_t)row0 * D + col0;
      const float* gsp = gsn + mi * 1024 + col0;
      f32x4 gsv[2][2];
#pragma unroll
      for (int bj = 0; bj < 2; ++bj)
#pragma unroll
        for (int n = 0; n < 2; ++n) gsv[bj][n] = anext ? *(const f32x4*)(gsp + bj * 128 + n * 4) : (f32x4){0.f, 0.f, 0.f, 0.f};
      f32x4 xb[2][2][2];
#define RES_LOAD(dst, eoff) do { _Pragma("unroll") for (int bj = 0; bj < 2; ++bj) { \
          if (SRCF32) { dst[bj][0] = *(const f32x4*)(src_f32 + (eoff) + bj * 128); dst[bj][1] = *(const f32x4*)(src_f32 + (eoff) + bj * 128 + 4); } \
          else { const u32x4 w_ = *(const u32x4*)(xbuf + (eoff) + bj * 128); u32x2 lo_, hi_; lo_.x = w_.x; lo_.y = w_.y; hi_.x = w_.z; hi_.y = w_.w; dst[bj][0] = unpack4(lo_); dst[bj][1] = unpack4(hi_); } } } while (0)
      RES_LOAD(xb[0], e0);
#pragma unroll
      for (int st = 0; st < 8; ++st) {
        const int ai = st >> 2, m = st & 3, cur = st & 1, rr = ai * 128 + m * 16;
        if (st < 7) { const int rn = ((st + 1) >> 2) * 128 + ((st + 1) & 3) * 16; RES_LOAD(xb[cur ^ 1], e0 + (size_t)rn * D); }
        float ss = 0.f;
#pragma unroll
        for (int bj = 0; bj < 2; ++bj) {
          const f32x4 x0 = xb[cur][bj][0] + gv[bj][0] * acc[ai][bj][m][0], x1 = xb[cur][bj][1] + gv[bj][1] * acc[ai][bj][m][1];
          const u32x2 p0 = pack4(x0), p1 = pack4(x1);
          u32x4 ow; ow.x = p0.x; ow.y = p0.y; ow.z = p1.x; ow.w = p1.y;
          *(u32x4*)(xdst + e0 + (size_t)rr * D + bj * 128) = ow;
          if (anext) {
            const u32x2 q0 = pack4(x0 * gsv[bj][0]), q1 = pack4(x1 * gsv[bj][1]);
            u32x4 aw; aw.x = q0.x; aw.y = q0.y; aw.z = q1.x; aw.w = q1.y;
            *(u32x4*)(anext + e0 + (size_t)rr * D + bj * 128) = aw;
            ss += x0[0] * x0[0] + x0[1] * x0[1] + x0[2] * x0[2] + x0[3] * x0[3] + x1[0] * x1[0] + x1[1] * x1[1] + x1[2] * x1[2] + x1[3] * x1[3];
          }
        }
        if (anext) { ss += shx(ss, 16, fr + 16 * fq); ss += shx(ss, 32, fr + 16 * fq); if (fq == 0) rsp[(size_t)(row0 + rr) * 16 + u.pn * 4 + wc] = ss; }
      }
#undef RES_LOAD
    } else {
#pragma unroll
      for (int ai = 0; ai < 2; ++ai)
#pragma unroll
        for (int m = 0; m < 4; ++m) {
          float* d = (float*)(w2 + slab_off) + (size_t)(u.k0 / u.nk) * MC * D + (size_t)(row0 + ai * 128 + m * 16 - MX) * D + col0;
#pragma unroll
          for (int bj = 0; bj < 2; ++bj)
#pragma unroll
            for (int n = 0; n < 2; ++n) *(f32x4*)(d + bj * 128 + n * 4) = gv[bj][n] * acc[ai][bj][m][n];
        }
    }
  }
};
struct EpiEvenIn {
  static constexpr bool PERM = false;
  bf16_t* UZ; bf16_t* Q; bf16_t* Kb; bf16_t* Vb; const float* ropeC; const float* ropeS; const float* rs; const float* bias;
  __device__ __forceinline__ void operator()(const AccT& acc, const Unit& u, int wr, int wc, int fr, int fq) const {
    const int row0 = u.pm * 256 + wr * 64 + fr;
    const int mi = u.pm < 64 ? 0 : (u.pm < 128 ? 1 : 2);
    const float* bp = bias + (size_t)mi * EVIN_N + u.pn * 256 + wc * 32 + 4 * fq;
    f32x4 bv[2][2]; float rv[2][4];
#pragma unroll
    for (int bj = 0; bj < 2; ++bj)
#pragma unroll
      for (int n = 0; n < 2; ++n) bv[bj][n] = *(const f32x4*)(bp + bj * 128 + n * 16);
#pragma unroll
    for (int ai = 0; ai < 2; ++ai)
#pragma unroll
      for (int m = 0; m < 4; ++m) rv[ai][m] = rs[row0 + ai * 128 + m * 16];
#pragma unroll
    for (int ai = 0; ai < 2; ++ai)
#pragma unroll
      for (int m = 0; m < 4; ++m) rv[ai][m] = rsqrtf(rv[ai][m] * (1.0f / 1024.0f) + 1e-6f);
    if (u.pn < 4) {
      const int col0 = u.pn * 256 + wc * 32 + 4 * fq;
#pragma unroll
      for (int ai = 0; ai < 2; ++ai)
#pragma unroll
        for (int m = 0; m < 4; ++m) {
          const int r = row0 + ai * 128 + m * 16;
          bf16_t* rowp = UZ + (size_t)r * D + col0;
#pragma unroll
          for (int bj = 0; bj < 2; ++bj)
#pragma unroll
            for (int n = 0; n < 2; ++n) { f32x4 v = acc[ai][bj][m][n] * rv[ai][m] + bv[bj][n];
#pragma unroll
              for (int j = 0; j < 4; ++j) v[j] = gelu_tanh(v[j]);
              *(u32x2*)(rowp + bj * 128 + n * 16) = pack4(v); }
        }
    } else {
      const bool rope_on = u.pm < 128;
      const bool by_col = (wc & 1) != 0;
      f32x4 csb[2], snb[2];
      { const int pos = row0 & (SEQ - 1); const int pidx = by_col ? (pos & 63) : (pos >> 6);
        csb[0] = *(const f32x4*)(ropeC + pidx * 16 + 4 * fq); snb[0] = *(const f32x4*)(ropeS + pidx * 16 + 4 * fq); }
#pragma unroll
      for (int st = 0; st < 8; ++st) {
        const int ai = st >> 2, m = st & 3, cur = st & 1;
        const int r = row0 + ai * 128 + m * 16;
        if (st < 7) { const int rn = row0 + ((st + 1) >> 2) * 128 + ((st + 1) & 3) * 16; const int pos = rn & (SEQ - 1); const int pidx = by_col ? (pos & 63) : (pos >> 6);
          csb[cur ^ 1] = *(const f32x4*)(ropeC + pidx * 16 + 4 * fq); snb[cur ^ 1] = *(const f32x4*)(ropeS + pidx * 16 + 4 * fq); }
        f32x4 cs = csb[cur], sn = snb[cur];
        if (!rope_on) { cs = (f32x4){1.f, 1.f, 1.f, 1.f}; sn = (f32x4){0.f, 0.f, 0.f, 0.f}; }
#pragma unroll
        for (int bj = 0; bj < 2; ++bj) {
          const f32x4 x1 = acc[ai][bj][m][0] * rv[ai][m] + bv[bj][0], x2 = acc[ai][bj][m][1] * rv[ai][m] + bv[bj][1];
          if (u.pn < 6) {
            const f32x4 o1 = (x1 * cs - x2 * sn) * 0.18033688011112042f, o2 = (x1 * sn + x2 * cs) * 0.18033688011112042f;
            bf16_t* qp = Q + (size_t)r * 512 + (u.pn - 4) * 256 + bj * 128 + wc * 32 + 4 * fq;
            *(u32x2*)(qp) = pack4(o1); *(u32x2*)(qp + 16) = pack4(o2);
          } else if (bj == 0) {
            const f32x4 o1 = x1 * cs - x2 * sn, o2 = x1 * sn + x2 * cs;
            bf16_t* kp = Kb + (size_t)r * 128 + wc * 32 + 4 * fq;
            *(u32x2*)(kp) = pack4(o1); *(u32x2*)(kp + 16) = pack4(o2);
          } else {
            bf16_t* vp = Vb + (size_t)r * 128 + wc * 32 + 4 * fq;
            *(u32x2*)(vp) = pack4(x1); *(u32x2*)(vp + 16) = pack4(x2);
          }
        }
      }
    }
  }
};
struct EpiOddIn {
  static constexpr bool PERM = false;
  bf16_t* G; bf16_t* XX; const float* rs; const float* bias;
  __device__ __forceinline__ void operator()(const AccT& acc, const Unit& u, int wr, int wc, int fr, int fq) const {
    const int row0 = u.pm * 256 + wr * 64 + fr;
    const int mi = u.pm < 64 ? 0 : (u.pm < 128 ? 1 : 2);
    const float* bp = bias + (size_t)mi * 2048 + u.pn * 256 + wc * 32 + 4 * fq;
    f32x4 bv[2][2];
#pragma unroll
    for (int bj = 0; bj < 2; ++bj)
#pragma unroll
      for (int n = 0; n < 2; ++n) bv[bj][n] = *(const f32x4*)(bp + bj * 128 + n * 16);
    float rvv[2][4];
#pragma unroll
    for (int ai = 0; ai < 2; ++ai)
#pragma unroll
      for (int m = 0; m < 4; ++m) rvv[ai][m] = rs[row0 + ai * 128 + m * 16];
#pragma unroll
    for (int ai = 0; ai < 2; ++ai)
#pragma unroll
      for (int m = 0; m < 4; ++m) rvv[ai][m] = rsqrtf(rvv[ai][m] * (1.0f / 1024.0f) + 1e-6f);
    const bool isg = u.pn < 4;
    bf16_t* base = isg ? G : XX;
    const int col0 = (u.pn & 3) * 256 + wc * 32 + 4 * fq;
#pragma unroll
    for (int ai = 0; ai < 2; ++ai)
#pragma unroll
      for (int m = 0; m < 4; ++m) {
        const int r = row0 + ai * 128 + m * 16;
        const float rv = rvv[ai][m];
        bf16_t* rowp = base + (size_t)r * D + col0;
#pragma unroll
        for (int bj = 0; bj < 2; ++bj)
#pragma unroll
          for (int n = 0; n < 2; ++n) { f32x4 v = acc[ai][bj][m][n] * rv + bv[bj][n];
            if (isg) {
#pragma unroll
              for (int j = 0; j < 4; ++j) v[j] = gelu_tanh(v[j]); }
            *(u32x2*)(rowp + bj * 128 + n * 16) = pack4(v); }
      }
  }
};
struct EpiRG {
  static constexpr bool PERM = false;
  const bf16_t* XC; bf16_t* LAB; const float* ba; const float* bx; const float* sp;
  __device__ __forceinline__ void operator()(const AccT& acc, const Unit& u, int wr, int wc, int fr, int fq) const {
    const int row0 = u.pm * 256 + wr * 64 + fr;
    const int d = u.pn >> 3, h = (u.pn >> 1) & 3, cb = u.pn & 1;
    const int ch0 = h * 256 + cb * 128 + wc * 32 + 4 * fq;
    bf16_t* LA = LAB + (size_t)(2 * d) * MR * D; bf16_t* BB = LA + (size_t)MR * D;
    f32x4 bav[2], bxv[2], spv[2]; u32x2 xw[2][2][4];
#pragma unroll
    for (int n = 0; n < 2; ++n) { bav[n] = *(const f32x4*)(ba + d * 1024 + ch0 + n * 16); bxv[n] = *(const f32x4*)(bx + d * 1024 + ch0 + n * 16); spv[n] = *(const f32x4*)(sp + d * 1024 + ch0 + n * 16); }
#pragma unroll
    for (int ai = 0; ai < 2; ++ai)
#pragma unroll
      for (int m = 0; m < 4; ++m) xw[0][ai][m] = *(const u32x2*)(XC + (size_t)(row0 + ai * 128 + m * 16) * D + ch0);
#pragma unroll
    for (int n = 0; n < 2; ++n)
#pragma unroll
      for (int ai = 0; ai < 2; ++ai)
#pragma unroll
        for (int m = 0; m < 4; ++m) {
          const size_t ro = (size_t)(row0 + ai * 128 + m * 16) * D + ch0 + n * 16;
          if (n == 0) xw[1][ai][m] = *(const u32x2*)(XC + ro + 16);
          const f32x4 xv = unpack4(xw[n][ai][m]);
          f32x4 la, bb;
#pragma unroll
          for (int j = 0; j < 4; ++j) {
            const float rr = fast_sigmoid(acc[ai][0][m][n][j] + bav[n][j]), ii = fast_sigmoid(acc[ai][1][m][n][j] + bxv[n][j]);
            const float l = rr * spv[n][j];
            la[j] = l; bb[j] = __fsqrt_rn(fmaxf(1.0f - __expf(2.0f * l), 0.f)) * ii * xv[j];
          }
          *(u32x2*)(LA + ro) = pack4(la); *(u32x2*)(BB + ro) = pack4(bb);
        }
  }
};

__device__ __forceinline__ void cvt_tile(const float* src, int ld, bf16_t* dst, int ldd, LAS float* tile) { const int tid_l = launder_v((int)threadIdx.x);
  const int t = tid_l, a = t >> 6, b = t & 63;
#pragma unroll
  for (int i = 0; i < 8; ++i) tile[(i * 8 + a) * 65 + b] = src[(size_t)(i * 8 + a) * ld + b];
  __syncthreads();
#pragma unroll
  for (int i = 0; i < 8; ++i) dst[(size_t)(i * 8 + a) * ldd + b] = f2bf(tile[b * 65 + i * 8 + a]);
  __syncthreads();
}
__device__ __forceinline__ void sincos_taylor(double r, double& s, double& c) {
  const double r2 = r * r; double ts = r, tc = 1.0; s = r; c = 1.0;
  for (int i = 1; i <= 15; ++i) { tc = -tc * r2 / (double)((2 * i - 1) * (2 * i)); ts = -ts * r2 / (double)((2 * i) * (2 * i + 1)); c += tc; s += ts; }
}
__device__ __forceinline__ void prologue(PK pk, LAS unsigned char* lds, const int bid, const int nb) { const int tid_l = launder_v((int)threadIdx.x);
  unsigned char* ws = pk->ws;
  const int tid = tid_l;
  LAS float* tile = (LAS float*)lds;
  LAS float* sc = (LAS float*)(lds + 16640);
  LAS float* red = (LAS float*)(lds + 16640 + 12288);
  for (int i = tid; i < 3072; i += 512) { const int v = i >> 10, k = i & 1023; const float x = v < 2 ? pk->in[I_C][v * 1024 + k] : pk->in[I_CCTX][k]; sc[i] = x * fast_sigmoid(x); }
  __syncthreads();
  float* mod = (float*)(ws + OFF_MOD);
  for (int it = bid; it < 288; it += nb) {
    const int l = it / 144, cb = it % 144, kg = tid >> 6, j = tid & 63;
    const float* w = pk->in[I_ADAW] + (size_t)l * D * NMOD + (size_t)(kg * 128) * NMOD + cb * 64 + j;
    float a0 = 0.f, a1 = 0.f, a2 = 0.f;
    for (int k = 0; k < 128; ++k) { const float wv = w[(size_t)k * NMOD]; a0 += sc[kg * 128 + k] * wv; a1 += sc[1024 + kg * 128 + k] * wv; a2 += sc[2048 + kg * 128 + k] * wv; }
    red[(kg * 3 + 0) * 64 + j] = a0; red[(kg * 3 + 1) * 64 + j] = a1; red[(kg * 3 + 2) * 64 + j] = a2;
    __syncthreads();
    if (tid < 192) { const int v = tid >> 6, jj = tid & 63; float s = pk->in[I_ADAB][l * NMOD + cb * 64 + jj];
      for (int q = 0; q < 8; ++q) s += red[(q * 3 + v) * 64 + jj];
      mod[((size_t)l * 3 + v) * NMOD + cb * 64 + jj] = s; }
    __syncthreads();
  }
  { float* rc = (float*)(ws + OFF_ROPE); float* rs = rc + 4096;
    for (int i = bid * 512 + tid; i < 4096; i += nb * 512) { const int pp = i >> 4, f = i & 15;
      const float inv = powf(10000.0f, -(float)f / 16.0f); const float ang = (float)pp * inv;
      const double ad = (double)ang; const double kq = rint(ad * 0.15915494309189535); const double r = ad - kq * 6.283185307179586477;
      double s, c; sincos_taylor(r, s, c); rc[i] = (float)c; rs[i] = (float)s; } }
  { float* sp = (float*)(ws + OFF_SP); for (int i = bid * 512 + tid; i < 2048; i += nb * 512) sp[i] = -8.0f * log1pf(expf(-pk->in[I_LAM][i])); }
  { float* cr = (float*)(ws + OFF_CTXR); const float* ci = pk->in[I_CTX]; for (int i = bid * 512 + tid_l; i < MC * D / 4; i += nb * 512) *(f32x4*)(cr + 4 * (size_t)i) = *(const f32x4*)(ci + 4 * (size_t)i); }
  { bf16_t* o = (bf16_t*)(ws + OFF_GMWS); for (int i = bid * 512 + tid; i < 65536; i += nb * 512) o[i] = f2bf(pk->in[I_GMWS][i]); }
  for (int ti = bid; ti < 10176; ti += nb) {
    int r = ti;
    if (r < 5632) { const int j = r / 1408, rem = r % 1408, nbk = rem >> 4, kb = rem & 15, pn = nbk >> 2, sub = nbk & 3;
      const float* src = (sub < 2 ? pk->in[I_WG] : pk->in[I_WU]) + (size_t)j * D * FF + (size_t)(kb * 64) * FF + pn * 128 + (sub & 1) * 64;
      cvt_tile(src, FF, (bf16_t*)(ws + OFF_W1 + j * SZ_W1) + (size_t)(nbk * 64) * D + kb * 64, D, tile); continue; }
    r -= 5632;
    if (r < 2816) { const int j = r / 704, rem = r % 704, nbk = rem / 44, kb = rem % 44;
      const float* src = pk->in[I_WD] + (size_t)j * FF * D + (size_t)(kb * 64) * D + nbk * 64;
      cvt_tile(src, D, (bf16_t*)(ws + OFF_W2 + j * SZ_W2) + (size_t)(nbk * 64) * FF + kb * 64, FF, tile); continue; }
    r -= 2816;
    if (r < 448) { const int nbk = r >> 4, kb = r & 15;
      cvt_tile(pk->in[I_EVIN] + (size_t)(kb * 64) * EVIN_N + nbk * 64, EVIN_N, (bf16_t*)(ws + OFF_EVIN) + (size_t)(nbk * 64) * D + kb * 64, D, tile); continue; }
    r -= 448;
    if (r < 256) { const int nbk = r >> 4, kb = r & 15;
      cvt_tile(pk->in[I_EVOUT] + (size_t)(kb * 64) * D + nbk * 64, D, (bf16_t*)(ws + OFF_EVOUT) + (size_t)(nbk * 64) * D + kb * 64, D, tile); continue; }
    r -= 256;
    if (r < 512) { const int nbk = r >> 4, kb = r & 15;
      cvt_tile(pk->in[I_ODIN] + (size_t)(kb * 64) * 2048 + nbk * 64, 2048, (bf16_t*)(ws + OFF_ODIN) + (size_t)(nbk * 64) * D + kb * 64, D, tile); continue; }
    r -= 512;
    if (r < 256) { const int nbk = r >> 4, kb = r & 15;
      cvt_tile(pk->in[I_ODOUT] + (size_t)(kb * 64) * D + nbk * 64, D, (bf16_t*)(ws + OFF_ODOUT) + (size_t)(nbk * 64) * D + kb * 64, D, tile); continue; }
    r -= 256;
    { const int nbk = r >> 2, kb = r & 3, t = nbk >> 2, sub = nbk & 3, d = t >> 3, h = (t >> 1) & 3, cb = t & 1;
      const float* src = (sub < 2 ? pk->in[I_RGWA] : pk->in[I_RGWX]) + (size_t)(d * 4 + h) * 65536 + (size_t)(kb * 64) * 256 + cb * 128 + (sub & 1) * 64;
      cvt_tile(src, 256, (bf16_t*)(ws + OFF_RGW) + (size_t)(nbk * 64) * 256 + kb * 64, 256, tile); }
  }
}

__device__ __forceinline__ void phase_prep(const float* src_lat, float* src_ctx, const float* gs, bf16_t* h, float* rs, int r0, const float* slab, int nslab, const float* rsp, bool reduce_lat, const int bid, const int nb) { const int tid_l = launder_v((int)threadIdx.x);
  const int lane = tid_l & 63, wv = tid_l >> 6;
  for (int rb = r0 + (bid * 8 + wv) * 2; rb < MR; rb += nb * 16) {
    f32x4 v[2][4];
#pragma unroll
    for (int q = 0; q < 2; ++q) { const int r = rb + q; const float* xr = r < MX ? src_lat + (size_t)r * D : src_ctx + (size_t)(r - MX) * D;
#pragma unroll
      for (int i = 0; i < 4; ++i) v[q][i] = *(const f32x4*)(xr + i * 256 + lane * 4); }
    if (rb >= MX && nslab > 0) {
      for (int sl = 0; sl < nslab; ++sl)
#pragma unroll
        for (int q = 0; q < 2; ++q)
#pragma unroll
          for (int i = 0; i < 4; ++i) v[q][i] = v[q][i] + *(const f32x4*)(slab + ((size_t)sl * MC + (rb + q - MX)) * D + i * 256 + lane * 4);
#pragma unroll
      for (int q = 0; q < 2; ++q)
#pragma unroll
        for (int i = 0; i < 4; ++i) *(f32x4*)(src_ctx + (size_t)(rb + q - MX) * D + i * 256 + lane * 4) = v[q][i];
    }
#pragma unroll
    for (int q = 0; q < 2; ++q) { const int r = rb + q; const int mi = r < SEQ ? 0 : (r < MX ? 1 : 2);
      float ss = 0.f;
#pragma unroll
      for (int i = 0; i < 4; ++i) { ss += v[q][i][0] * v[q][i][0] + v[q][i][1] * v[q][i][1] + v[q][i][2] * v[q][i][2] + v[q][i][3] * v[q][i][3];
        const f32x4 g4 = *(const f32x4*)(gs + mi * 1024 + i * 256 + lane * 4);
        *(u32x2*)(h + (size_t)r * D + i * 256 + lane * 4) = pack4(v[q][i] * g4); }
      ss = wave_sum(ss, lane);
      if (lane == 0) rs[r] = ss; }
  }
  if (reduce_lat) {
    for (int r = bid * 512 + tid_l; r < MX; r += nb * 512) {
      const f32x4 a = *(const f32x4*)(rsp + (size_t)r * 16), b = *(const f32x4*)(rsp + (size_t)r * 16 + 4), c = *(const f32x4*)(rsp + (size_t)r * 16 + 8), d = *(const f32x4*)(rsp + (size_t)r * 16 + 12);
      rs[r] = ((((a[0] + a[1]) + (a[2] + a[3])) + ((b[0] + b[1]) + (b[2] + b[3]))) + (((c[0] + c[1]) + (c[2] + c[3])) + ((d[0] + d[1]) + (d[2] + d[3]))));
    }
  }
}
__device__ __forceinline__ void prologue2(PK pk, const int bid, const int nb) { const int tid_l = launder_v((int)threadIdx.x);
  unsigned char* ws = pk->ws; const float* mod = (const float*)(ws + OFF_MOD);
  { float* gs = (float*)(ws + OFF_GS);
    for (int i = bid * 512 + tid_l; i < 2 * 3 * 3 * 1024; i += nb * 512) { const int c = i & 1023, mi = (i >> 10) % 3, lj = i / 3072, l = lj / 3, j = lj % 3;
      gs[i] = pk->in[I_NORMG][(size_t)(l * 3 + j) * D + c] * (1.0f + mod[(size_t)(l * 3 + mi) * NMOD + (3 * j + 1) * 1024 + c]); } }
  const int lane = tid_l & 63, wv = tid_l >> 6;
  for (int t = bid * 8 + wv; t < 4 * 5632 + 1792 + 2048; t += nb * 8) {
    const bf16_t* wrow; float* bo; int l, j, n, ncols;
    if (t < 4 * 5632) { const int j4 = t / 5632; n = t % 5632; l = j4 >> 1; j = (j4 & 1) * 2; ncols = 5632; wrow = (const bf16_t*)(ws + OFF_W1 + j4 * SZ_W1) + (size_t)n * D; bo = (float*)(ws + OFF_BIASF) + (size_t)j4 * 3 * 5632; }
    else if (t < 4 * 5632 + 1792) { n = t - 4 * 5632; l = 0; j = 1; ncols = 1792; wrow = (const bf16_t*)(ws + OFF_EVIN) + (size_t)n * D; bo = (float*)(ws + OFF_BIASE); }
    else { n = t - 4 * 5632 - 1792; l = 1; j = 1; ncols = 2048; wrow = (const bf16_t*)(ws + OFF_ODIN) + (size_t)n * D; bo = (float*)(ws + OFF_BIASO); }
    const u32x4 w0 = *(const u32x4*)(wrow + lane * 16), w1 = *(const u32x4*)(wrow + lane * 16 + 8);
    const float wf[16] = {bflo(w0.x), bfhi(w0.x), bflo(w0.y), bfhi(w0.y), bflo(w0.z), bfhi(w0.z), bflo(w0.w), bfhi(w0.w), bflo(w1.x), bfhi(w1.x), bflo(w1.y), bfhi(w1.y), bflo(w1.z), bfhi(w1.z), bflo(w1.w), bfhi(w1.w)};
#pragma unroll
    for (int mi = 0; mi < 3; ++mi) { const float* sh = mod + (size_t)(l * 3 + mi) * NMOD + (3 * j) * 1024 + lane * 16; float a = 0.f;
#pragma unroll
      for (int q = 0; q < 4; ++q) { const f32x4 s4 = *(const f32x4*)(sh + 4 * q); a += s4[0] * wf[4 * q] + s4[1] * wf[4 * q + 1] + s4[2] * wf[4 * q + 2] + s4[3] * wf[4 * q + 3]; }
      a = wave_sum(a, lane);
      if (lane == 0) bo[(size_t)mi * ncols + n] = a; }
  }
}
__device__ __forceinline__ void phase_final_norm(float* out, const bf16_t* xb, const float* g, const int bid, const int nb) { const int tid_l = launder_v((int)threadIdx.x);
  const int lane = tid_l & 63, wv = tid_l >> 6;
  f32x4 gv[2][2];
#pragma unroll
  for (int i = 0; i < 2; ++i) { gv[i][0] = *(const f32x4*)(g + i * 512 + lane * 8); gv[i][1] = *(const f32x4*)(g + i * 512 + lane * 8 + 4); }
  for (int rb = (bid * 8 + wv) * 8; rb < MX; rb += nb * 64) {
    u32x4 w[8][2];
#pragma unroll
    for (int q = 0; q < 8; ++q)
#pragma unroll
      for (int i = 0; i < 2; ++i) w[q][i] = *(const u32x4*)(xb + (size_t)(rb + q) * D + i * 512 + lane * 8);
#pragma unroll
    for (int q = 0; q < 8; ++q) {
      f32x4 v[2][2]; float ss = 0.f;
#pragma unroll
      for (int i = 0; i < 2; ++i) { u32x2 lo, hi; lo.x = w[q][i].x; lo.y = w[q][i].y; hi.x = w[q][i].z; hi.y = w[q][i].w; v[i][0] = unpack4(lo); v[i][1] = unpack4(hi);
#pragma unroll
        for (int h = 0; h < 2; ++h) ss += v[i][h][0] * v[i][h][0] + v[i][h][1] * v[i][h][1] + v[i][h][2] * v[i][h][2] + v[i][h][3] * v[i][h][3]; }
      ss = wave_sum(ss, lane);
      const float rstd = rsqrtf(ss * (1.0f / 1024.0f) + 1e-6f);
#pragma unroll
      for (int i = 0; i < 2; ++i)
#pragma unroll
        for (int h = 0; h < 2; ++h) *(f32x4*)(out + (size_t)(rb + q) * D + i * 512 + lane * 8 + h * 4) = v[i][h] * rstd * gv[i][h]; }
  }
}

constexpr int VSTR = 648;
__device__ __forceinline__ void attn_unit(PK pk, int u, LAS unsigned char* lds) { const int tid_l = launder_v((int)threadIdx.x);
  const bf16_t* Q = (const bf16_t*)(pk->ws + OFF_Q); const bf16_t* Kb = (const bf16_t*)(pk->ws + OFF_K); const bf16_t* Vb = (const bf16_t*)(pk->ws + OFF_V);
  bf16_t* MIX = (bf16_t*)(pk->ws + OFF_MIXE);
  const int tid = tid_l, wv = tid >> 6, lane = tid & 63, fr = lane & 15, fq = lane >> 4;
  const bool is_ctx = u >= 512;
  int b, qb, kvh;
  if (!is_ctx) { b = u >> 8; qb = (u >> 1) & 127; kvh = u & 1; } else { const int j = u - 512; b = j >> 2; qb = (j >> 1) & 1; kvh = j & 1; }
  const int qrow0 = is_ctx ? MX + b * CTXL + qb * 128 : b * SEQ + qb * 128;
  LAS bf16_t* VT = (LAS bf16_t*)lds;
#pragma unroll 1
  for (int c = 0; c < 5; ++c) {
    const bool active = c >= 3 ? true : (is_ctx ? false : (c == 0 ? qb > 0 : (c == 2 ? qb < 127 : true)));
    if (!active) continue;
    const int base = c >= 3 ? MX + b * CTXL + (c - 3) * 128 : qrow0 + (c - 1) * 128;
    const int kp = tid & 63, oc = tid >> 6;
    const bf16_t* vsrc = Vb + (size_t)(base + 2 * kp) * 128 + kvh * 64 + oc * 8;
    const u32x4 v0 = *(const u32x4*)(vsrc), v1 = *(const u32x4*)(vsrc + 128);
    LAS unsigned* vdst = (LAS unsigned*)(VT + (oc * 8) * VSTR + c * 128 + 2 * kp);
    vdst[0 * (VSTR / 2)] = (v0.x & 0xffffu) | (v1.x << 16); vdst[1 * (VSTR / 2)] = (v0.x >> 16) | (v1.x & 0xffff0000u);
    vdst[2 * (VSTR / 2)] = (v0.y & 0xffffu) | (v1.y << 16); vdst[3 * (VSTR / 2)] = (v0.y >> 16) | (v1.y & 0xffff0000u);
    vdst[4 * (VSTR / 2)] = (v0.z & 0xffffu) | (v1.z << 16); vdst[5 * (VSTR / 2)] = (v0.z >> 16) | (v1.z & 0xffff0000u);
    vdst[6 * (VSTR / 2)] = (v0.w & 0xffffu) | (v1.w << 16); vdst[7 * (VSTR / 2)] = (v0.w >> 16) | (v1.w & 0xffff0000u);
  }
  __syncthreads();
  const int head = kvh * 4 + (wv >> 1);
  const float LOG2E = 1.4426950408889634f;
  const float sink2 = pk->in[I_SINK][head] * LOG2E;
  LAS unsigned char* KB0 = lds + 83968;
  constexpr int KROW = 144, KBUF = 128 * KROW;
  const int skey = tid >> 2, sseg = (tid & 3) * 2;
#define ATT_ACTIVE(c_) ((c_) >= 3 ? true : (is_ctx ? false : ((c_) == 0 ? qb > 0 : ((c_) == 2 ? qb < 127 : true))))
#define ATT_BASE(c_) ((c_) >= 3 ? MX + b * CTXL + ((c_) - 3) * 128 : qrow0 + ((c_) - 1) * 128)
  int par = 0;
#pragma unroll 1
  for (int hq = 0; hq < 2; ++hq) {
    const int qoff = (wv & 1) * 64 + hq * 32;
    float mrun[2], lrun[2]; f32x4 o[2][4];
#pragma unroll
    for (int qt = 0; qt < 2; ++qt) { mrun[qt] = sink2; lrun[qt] = 0.25f;
#pragma unroll
      for (int dt = 0; dt < 4; ++dt) o[qt][dt] = (f32x4){0.f, 0.f, 0.f, 0.f}; }
    int c = is_ctx ? 3 : (qb > 0 ? 0 : 1);
    { const bf16_t* ks = Kb + (size_t)(ATT_BASE(c) + skey) * 128 + kvh * 64 + sseg * 8;
      const u32x4 a0 = *(const u32x4*)(ks), a1 = *(const u32x4*)(ks + 8);
      LAS unsigned char* kd = KB0 + par * KBUF + skey * KROW + sseg * 16;
      *(LAS u32x4*)(kd) = a0; *(LAS u32x4*)(kd + 16) = a1; }
    __syncthreads();
#pragma unroll 1
    while (c < 5) {
      int cn = c + 1; while (cn < 5 && !ATT_ACTIVE(cn)) ++cn;
      u32x4 n0 = {0u, 0u, 0u, 0u}, n1 = {0u, 0u, 0u, 0u};
      if (cn < 5) { const bf16_t* ks = Kb + (size_t)(ATT_BASE(cn) + skey) * 128 + kvh * 64 + sseg * 8; n0 = *(const u32x4*)(ks); n1 = *(const u32x4*)(ks + 8); }
      const int dlo = c == 0 ? 0 : -100000, dhi = c == 2 ? 0 : 100000;
      const LAS unsigned char* kcur = KB0 + par * KBUF + fr * KROW + fq * 16;
#pragma unroll
      for (int qt = 0; qt < 2; ++qt) {
        const int iq = qoff + qt * 16 + fr; const int dq = 4 * fq - iq;
        const bf16_t* qp = Q + (size_t)(qrow0 + iq) * 512 + head * 64 + fq * 8;
        const bf16x8 q0 = *(const bf16x8*)(qp), q1 = *(const bf16x8*)(qp + 32);
        f32x4 st[8];
#pragma unroll
        for (int kt = 0; kt < 8; ++kt) {
          const bf16x8 k0 = *(const LAS bf16x8*)(kcur + kt * 16 * KROW), k1 = *(const LAS bf16x8*)(kcur + kt * 16 * KROW + 64);
          f32x4 sx = __builtin_amdgcn_mfma_f32_16x16x32_bf16(k0, q0, (f32x4){0.f, 0.f, 0.f, 0.f}, 0, 0, 0);
          st[kt] = __builtin_amdgcn_mfma_f32_16x16x32_bf16(k1, q1, sx, 0, 0, 0);
        }
        float mx = -1e30f;
        if (c == 0 || c == 2) {
#pragma unroll
          for (int kt = 0; kt < 8; ++kt)
#pragma unroll
            for (int j = 0; j < 4; ++j) {
              const int df = kt * 16 + j + dq;
              float sv = st[kt][j];
              if (df < dlo || df > dhi) sv = -1e30f;
              st[kt][j] = sv; mx = fmaxf(mx, sv);
            }
        } else {
#pragma unroll
          for (int kt = 0; kt < 8; ++kt)
#pragma unroll
            for (int j = 0; j < 4; ++j) mx = fmaxf(mx, st[kt][j]);
        }
        mx = fmaxf(mx, shx(mx, 16, lane)); mx = fmaxf(mx, shx(mx, 32, lane));
        const float mnew = fmaxf(mrun[qt], mx), alpha = exp2f(mrun[qt] - mnew);
        mrun[qt] = mnew;
        float ls = 0.f;
#pragma unroll
        for (int kt = 0; kt < 8; ++kt)
#pragma unroll
          for (int j = 0; j < 4; ++j) { const float pv = exp2f(st[kt][j] - mnew); st[kt][j] = pv; ls += pv; }
        lrun[qt] = lrun[qt] * alpha + ls;
#pragma unroll
        for (int dt = 0; dt < 4; ++dt) o[qt][dt] = o[qt][dt] * alpha;
#pragma unroll
        for (int kk = 0; kk < 4; ++kk) {
          u32x4 pw; pw.x = cvt_pk_bf16(st[2 * kk][0], st[2 * kk][1]); pw.y = cvt_pk_bf16(st[2 * kk][2], st[2 * kk][3]);
          pw.z = cvt_pk_bf16(st[2 * kk + 1][0], st[2 * kk + 1][1]); pw.w = cvt_pk_bf16(st[2 * kk + 1][2], st[2 * kk + 1][3]);
          const bf16x8 pf = __builtin_bit_cast(bf16x8, pw);
#pragma unroll
          for (int dt = 0; dt < 4; ++dt) {
            const LAS bf16_t* vp = VT + (dt * 16 + fr) * VSTR + c * 128 + kk * 32 + 4 * fq;
            u32x4 vw; const u32x2 va = *(const LAS u32x2*)(vp), vb = *(const LAS u32x2*)(vp + 16);
            vw.x = va.x; vw.y = va.y; vw.z = vb.x; vw.w = vb.y;
            o[qt][dt] = __builtin_amdgcn_mfma_f32_16x16x32_bf16(__builtin_bit_cast(bf16x8, vw), pf, o[qt][dt], 0, 0, 0);
          }
        }
      }
      if (cn < 5) { LAS unsigned char* kd = KB0 + (par ^ 1) * KBUF + skey * KROW + sseg * 16; *(LAS u32x4*)(kd) = n0; *(LAS u32x4*)(kd + 16) = n1; }
      __syncthreads();
      c = cn; par ^= 1;
    }
#pragma unroll
    for (int qt = 0; qt < 2; ++qt) {
      float l = lrun[qt]; l += shx(l, 16, lane); l += shx(l, 32, lane);
      const float inv = 1.0f / l;
      bf16_t* op = MIX + (size_t)(qrow0 + qoff + qt * 16 + fr) * D + 512 + head * 64 + 4 * fq;
#pragma unroll
      for (int dt = 0; dt < 4; ++dt) *(u32x2*)(op + dt * 16) = pack4(o[qt][dt] * inv);
    }
  }
  __syncthreads();
}
__device__ __forceinline__ void gate_unit(PK pk, int u, LAS unsigned char* lds) { const int tid_l = launder_v((int)threadIdx.x);
  const bf16_t* UZ = (const bf16_t*)(pk->ws + OFF_UZ); bf16_t* MIX = (bf16_t*)(pk->ws + OFF_MIXE); const bf16_t* WS = (const bf16_t*)(pk->ws + OFF_GMWS);
  const int tid = tid_l, wv = tid >> 6, lane = tid & 63, fr = lane & 15, fq = lane >> 4;
  const int n = u >> 2, g = u & 3, row0 = n * 128;
  LAS float* rstd = (LAS float*)lds; LAS bf16_t* ZT = (LAS bf16_t*)(lds + 512);
  { u32x4 w[16];
#pragma unroll
    for (int i = 0; i < 16; ++i) w[i] = *(const u32x4*)(UZ + (size_t)(row0 + wv * 16 + i) * D + 512 + lane * 8);
#pragma unroll
    for (int i = 0; i < 16; ++i) {
      float ss = bflo(w[i].x) * bflo(w[i].x) + bfhi(w[i].x) * bfhi(w[i].x) + bflo(w[i].y) * bflo(w[i].y) + bfhi(w[i].y) * bfhi(w[i].y) + bflo(w[i].z) * bflo(w[i].z) + bfhi(w[i].z) * bfhi(w[i].z) + bflo(w[i].w) * bflo(w[i].w) + bfhi(w[i].w) * bfhi(w[i].w);
      ss = wave_sum(ss, lane);
      if (lane == 0) rstd[wv * 16 + i] = rsqrtf(ss * (1.0f / 512.0f) + 1e-6f); } }
  __syncthreads();
#pragma unroll
  for (int i = 0; i < 2; ++i) { const int tp = lane, oc = wv + 8 * i;
    const bf16_t* zsrc = UZ + (size_t)(row0 + 2 * tp) * D + 512 + g * 128 + oc * 8;
    const u32x4 z0 = *(const u32x4*)(zsrc), z1 = *(const u32x4*)(zsrc + D);
    const float r0 = rstd[2 * tp], r1 = rstd[2 * tp + 1]; const float* gn = pk->in[I_GMG] + g * 128 + oc * 8;
    const f32x4 g0 = *(const f32x4*)(gn), g1 = *(const f32x4*)(gn + 4);
    LAS unsigned* zd = (LAS unsigned*)(ZT + (oc * 8) * 136 + 2 * tp);
    zd[0 * 68] = cvt_pk_bf16(bflo(z0.x) * r0 * g0[0], bflo(z1.x) * r1 * g0[0]); zd[1 * 68] = cvt_pk_bf16(bfhi(z0.x) * r0 * g0[1], bfhi(z1.x) * r1 * g0[1]);
    zd[2 * 68] = cvt_pk_bf16(bflo(z0.y) * r0 * g0[2], bflo(z1.y) * r1 * g0[2]); zd[3 * 68] = cvt_pk_bf16(bfhi(z0.y) * r0 * g0[3], bfhi(z1.y) * r1 * g0[3]);
    zd[4 * 68] = cvt_pk_bf16(bflo(z0.z) * r0 * g1[0], bflo(z1.z) * r1 * g1[0]); zd[5 * 68] = cvt_pk_bf16(bfhi(z0.z) * r0 * g1[1], bfhi(z1.z) * r1 * g1[1]);
    zd[6 * 68] = cvt_pk_bf16(bflo(z0.w) * r0 * g1[2], bflo(z1.w) * r1 * g1[2]); zd[7 * 68] = cvt_pk_bf16(bfhi(z0.w) * r0 * g1[3], bfhi(z1.w) * r1 * g1[3]); }
  __syncthreads();
  bf16x8 bw[4];
#pragma unroll
  for (int kk = 0; kk < 4; ++kk) bw[kk] = *(const bf16x8*)(WS + (size_t)(g * 128 + wv * 16 + fr) * 128 + kk * 32 + fq * 8);
  const int row = row0 + wv * 16 + fr;
  const float bsv = pk->in[I_GMBS][g * 128 + wv * 16 + fr];
#pragma unroll
  for (int ct = 0; ct < 8; ++ct) {
    f32x4 acc = {0.f, 0.f, 0.f, 0.f};
#pragma unroll
    for (int kk = 0; kk < 4; ++kk) { const bf16x8 a = *(const LAS bf16x8*)(ZT + (ct * 16 + fr) * 136 + kk * 32 + fq * 8); acc = __builtin_amdgcn_mfma_f32_16x16x32_bf16(a, bw[kk], acc, 0, 0, 0); }
    const int col = g * 128 + ct * 16 + 4 * fq;
    const f32x4 uu = unpack4(*(const u32x2*)(UZ + (size_t)row * D + col));
    *(u32x2*)(MIX + (size_t)row * D + col) = pack4(uu * (acc + bsv));
  }
  __syncthreads();
}

__device__ __forceinline__ void phase_conv(PK pk, const int bid, const int nb) { const int tid_l = launder_v((int)threadIdx.x);
  const bf16_t* __restrict__ XX = (const bf16_t*)(pk->ws + OFF_XX); bf16_t* __restrict__ XC = (bf16_t*)(pk->ws + OFF_XC);
  const float* __restrict__ cw = pk->in[I_CONVW]; const float* __restrict__ cb = pk->in[I_CONVB];
#pragma unroll 4
  for (int idx = bid * 512 + tid_l; idx < MR * 128; idx += nb * 512) {
    const int r = idx >> 7, c = (idx & 127) * 8;
    int pos, len; if (r < MX) { pos = r & (SEQ - 1); len = SEQ; } else { pos = (r - MX) & (CTXL - 1); len = CTXL; }
    float a[8];
#pragma unroll
    for (int e = 0; e < 8; ++e) a[e] = cb[c + e];
#pragma unroll
    for (int j = 0; j < 4; ++j) { const int pp = pos - 1 + j;
      if (pp >= 0 && pp < len) { const u32x4 w = *(const u32x4*)(XX + (size_t)(r - 1 + j) * D + c); const float* cwj = cw + j * 1024 + c;
        a[0] += cwj[0] * bflo(w.x); a[1] += cwj[1] * bfhi(w.x); a[2] += cwj[2] * bflo(w.y); a[3] += cwj[3] * bfhi(w.y);
        a[4] += cwj[4] * bflo(w.z); a[5] += cwj[5] * bfhi(w.z); a[6] += cwj[6] * bflo(w.w); a[7] += cwj[7] * bfhi(w.w); } }
    u32x4 o; o.x = cvt_pk_bf16(a[0], a[1]); o.y = cvt_pk_bf16(a[2], a[3]); o.z = cvt_pk_bf16(a[4], a[5]); o.w = cvt_pk_bf16(a[6], a[7]);
    *(u32x4*)(XC + (size_t)r * D + c) = o;
  }
}
__device__ __forceinline__ void scan_item(int it, int& b, int& ci, int& row0, int& len) {
  if (it < 1024) { b = it >> 9; const int lc = it & 511; ci = 32 + lc; row0 = b * SEQ + lc * 32; len = 32; }
  else { const int j = it - 1024; b = j >> 5; ci = j & 31; row0 = MX + b * CTXL + ci * 8; len = 8; }
}
#define SCAN_STEP(H, LAW, BW) do { \
    H[0] = __expf(bflo(LAW.x)) * H[0] + bflo(BW.x); H[1] = __expf(bfhi(LAW.x)) * H[1] + bfhi(BW.x); \
    H[2] = __expf(bflo(LAW.y)) * H[2] + bflo(BW.y); H[3] = __expf(bfhi(LAW.y)) * H[3] + bfhi(BW.y); \
    H[4] = __expf(bflo(LAW.z)) * H[4] + bflo(BW.z); H[5] = __expf(bfhi(LAW.z)) * H[5] + bfhi(BW.z); \
    H[6] = __expf(bflo(LAW.w)) * H[6] + bflo(BW.w); H[7] = __expf(bfhi(LAW.w)) * H[7] + bfhi(BW.w); } while (0)
#define SCAN_ACCP(P, LAW) do { P[0] += bflo(LAW.x); P[1] += bfhi(LAW.x); P[2] += bflo(LAW.y); P[3] += bfhi(LAW.y); P[4] += bflo(LAW.z); P[5] += bfhi(LAW.z); P[6] += bflo(LAW.w); P[7] += bfhi(LAW.w); } while (0)
__device__ __forceinline__ void phase_scan1(PK pk, const int bid, const int nb) { const int tid_l = launder_v((int)threadIdx.x);
  const bf16_t* __restrict__ LAB = (const bf16_t*)(pk->ws + OFF_LAB); float* __restrict__ PE = (float*)(pk->ws + OFF_PE);
  const int ch = (tid_l & 127) * 8;
  for (int it = bid * 4 + (tid_l >> 7); it < 1088; it += nb * 4) {
    int b, ci, row0, len; scan_item(it, b, ci, row0, len);
#pragma unroll
    for (int d = 0; d < 2; ++d) {
      const bf16_t* __restrict__ LA = LAB + (size_t)(2 * d) * MR * D + ch; const bf16_t* __restrict__ BB = LAB + (size_t)(2 * d + 1) * MR * D + ch;
      float H[8], P[8];
#pragma unroll
      for (int e = 0; e < 8; ++e) { H[e] = 0.f; P[e] = 0.f; }
#pragma unroll 1
      for (int t0 = 0; t0 < len; t0 += 8) {
        u32x4 lw[8], bw[8];
#pragma unroll
        for (int k = 0; k < 8; ++k) { const int r = row0 + (d == 0 ? t0 + k : len - 1 - t0 - k); lw[k] = *(const u32x4*)(LA + (size_t)r * D); bw[k] = *(const u32x4*)(BB + (size_t)r * D); }
#pragma unroll
        for (int k = 0; k < 8; ++k) { SCAN_STEP(H, lw[k], bw[k]); SCAN_ACCP(P, lw[k]); }
      }
      float* pp = PE + ((size_t)(d * 2 + b) * NCH + ci) * 1024 + ch; float* ep = pp + (size_t)2 * 2 * NCH * 1024;
      *(f32x4*)(pp) = (f32x4){P[0], P[1], P[2], P[3]}; *(f32x4*)(pp + 4) = (f32x4){P[4], P[5], P[6], P[7]};
      *(f32x4*)(ep) = (f32x4){H[0], H[1], H[2], H[3]}; *(f32x4*)(ep + 4) = (f32x4){H[4], H[5], H[6], H[7]};
    }
  }
}
__device__ __forceinline__ void phase_scan2(PK pk, const int bid, const int nb) { const int tid_l = launder_v((int)threadIdx.x);
  const float* PE = (const float*)(pk->ws + OFF_PE); float* HIN = (float*)(pk->ws + OFF_HIN);
  if (bid >= 64 || tid_l >= 64) return;
  const int id = bid * 64 + tid_l, d = id >> 11, b = (id >> 10) & 1, ch = id & 1023;
  const float* pp = PE + (size_t)(d * 2 + b) * NCH * 1024 + ch; const float* ep = pp + (size_t)2 * 2 * NCH * 1024;
  float* hp = HIN + (size_t)(d * 2 + b) * NCH * 1024 + ch;
  float H = 0.f;
#pragma unroll 1
  for (int s0 = 0; s0 < NCH; s0 += 32) {
    float pv[32], ev[32];
#pragma unroll
    for (int k = 0; k < 32; ++k) { const int s = s0 + k; const int ci = d == 0 ? s : (s < 32 ? 31 - s : 575 - s); pv[k] = pp[(size_t)ci * 1024]; ev[k] = ep[(size_t)ci * 1024]; }
#pragma unroll
    for (int k = 0; k < 32; ++k) { const int s = s0 + k; const int ci = d == 0 ? s : (s < 32 ? 31 - s : 575 - s); hp[(size_t)ci * 1024] = H; H = __expf(pv[k]) * H + ev[k]; }
  }
}
__device__ __forceinline__ void phase_scan3(PK pk, LAS unsigned char* lds, const int bid, const int nb) { const int tid_l = launder_v((int)threadIdx.x);
  const bf16_t* __restrict__ LAB = (const bf16_t*)(pk->ws + OFF_LAB); const float* __restrict__ HIN = (const float*)(pk->ws + OFF_HIN);
  const bf16_t* __restrict__ G = (const bf16_t*)(pk->ws + OFF_G); bf16_t* MIX = (bf16_t*)(pk->ws + OFF_MIXO);
  const int ch = (tid_l & 127) * 8;
  LAS u32x4* slot = (LAS u32x4*)lds + tid_l;
#define S3_FWD_BATCH(T0, SINK) do { u32x4 lw[8], bw[8]; \
        _Pragma("unroll") for (int k = 0; k < 8; ++k) { const int r = row0 + (T0) + k; lw[k] = *(const u32x4*)(LA + (size_t)r * D); bw[k] = *(const u32x4*)(BB + (size_t)r * D); } \
        _Pragma("unroll") for (int k = 0; k < 8; ++k) { SCAN_STEP(H, lw[k], bw[k]); \
          u32x4 o; o.x = cvt_pk_bf16(H[0], H[1]); o.y = cvt_pk_bf16(H[2], H[3]); o.z = cvt_pk_bf16(H[4], H[5]); o.w = cvt_pk_bf16(H[6], H[7]); SINK; } } while (0)
#define S3_BWD_BATCH(T0, SRC) do { u32x4 lw[8], bw[8], gw[8]; \
        _Pragma("unroll") for (int k = 0; k < 8; ++k) { const int r = row0 + (T0) + 7 - k; lw[k] = *(const u32x4*)(LA + (size_t)r * D); bw[k] = *(const u32x4*)(BB + (size_t)r * D); gw[k] = *(const u32x4*)(G + (size_t)r * D + ch); } \
        _Pragma("unroll") for (int k = 0; k < 8; ++k) { const int r = row0 + (T0) + 7 - k; SCAN_STEP(H, lw[k], bw[k]); const u32x4 hf = SRC, gg = gw[k]; u32x4 o_; \
          o_.x = cvt_pk_bf16((bflo(hf.x) + H[0]) * bflo(gg.x), (bfhi(hf.x) + H[1]) * bfhi(gg.x)); \
          o_.y = cvt_pk_bf16((bflo(hf.y) + H[2]) * bflo(gg.y), (bfhi(hf.y) + H[3]) * bfhi(gg.y)); \
          o_.z = cvt_pk_bf16((bflo(hf.z) + H[4]) * bflo(gg.z), (bfhi(hf.z) + H[5]) * bfhi(gg.z)); \
          o_.w = cvt_pk_bf16((bflo(hf.w) + H[6]) * bflo(gg.w), (bfhi(hf.w) + H[7]) * bfhi(gg.w)); \
          *(u32x4*)(MIX + (size_t)r * D + ch) = o_; } } while (0)
  for (int it = bid * 4 + (tid_l >> 7); it < 1024  ; it += nb * 4) {
    int b, ci, row0, len; scan_item(it, b, ci, row0, len);
    u32x4 hfr[8];
    { const bf16_t* LA = LAB + ch; const bf16_t* __restrict__ BB = LAB + (size_t)MR * D + ch;
      const float* hp = HIN + ((size_t)(0 * 2 + b) * NCH + ci) * 1024 + ch;
      const f32x4 h0 = *(const f32x4*)(hp), h1 = *(const f32x4*)(hp + 4);
      float H[8] = {h0[0], h0[1], h0[2], h0[3], h1[0], h1[1], h1[2], h1[3]};
#pragma unroll 1
      for (int t0 = 0; t0 < 16; t0 += 8) S3_FWD_BATCH(t0, slot[(t0 + k) * 512] = o);
      S3_FWD_BATCH(16, *(u32x4*)(MIX + (size_t)(row0 + 16 + k) * D + ch) = o);
      S3_FWD_BATCH(24, hfr[k] = o);
    }
    { const bf16_t* __restrict__ LA = LAB + (size_t)2 * MR * D + ch; const bf16_t* __restrict__ BB = LAB + (size_t)3 * MR * D + ch;
      const float* hp = HIN + ((size_t)(1 * 2 + b) * NCH + ci) * 1024 + ch;
      const f32x4 h0 = *(const f32x4*)(hp), h1 = *(const f32x4*)(hp + 4);
      float H[8] = {h0[0], h0[1], h0[2], h0[3], h1[0], h1[1], h1[2], h1[3]};
      S3_BWD_BATCH(24, hfr[7 - k]);
      { u32x4 hfw[8];
#pragma unroll
        for (int k = 0; k < 8; ++k) hfw[k] = *(const u32x4*)(MIX + (size_t)(row0 + 23 - k) * D + ch);
        S3_BWD_BATCH(16, hfw[k]); }
#pragma unroll 1
      for (int t0 = 8; t0 >= 0; t0 -= 8) S3_BWD_BATCH(t0, slot[(t0 + 7 - k) * 512]);
    }
  }
#undef S3_FWD_BATCH
#undef S3_BWD_BATCH
}

#define XB_TMO      128
#define XB_XCNT(j)  (256  + 64 * (j))
#define XB_XSUB(j)  (1280 + 64 * (j))
#define XB_XGEN(j)  (2304 + 64 * (j))
#define XB_TOP      3328
#define XB_TOPGEN   3392
#define XCD_BAR_WORDS 3456
#define XB_SPIN_CAP (1u << 22)
__device__ __forceinline__ unsigned xb_ld(unsigned* p)              { return __hip_atomic_load(p, __ATOMIC_RELAXED, __HIP_MEMORY_SCOPE_AGENT); }
__device__ __forceinline__ unsigned xb_add(unsigned* p, unsigned v) { return __hip_atomic_fetch_add(p, v, __ATOMIC_RELAXED, __HIP_MEMORY_SCOPE_AGENT); }
__device__ __forceinline__ unsigned xb_xcc_id() { return (unsigned)__builtin_amdgcn_s_getreg((3 << 11) | 20) & 0xFu; }
#define XB_SPIN(cond, bar) do { unsigned _sp = 0; while (cond) { __builtin_amdgcn_s_sleep(1); \
    if ((++_sp & 255u) == 0u) { if (xb_ld(&(bar)[XB_TMO])) break; if (_sp > XB_SPIN_CAP) { atomicAdd(&(bar)[XB_TMO], 1u); break; } } } } while (0)
__device__ __forceinline__ void xcd_barrier_complete(unsigned* bar, unsigned x, unsigned& nloc, unsigned& nx) {
    const unsigned G = gridDim.x * gridDim.y * gridDim.z;
    unsigned sum, cnt, mine, sp = 0u;
    for (;;) {
        sum = 0u; cnt = 0u; mine = 0u;
#pragma unroll
        for (unsigned j = 0; j < 16; ++j) { const unsigned c = xb_ld(&bar[XB_XCNT(j)]); sum += c; cnt += (c > 0u) ? 1u : 0u; mine = (j == x) ? c : mine; }
        if (sum == G) break;
        __builtin_amdgcn_s_sleep(1);
        if ((++sp & 255u) == 0u) { if (xb_ld(&bar[XB_TMO])) break; if (sp > XB_SPIN_CAP) { atomicAdd(&bar[XB_TMO], 1u); break; } }
    }
    nloc = mine > 0u ? mine : 1u; nx = cnt > 0u ? cnt : 1u;
}
__device__ __forceinline__ void xcd_barrier(LAS unsigned char* lds) {
    asm volatile("s_waitcnt vmcnt(0)" ::: "memory");
    __syncthreads();
    if (threadIdx.x == 0) {
        PK pk_ = get_pk(); unsigned* bar = (unsigned*)(pk_->ws + OFF_BAR);
        volatile LAS unsigned* st = (volatile LAS unsigned*)(lds + 131072);
        const unsigned x = xb_xcc_id();
        __builtin_amdgcn_s_waitcnt(0);
        unsigned nloc = st[0], nx = st[1];
        if (nloc == 0u) { xcd_barrier_complete(bar, x, nloc, nx); st[0] = nloc; st[1] = nx; }
        const unsigned old = xb_add(&bar[XB_XSUB(x)], 1u);
        const unsigned gen = old / nloc;
        if (old + 1u == (gen + 1u) * nloc) {
            __builtin_amdgcn_fence(__ATOMIC_RELEASE, "agent");
            asm volatile("s_waitcnt vmcnt(0)" ::: "memory");
            const unsigned og = xb_add(&bar[XB_TOP], 1u);
            const unsigned tg = og / nx;
            if (og + 1u == (tg + 1u) * nx) xb_add(&bar[XB_TOPGEN], 1u);
            else XB_SPIN(xb_ld(&bar[XB_TOPGEN]) == tg, bar);
            __builtin_amdgcn_fence(__ATOMIC_ACQUIRE, "agent");
            xb_add(&bar[XB_XGEN(x)], 1u);
            asm volatile("s_waitcnt vmcnt(0)" ::: "memory");
        } else {
            XB_SPIN(xb_ld(&bar[XB_XGEN(x)]) == gen, bar);
            __builtin_amdgcn_fence(__ATOMIC_ACQUIRE, "agent");
            asm volatile("s_waitcnt vmcnt(0)" ::: "memory");
        }
    }
    __syncthreads();
}

#ifdef TPROBE
#define TSTAMP(k) do { PK pk_ = get_pk(); unsigned long long* ta_ = (unsigned long long*)(pk_->ws + OFF_PE); if (blockIdx.x == 0 && threadIdx.x == 0) { const unsigned long long now_ = wall_clock64(); ta_[k] += now_ - ta_[15]; ta_[15] = now_; } } while (0)
#else
#define TSTAMP(k) do {} while (0)
#endif
#define PHASE_VARS PK pk = get_pk(); const int bid = launder_i(cid), G = launder_i((int)gridDim.x); unsigned char* ws = pk->ws; (void)ws; (void)bid; (void)G
#define ZERO_RS(buf) do { float* z_ = (float*)(ws + OFF_RS) + (size_t)(buf) * MR; for (int i_ = bid * 512 + (int)threadIdx.x; i_ < MX; i_ += G * 512) z_[i_] = 0.f; } while (0)
__global__ void __launch_bounds__(512, 2) fwd_mega(Params p_unused) {
  extern __shared__ __attribute__((aligned(16))) unsigned char shm[];
  LAS unsigned char* lds = (LAS unsigned char*)shm;
  cg::grid_group grid = cg::this_grid();
  const int cid = (int)blockIdx.x;
  { PK pk_ = get_pk();
    if (threadIdx.x == 0) { const unsigned x = xb_xcc_id();
      ((volatile LAS unsigned*)(lds + 131072))[0] = 0u; ((volatile LAS unsigned*)(lds + 131072))[1] = 0u;
      (void)xb_add((unsigned*)(pk_->ws + OFF_BAR) + XB_XCNT(x), 1u); }
    __syncthreads(); }
#ifdef TPROBE
  { PK pk_ = get_pk(); unsigned long long* ta_ = (unsigned long long*)(pk_->ws + OFF_PE); if (blockIdx.x == 0 && threadIdx.x < 16) ta_[threadIdx.x] = threadIdx.x == 15 ? (unsigned long long)wall_clock64() : 0ull; }
#endif

  { PHASE_VARS; prologue(pk, lds, bid, G); }
  grid.sync();
#ifdef REP_PRO2
  { PHASE_VARS; prologue(pk, lds, bid, G); }
  xcd_barrier(lds);
#endif
  { PHASE_VARS; prologue2(pk, bid, G); }
  xcd_barrier(lds); TSTAMP(0);
#pragma unroll 1
  for (int l = 0; l < 2; ++l) {
#pragma unroll 1
    for (int s3 = 0; s3 < 3; ++s3) {
      const bool first = (l == 0 && s3 == 0);
      const bool lastp = (l == 1 && s3 == 2);
      const int q = l * 3 + s3, rb = q & 1;
      { PHASE_VARS;
        phase_prep(pk->in[I_X], (float*)(ws + OFF_CTXR), (const float*)(ws + OFF_GS) + (size_t)q * 3072, (bf16_t*)(ws + OFF_H), (float*)(ws + OFF_RS) + (size_t)rb * MR, first ? 0 : (lastp ? MR : MX),
                   (const float*)(ws + (s3 == 2 ? OFF_BIG : OFF_EXTRA)), first ? 0 : (s3 == 2 ? 4 : 11), (const float*)(ws + OFF_RSP), !first, bid, G); }
      xcd_barrier(lds); TSTAMP(1);
      if (s3 != 1) {
        const int f = s3 >> 1, j = l * 2 + f;
        { PHASE_VARS;
          pg8::Gemm g{(const bf16_t*)(ws + OFF_H), (const bf16_t*)(ws + OFF_W1 + j * SZ_W1), MR, 2 * FF, D, D, 0, 0};
          pg8::StaticOrder S; S.init(lastp ? MX : g.M, g.N, g.K, G, bid);
          EpiSwiglu e{(bf16_t*)(ws + OFF_BIG), (const float*)(ws + OFF_RS) + (size_t)rb * MR, (const float*)(ws + OFF_BIASF) + (size_t)j * 3 * 5632};
          pg8::gemm_phase(lds, g, S, e); }
        xcd_barrier(lds); TSTAMP(2);
        { PHASE_VARS;
          pg8::Gemm g{(const bf16_t*)(ws + OFF_BIG), (const bf16_t*)(ws + OFF_W2 + j * SZ_W2), MR, D, FF, FF, 0, 1};
          pg8::StaticOrder S; if (lastp) S.init(MX, g.N, g.K, G, bid); else S.init_split(g.N, g.K, G, bid, 11);
          if (first) { EpiResid<true, true> e{pk->in[I_X], (bf16_t*)pk->out, ws, q}; pg8::gemm_phase(lds, g, S, e); }
          else { EpiResid<false, true> e{pk->in[I_X], (bf16_t*)pk->out, ws, q}; pg8::gemm_phase(lds, g, S, e); } }
        xcd_barrier(lds); TSTAMP(3);
      } else if (l == 0) {
        { PHASE_VARS;
          pg8::Gemm g{(const bf16_t*)(ws + OFF_H), (const bf16_t*)(ws + OFF_EVIN), MR, EVIN_N, D, D, 0, 0};
          pg8::StaticOrder S; S.init(g.M, g.N, g.K, G, bid);
          EpiEvenIn e{(bf16_t*)(ws + OFF_UZ), (bf16_t*)(ws + OFF_Q), (bf16_t*)(ws + OFF_K), (bf16_t*)(ws + OFF_V), (const float*)(ws + OFF_ROPE), (const float*)(ws + OFF_ROPE) + 4096,
                      (const float*)(ws + OFF_RS) + (size_t)rb * MR, (const float*)(ws + OFF_BIASE)};
          pg8::gemm_phase(lds, g, S, e); }
        xcd_barrier(lds); TSTAMP(4);
#ifndef REP_ATT
#define REP_ATT 1
#endif
#ifndef ATT_LO
#define ATT_LO 0
#define ATT_HI 1560
#endif
        for (int rep = 0; rep < REP_ATT; ++rep) {
        { PHASE_VARS;
          for (int u = bid + (rep ? ATT_LO : 0); u < (rep ? ATT_HI : 520 + 1040); u += G) { if (u < 520) attn_unit(pk, u, lds); else gate_unit(pk, u - 520, lds); } }
        xcd_barrier(lds); } TSTAMP(5);
        { PHASE_VARS;
          pg8::Gemm g{(const bf16_t*)(ws + OFF_MIXE), (const bf16_t*)(ws + OFF_EVOUT), MR, D, D, D, 0, 0};
          pg8::StaticOrder S; S.init_split(g.N, g.K, G, bid, 4);
          EpiResid<false, false> e{pk->in[I_X], (bf16_t*)pk->out, ws, q};
          pg8::gemm_phase(lds, g, S, e); }
        xcd_barrier(lds); TSTAMP(6);
      } else {
        { PHASE_VARS;
          pg8::Gemm g{(const bf16_t*)(ws + OFF_H), (const bf16_t*)(ws + OFF_ODIN), MR, 2048, D, D, 0, 0};
          pg8::StaticOrder S; S.init(g.M, g.N, g.K, G, bid);
          EpiOddIn e{(bf16_t*)(ws + OFF_G), (bf16_t*)(ws + OFF_XX), (const float*)(ws + OFF_RS) + (size_t)rb * MR, (const float*)(ws + OFF_BIASO)};
          pg8::gemm_phase(lds, g, S, e); }
        xcd_barrier(lds); TSTAMP(7);
        { PHASE_VARS; phase_conv(pk, bid, G); }
        xcd_barrier(lds); TSTAMP(8);
        { PHASE_VARS;
          pg8::Gemm g{(const bf16_t*)(ws + OFF_XC), (const bf16_t*)(ws + OFF_RGW), MR, 4096, 256, D, 1, 0};
          pg8::StaticOrder S; S.init(g.M, g.N, g.K, G, bid);
          EpiRG e{(const bf16_t*)(ws + OFF_XC), (bf16_t*)(ws + OFF_LAB), pk->in[I_RGBA], pk->in[I_RGBX], (const float*)(ws + OFF_SP)};
          pg8::gemm_phase(lds, g, S, e); }
        xcd_barrier(lds); TSTAMP(9);
        { PHASE_VARS; phase_scan1(pk, bid, G); }
        xcd_barrier(lds); TSTAMP(10);
        { PHASE_VARS; phase_scan2(pk, bid, G); }
        xcd_barrier(lds); TSTAMP(11);
        { PHASE_VARS; phase_scan3(pk, lds, bid, G); }
        xcd_barrier(lds); TSTAMP(12);
        { PHASE_VARS;
          pg8::Gemm g{(const bf16_t*)(ws + OFF_MIXO), (const bf16_t*)(ws + OFF_ODOUT), MR, D, D, D, 0, 0};
          pg8::StaticOrder S; S.init(MX, g.N, g.K, G, bid);
          EpiResid<false, false> e{pk->in[I_X], (bf16_t*)pk->out, ws, q};
          pg8::gemm_phase(lds, g, S, e); }
        xcd_barrier(lds); TSTAMP(13);
      }
    }
  }
  { PHASE_VARS; phase_final_norm(pk->out, (const bf16_t*)(ws + OFF_H), pk->in[I_FNG], bid, G); }
}

extern "C" void kernel_launch(void* const* d_in, const int* in_sizes, int n_in, void* d_out, int out_size,
                              void* d_ws, size_t ws_size, hipStream_t stream) {
  static int grid_blocks = 0;
  if (!grid_blocks) {
    int dev = 0, cus = 0, per_cu = 0;
    (void)hipGetDevice(&dev);
    (void)hipDeviceGetAttribute(&cus, hipDeviceAttributeMultiprocessorCount, dev);
    (void)hipFuncSetAttribute((const void*)fwd_mega, hipFuncAttributeMaxDynamicSharedMemorySize, LDS_BYTES);
    (void)hipOccupancyMaxActiveBlocksPerMultiprocessor(&per_cu, (const void*)fwd_mega, 512, LDS_BYTES);
    (void)hipGetLastError();
    grid_blocks = cus > 0 ? cus : 256;
    if (ws_size < WS_NEED2 || n_in != 26) { fprintf(stderr, "kernel_launch: ws_size %zu < %zu or n_in %d != 26\n", ws_size, (size_t)WS_NEED, n_in); grid_blocks = -1; }
  }
  if (grid_blocks < 0) return;
  Params p{};
  for (int i = 0; i < 26; ++i) p.in[i] = (const float*)d_in[i];
  p.out = (float*)d_out; p.ws = (unsigned char*)d_ws;
  (void)hipMemsetAsync((unsigned char*)d_ws + OFF_CNT, 0, 256 + 3456 * 4, stream);
  void* args[] = {&p};
  hipError_t e = hipLaunchCooperativeKernel((const void*)fwd_mega, dim3(grid_blocks), dim3(512), args, LDS_BYTES, stream);
  if (e != hipSuccess) fprintf(stderr, "cooperative launch failed: %s (grid %d)\n", hipGetErrorString(e), grid_blocks);
}
```

```cpp
#include <hip/hip_runtime.h>
#include <hip/hip_cooperative_groups.h>
#include <cstdio>
namespace cg = cooperative_groups;

#define LAS __attribute__((address_space(3)))
typedef unsigned short bf16_t;
typedef short bf16x8 __attribute__((ext_vector_type(8)));
typedef short bf16x4 __attribute__((ext_vector_type(4)));
typedef float f32x4 __attribute__((ext_vector_type(4)));
typedef unsigned u32x2 __attribute__((ext_vector_type(2)));
typedef unsigned u32x4 __attribute__((ext_vector_type(4)));

constexpr int D = 1024, FF = 2816, SEQ = 16384, MX = 32768, MC = 512, MR = MX + MC, CTXL = 256;
constexpr int NMOD = 9216;
constexpr int EVIN_N = 1792;
constexpr int LDS_BYTES = 131072 + 64;
constexpr int NCH = 544;

constexpr size_t SZ_W1 = (size_t)2 * FF * D * 2;
constexpr size_t SZ_W2 = (size_t)D * FF * 2;
constexpr size_t OFF_W1 = 0;
constexpr size_t OFF_W2 = OFF_W1 + 4 * SZ_W1;
constexpr size_t OFF_EVIN = OFF_W2 + 4 * SZ_W2;
constexpr size_t OFF_EVOUT = OFF_EVIN + (size_t)EVIN_N * D * 2;
constexpr size_t OFF_ODIN = OFF_EVOUT + (size_t)D * D * 2;
constexpr size_t OFF_ODOUT = OFF_ODIN + (size_t)2048 * D * 2;
constexpr size_t OFF_RGW = OFF_ODOUT + (size_t)D * D * 2;
constexpr size_t OFF_GMWS = OFF_RGW + (size_t)4096 * 256 * 2;
constexpr size_t OFF_MOD = OFF_GMWS + (size_t)4 * 128 * 128 * 2;
constexpr size_t OFF_ROPE = OFF_MOD + (size_t)2 * 3 * NMOD * 4;
constexpr size_t OFF_SP = OFF_ROPE + (size_t)256 * 16 * 2 * 4;
constexpr size_t OFF_GS = OFF_SP + (size_t)2 * 1024 * 4;
constexpr size_t OFF_BIASF = OFF_GS + (size_t)2 * 3 * 3 * 1024 * 4;
constexpr size_t OFF_BIASE = OFF_BIASF + (size_t)4 * 3 * 5632 * 4;
constexpr size_t OFF_BIASO = OFF_BIASE + (size_t)3 * 1792 * 4;
constexpr size_t OFF_RS = OFF_BIASO + (size_t)3 * 2048 * 4;
constexpr size_t OFF_CNT = OFF_RS + (size_t)2 * MR * 4;
constexpr size_t OFF_BAR = OFF_CNT + 256;
constexpr size_t OFF_CTXR = OFF_BAR + 3456 * 4;
constexpr size_t OFF_PE = OFF_CTXR + (size_t)MC * D * 4;
constexpr size_t SZ_CARRY = (size_t)2 * 2 * NCH * 1024 * 4;
constexpr size_t OFF_HIN = OFF_PE + 2 * SZ_CARRY;
constexpr size_t OFF_H = OFF_HIN + SZ_CARRY;
constexpr size_t SZ_ROWS = (size_t)MR * D * 2;
constexpr size_t OFF_BIG = OFF_H + SZ_ROWS;
constexpr size_t SZ_ACT = (size_t)MR * FF * 2;
constexpr size_t OFF_EXTRA = OFF_BIG + SZ_ACT;
constexpr size_t OFF_UZ = OFF_BIG;
constexpr size_t OFF_Q = OFF_UZ + SZ_ROWS;
constexpr size_t OFF_K = OFF_Q + SZ_ROWS / 2;
constexpr size_t OFF_V = OFF_K + SZ_ROWS / 8;
constexpr size_t OFF_MIXE = OFF_EXTRA;
constexpr size_t OFF_G = OFF_BIG;
constexpr size_t OFF_XX = OFF_G + SZ_ROWS;
constexpr size_t OFF_XC = OFF_H;
constexpr size_t OFF_LAB = OFF_XX;
constexpr size_t OFF_MIXO = OFF_LAB;
constexpr size_t WS_NEED = OFF_LAB + 4 * SZ_ROWS;
constexpr size_t OFF_RSP = OFF_LAB + 4 * SZ_ROWS;
constexpr size_t WS_NEED2 = OFF_RSP + (size_t)MR * 16 * 4;
static_assert(OFF_MIXE + SZ_ROWS <= WS_NEED, "ws");
static_assert(WS_NEED2 <= (size_t)536870912, "workspace budget 2");
static_assert(WS_NEED <= (size_t)536870912, "workspace budget");

struct Params { const float* in[26]; float* out; unsigned char* ws; };
typedef const Params __attribute__((address_space(4))) * PK;
__device__ __forceinline__ PK get_pk() { PK pk = (PK)__builtin_amdgcn_kernarg_segment_ptr(); asm volatile("" : "+s"(pk)); return pk; }
__device__ __forceinline__ int launder_i(int v) { asm volatile("" : "+s"(v)); return v; }
__device__ __forceinline__ float launder_f(float v) { asm volatile("" : "+s"(v)); return v; }
__device__ __forceinline__ int launder_v(int v) { asm volatile("" : "+v"(v)); return v; }
#define TID_X tid_l
enum { I_X = 0, I_C, I_CTX, I_CCTX, I_ADAW, I_ADAB, I_NORMG, I_WG, I_WU, I_WD, I_EVIN, I_EVOUT, I_GMG, I_GMWS, I_GMBS, I_SINK,
       I_ODIN, I_ODOUT, I_CONVW, I_CONVB, I_RGWA, I_RGBA, I_RGWX, I_RGBX, I_LAM, I_FNG };

__device__ __forceinline__ unsigned cvt_pk_bf16(float lo, float hi) { unsigned r; asm volatile("v_cvt_pk_bf16_f32 %0, %1, %2" : "=v"(r) : "v"(lo), "v"(hi)); return r; }
__device__ __forceinline__ bf16_t f2bf(float f) { return (bf16_t)(cvt_pk_bf16(f, 0.f) & 0xffffu); }
__device__ __forceinline__ float bf2f(bf16_t b) { return __uint_as_float(((unsigned)b) << 16); }
__device__ __forceinline__ float bflo(unsigned w) { return __uint_as_float(w << 16); }
__device__ __forceinline__ float bfhi(unsigned w) { return __uint_as_float(w & 0xffff0000u); }
__device__ __forceinline__ u32x2 pack4(f32x4 v) { u32x2 r; r.x = cvt_pk_bf16(v[0], v[1]); r.y = cvt_pk_bf16(v[2], v[3]); return r; }
__device__ __forceinline__ f32x4 unpack4(u32x2 w) { f32x4 r; r[0] = bflo(w.x); r[1] = bfhi(w.x); r[2] = bflo(w.y); r[3] = bfhi(w.y); return r; }
__device__ __forceinline__ float fast_sigmoid(float x) { return __fdividef(1.0f, 1.0f + __expf(-x)); }
__device__ __forceinline__ float gelu_tanh(float x) { const float t = 1.5957691216f * (x + 0.044715f * x * x * x); return x * fast_sigmoid(t); }
__device__ __forceinline__ float shx(float v, int o, int lane) { return __int_as_float(__builtin_amdgcn_ds_bpermute((lane ^ o) << 2, __float_as_int(v))); }
__device__ __forceinline__ float wave_sum(float v, int lane) {
#pragma unroll
  for (int o = 32; o >= 1; o >>= 1) v += shx(v, o, lane);
  return v;
}

namespace pg8 {
constexpr int BM = 256, BK = 64, HALF = 128, HTB = HALF * BK * 2, NXCD = 8, WGM = 8;
__device__ __forceinline__ int lds_byte(int r, int c) { const int st = (r >> 4) * 2 + (c >> 5), rr = r & 15, cc = c & 31, ob = rr * 64 + cc * 2; return st * 1024 + (ob ^ (((ob >> 9) & 1) << 5)); }
__device__ __forceinline__ void stage_rc(int b, int& R, int& C) { const int st = b / 1024, sb = b % 1024, swz = sb ^ (((sb >> 9) & 1) << 5); R = (st >> 1) * 16 + swz / 64; C = (st & 1) * 32 + (swz % 64) / 2; }
__device__ __forceinline__ int perm32(int rho) { const int n = rho >> 4, i = rho & 15; return 8 * (i >> 2) + 4 * n + (i & 3); }
struct Unit { int pm, pn, k0, nk; };
struct Gemm { const bf16_t* A; const bf16_t* Bt; int M, N, K, lda; int bd; int ablk; };
struct StaticOrder {
  int nM, nN, nwg, G, c, ntfull, nslice, nkslice;
  __device__ void init(int M, int N, int K, int G_, int c_) { nM = M / BM; nN = N / BM; nwg = nM * nN; G = G_; c = c_; ntfull = K / BK; nslice = 0; nkslice = 0; }
  __device__ void init_split(int N, int K, int G_, int c_, int S) { nM = 128; nN = N / BM; nwg = nM * nN; G = G_; c = c_; ntfull = K / BK; nslice = S; nkslice = ntfull / S; }
  __device__ bool next(int i, Unit& u) const {
    const long L = (long)i * G + c;
    if (L >= nwg) {
      const int e = (int)(L - nwg);
      if (e >= 2 * nN * nslice) return false;
      const int sl = e % nslice, tl = e / nslice;
      u.pm = 128 + tl / nN; u.pn = tl % nN; u.k0 = sl * nkslice; u.nk = nkslice; return true;
    }
    int wgid = (int)L; { const int q = nwg / NXCD, r = nwg % NXCD, xcd = wgid % NXCD, off = wgid / NXCD; wgid = (xcd < r ? xcd * (q + 1) : r * (q + 1) + (xcd - r) * q) + off; }
    const int nig = WGM * nN, gid = wgid / nig, fm = gid * WGM, gsz = (nM - fm) < WGM ? (nM - fm) : WGM;
    u.pm = fm + ((wgid % nig) % gsz); u.pn = (wgid % nig) / gsz; u.k0 = 0; u.nk = ntfull; return true;
  }
};

template <class Epi>
__device__ __forceinline__ void gemm_phase(LAS unsigned char* lds, const Gemm g, const StaticOrder& S, const Epi& E) { const int tid_l = launder_v((int)threadIdx.x);
  const int tid = tid_l, wid = __builtin_amdgcn_readfirstlane(tid >> 6), lane = tid & 63, wr = wid >> 2, wc = wid & 3, fr = lane & 15, fq = lane >> 4;
  const int K = g.K;
  unsigned voffA[2], voffB[2];
#pragma unroll
  for (int i = 0; i < 2; ++i) { int R, C; stage_rc(tid * 16 + i * 8192, R, C); const int Rb = Epi::PERM ? ((R & ~31) + perm32(R & 31)) : R;
    voffA[i] = (unsigned)(R * (g.ablk ? 64 : g.lda) + C) * 2u; voffB[i] = (unsigned)(Rb * K + C) * 2u; }
  const size_t kstep = (size_t)(BK * 2), kstepA = g.ablk ? (size_t)32768 : kstep;
  const size_t hstepA = g.ablk ? (size_t)16384 : (size_t)HALF * g.lda * 2, hstepB = (size_t)HALF * K * 2;
  const size_t tstepA = g.ablk ? (size_t)(K / BK) * 32768 : 2 * hstepA, tstepB = 2 * hstepB;
  const unsigned ldsw = (unsigned)wid * 1024u;
  const int aoff = lds_byte(wr * 64 + fr, fq * 8), boff = lds_byte(wc * 32 + fr, fq * 8);
#define PG8_SA(b, h) (((b) * 2 + (h)) * HTB)
#define PG8_SB(b, h) ((4 + (b) * 2 + (h)) * HTB)
#define PG8_STAGE(bufoff, gbase, voff) do { _Pragma("unroll") for (int _i = 0; _i < 2; ++_i) \
        __builtin_amdgcn_global_load_lds((const unsigned*)((const char*)(gbase) + (voff)[_i]), (LAS unsigned*)(lds + (bufoff) + ldsw + _i * 8192), 16, 0, 0); } while (0)
#define PG8_LDA(dst, b, h) do { _Pragma("unroll") for (int m = 0; m < 4; ++m) _Pragma("unroll") for (int k = 0; k < 2; ++k) dst[m][k] = *(const LAS bf16x8*)(lds + PG8_SA(b, h) + aoff + m * 2048 + k * 1024); } while (0)
#define PG8_LDB(dst, b, h) do { _Pragma("unroll") for (int n = 0; n < 2; ++n) _Pragma("unroll") for (int k = 0; k < 2; ++k) dst[n][k] = *(const LAS bf16x8*)(lds + PG8_SB(b, h) + boff + n * 2048 + k * 1024); } while (0)
#define PG8_MMA(ai, bj, At, Bt) do { __builtin_amdgcn_s_setprio(1); _Pragma("unroll") for (int m = 0; m < 4; ++m) _Pragma("unroll") for (int n = 0; n < 2; ++n) _Pragma("unroll") for (int k = 0; k < 2; ++k) \
        acc[ai][bj][m][n] = __builtin_amdgcn_mfma_f32_16x16x32_bf16(Bt[n][k], At[m][k], acc[ai][bj][m][n], 0, 0, 0); __builtin_amdgcn_s_setprio(0); } while (0)
#define PG8_WAIT_V(n) asm volatile("s_waitcnt vmcnt(" #n ")" ::: "memory")
#define PG8_WAIT_L(n) asm volatile("s_waitcnt lgkmcnt(" #n ")" ::: "memory")
#define PG8_BAR __builtin_amdgcn_s_barrier()
#define PG8_SCHED __builtin_amdgcn_sched_barrier(0)
#define PG8_ABASE(u) ((const char*)g.A + (size_t)(u).pm * tstepA + (size_t)(u).k0 * kstepA + (g.bd ? (size_t)((((u).pn >> 1) & 3) * 512) : (size_t)0))
#define PG8_BBASE(u) ((const char*)g.Bt + (size_t)(u).pn * tstepB + (size_t)(u).k0 * kstep)
  Unit cur, nxt; int ui = 0;
  if (!S.next(0, cur)) return;
  f32x4 acc[2][2][4][2];
#pragma unroll
  for (int a = 0; a < 2; ++a)
#pragma unroll
    for (int b = 0; b < 2; ++b)
#pragma unroll
      for (int m = 0; m < 4; ++m)
#pragma unroll
        for (int n = 0; n < 2; ++n) acc[a][b][m][n] = (f32x4){0.f, 0.f, 0.f, 0.f};
  bf16x8 At[4][2], B0[2][2], B1[2][2];
  const char* cA = PG8_ABASE(cur); const char* cB = PG8_BBASE(cur);
  PG8_STAGE(PG8_SB(0, 0), cB, voffB); PG8_STAGE(PG8_SA(0, 0), cA, voffA); PG8_STAGE(PG8_SB(0, 1), cB + hstepB, voffB); PG8_STAGE(PG8_SA(0, 1), cA + hstepA, voffA);
  if (wr == 1) PG8_BAR;
  PG8_WAIT_V(4); PG8_BAR;
  PG8_STAGE(PG8_SB(1, 0), cB + kstep, voffB); PG8_STAGE(PG8_SA(1, 0), cA + kstepA, voffA); PG8_STAGE(PG8_SB(1, 1), cB + hstepB + kstep, voffB);
  PG8_WAIT_V(6); PG8_BAR;
  for (;;) {
    const bool has_next = S.next(ui + 1, nxt);
    const char* nA = has_next ? PG8_ABASE(nxt) : cA; const char* nB = has_next ? PG8_BBASE(nxt) : cB;
    const int nt = cur.nk;
#pragma unroll 1
    for (int t = 0; t < nt; t += 2) {
      const bool last = (t == nt - 2);
      const char* a1 = cA + (size_t)(t + 1) * kstepA;
      const char* a2 = last ? nA : cA + (size_t)(t + 2) * kstepA; const char* b2 = last ? nB : cB + (size_t)(t + 2) * kstep;
      const char* a3 = a2 + kstepA; const char* b3 = b2 + kstep;
      PG8_LDB(B0, 0, 0); PG8_SCHED; PG8_LDA(At, 0, 0); PG8_STAGE(PG8_SA(1, 1), a1 + hstepA, voffA);
      PG8_WAIT_L(8); PG8_BAR; PG8_WAIT_L(0); PG8_MMA(0, 0, At, B0); PG8_BAR; PG8_SCHED;
      PG8_LDB(B1, 0, 1); PG8_STAGE(PG8_SB(0, 0), b2, voffB);
      PG8_BAR; PG8_WAIT_L(0); PG8_MMA(0, 1, At, B1); PG8_BAR;
      PG8_LDA(At, 0, 1); PG8_STAGE(PG8_SA(0, 0), a2, voffA);
      PG8_BAR; PG8_WAIT_L(0); PG8_MMA(1, 0, At, B0); PG8_BAR; PG8_SCHED;
      PG8_STAGE(PG8_SB(0, 1), b2 + hstepB, voffB);
      PG8_WAIT_V(6); PG8_BAR; PG8_MMA(1, 1, At, B1); PG8_BAR;
      PG8_LDB(B0, 1, 0); PG8_SCHED; PG8_LDA(At, 1, 0); PG8_STAGE(PG8_SA(0, 1), a2 + hstepA, voffA);
      PG8_WAIT_L(8); PG8_BAR; PG8_WAIT_L(0); PG8_MMA(0, 0, At, B0); PG8_BAR; PG8_SCHED;
      PG8_LDB(B1, 1, 1); PG8_STAGE(PG8_SB(1, 0), b3, voffB);
      PG8_BAR; PG8_WAIT_L(0); PG8_MMA(0, 1, At, B1); PG8_BAR;
      PG8_LDA(At, 1, 1); PG8_STAGE(PG8_SA(1, 0), a3, voffA);
      PG8_BAR; PG8_WAIT_L(0); PG8_MMA(1, 0, At, B0); PG8_BAR; PG8_SCHED;
      PG8_STAGE(PG8_SB(1, 1), b3 + hstepB, voffB);
      PG8_WAIT_V(6); PG8_BAR; PG8_MMA(1, 1, At, B1); PG8_BAR;
    }
    E(acc, cur, wr, wc, fr, fq);
    if (!has_next) break;
#pragma unroll
    for (int a = 0; a < 2; ++a)
#pragma unroll
      for (int b = 0; b < 2; ++b)
#pragma unroll
        for (int m = 0; m < 4; ++m)
#pragma unroll
          for (int n = 0; n < 2; ++n) acc[a][b][m][n] = (f32x4){0.f, 0.f, 0.f, 0.f};
    cur = nxt; cA = nA; cB = nB; ++ui;
  }
  PG8_WAIT_V(0);
  if (wr == 0) PG8_BAR;
  PG8_BAR;
#undef PG8_SA
#undef PG8_SB
#undef PG8_STAGE
#undef PG8_LDA
#undef PG8_LDB
#undef PG8_MMA
#undef PG8_WAIT_V
#undef PG8_WAIT_L
#undef PG8_BAR
#undef PG8_SCHED
#undef PG8_ABASE
#undef PG8_BBASE
}
}
using pg8::Unit;
typedef f32x4 AccT[2][2][4][2];

struct EpiSwiglu {
  static constexpr bool PERM = true;
  bf16_t* act; const float* rs; const float* bias;
  __device__ __forceinline__ void operator()(const AccT& acc, const Unit& u, int wr, int wc, int fr, int fq) const {
    const int row0 = u.pm * 256 + wr * 64 + fr, col0 = u.pn * 128 + wc * 32 + 8 * fq;
    const int mi = u.pm < 64 ? 0 : (u.pm < 128 ? 1 : 2);
    const float* bp = bias + (size_t)mi * (2 * FF) + u.pn * 256 + wc * 32 + 8 * fq;
    f32x4 bg[2], bu[2]; float rv[2][4];
#pragma unroll
    for (int n = 0; n < 2; ++n) { bg[n] = *(const f32x4*)(bp + n * 4); bu[n] = *(const f32x4*)(bp + 128 + n * 4); }
#pragma unroll
    for (int ai = 0; ai < 2; ++ai)
#pragma unroll
      for (int m = 0; m < 4; ++m) rv[ai][m] = rs[row0 + ai * 128 + m * 16];
#pragma unroll
    for (int ai = 0; ai < 2; ++ai)
#pragma unroll
      for (int m = 0; m < 4; ++m) rv[ai][m] = rsqrtf(rv[ai][m] * (1.0f / 1024.0f) + 1e-6f);
#pragma unroll
    for (int ai = 0; ai < 2; ++ai)
#pragma unroll
      for (int m = 0; m < 4; ++m) {
        const int r = row0 + ai * 128 + m * 16;
        bf16_t* rowp = act + ((size_t)(r >> 8) * (FF / 64) + (col0 >> 6)) * 16384 + (size_t)(r & 255) * 64 + (col0 & 63);
        u32x4 ow;
#pragma unroll
        for (int n = 0; n < 2; ++n) {
          const f32x4 gg = acc[ai][0][m][n] * rv[ai][m] + bg[n], uu = acc[ai][1][m][n] * rv[ai][m] + bu[n]; f32x4 v;
#pragma unroll
          for (int j = 0; j < 4; ++j) v[j] = gg[j] * fast_sigmoid(gg[j]) * uu[j];
          const u32x2 pk2 = pack4(v);
          if (n == 0) { ow.x = pk2.x; ow.y = pk2.y; } else { ow.z = pk2.x; ow.w = pk2.y; }
        }
        *(u32x4*)(rowp) = ow;
      }
  }
};
template <bool SRCF32, bool HALF>
struct EpiResid {
  static constexpr bool PERM = true;
  const float* src_f32; bf16_t* xbuf; unsigned char* wsb; int qi;
  __device__ __forceinline__ void operator()(const AccT& acc, const Unit& u, int wr, int wc, int fr, int fq) const {
    unsigned char* w2 = wsb; asm volatile("" : "+s"(w2));
    const int q = qi, l = q / 3, s3 = q - 3 * l;
    const float* gate = (const float*)(w2 + OFF_MOD) + l * 3 * NMOD + (HALF ? 3 * s3 + 2 : 5) * 1024;
    bf16_t* anext = q < 5 ? (bf16_t*)(w2 + OFF_H) : (bf16_t*)nullptr; const float* gsn = (const float*)(w2 + OFF_GS) + (q + 1) * 3072; float* rsp = (float*)(w2 + OFF_RSP);
    const size_t slab_off = HALF ? OFF_EXTRA : OFF_BIG;
    bf16_t* xdst = q < 5 ? xbuf : (bf16_t*)(w2 + OFF_H);
    const int row0 = u.pm * 256 + wr * 64 + fr, col0 = u.pn * 256 + wc * 32 + 8 * fq;
    const int mi = u.pm < 64 ? 0 : (u.pm < 128 ? 1 : 2);
    const float* gp = gate + (size_t)mi * NMOD + col0;
    f32x4 gv[2][2];
#pragma unroll
    for (int bj = 0; bj < 2; ++bj)
#pragma unroll
      for (int n = 0; n < 2; ++n) gv[bj][n] = *(const f32x4*)(gp + bj * 128 + n * 4) * (HALF ? 0.5f : 1.0f);
    if (u.pm < 128) {
      const size_t e0 = (size_t)row0 * D + col0;
      const float* gsp = gsn + mi * 1024 + col0;
      f32x4 gsv[2][2];
#pragma unroll
      for (int bj = 0; bj < 2; ++bj)
#pragma unroll
        for (int n = 0; n < 2; ++n) gsv[bj][n] = anext ? *(const f32x4*)(gsp + bj * 128 + n * 4) : (f32x4){0.f, 0.f, 0.f, 0.f};
      f32x4 xb[2][2][2];
#define RES_LOAD(dst, eoff) do { _Pragma("unroll") for (int bj = 0; bj < 2; ++bj) { \
          if (SRCF32) { dst[bj][0] = *(const f32x4*)(src_f32 + (eoff) + bj * 128); dst[bj][1] = *(const f32x4*)(src_f32 + (eoff) + bj * 128 + 4); } \
          else { const u32x4 w_ = *(const u32x4*)(xbuf + (eoff) + bj * 128); u32x2 lo_, hi_; lo_.x = w_.x; lo_.y = w_.y; hi_.x = w_.z; hi_.y = w_.w; dst[bj][0] = unpack4(lo_); dst[bj][1] = unpack4(hi_); } } } while (0)
      RES_LOAD(xb[0], e0);
#pragma unroll
      for (int st = 0; st < 8; ++st) {
        const int ai = st >> 2, m = st & 3, cur = st & 1, rr = ai * 128 + m * 16;
        if (st < 7) { const int rn = ((st + 1) >> 2) * 128 + ((st + 1) & 3) * 16; RES_LOAD(xb[cur ^ 1], e0 + (size_t)rn * D); }
        float ss = 0.f;
#pragma unroll
        for (int bj = 0; bj < 2; ++bj) {
          const f32x4 x0 = xb[cur][bj][0] + gv[bj][0] * acc[ai][bj][m][0], x1 = xb[cur][bj][1] + gv[bj][1] * acc[ai][bj][m][1];
          const u32x2 p0 = pack4(x0), p1 = pack4(x1);
          u32x4 ow; ow.x = p0.x; ow.y = p0.y; ow.z = p1.x; ow.w = p1.y;
          *(u32x4*)(xdst + e0 + (size_t)rr * D + bj * 128) = ow;
          if (anext) {
            const u32x2 q0 = pack4(x0 * gsv[bj][0]), q1 = pack4(x1 * gsv[bj][1]);
            u32x4 aw; aw.x = q0.x; aw.y = q0.y; aw.z = q1.x; aw.w = q1.y;
            *(u32x4*)(anext + e0 + (size_t)rr * D + bj * 128) = aw;
            ss += x0[0] * x0[0] + x0[1] * x0[1] + x0[2] * x0[2] + x0[3] * x0[3] + x1[0] * x1[0] + x1[1] * x1[1] + x1[2] * x1[2] + x1[3] * x1[3];
          }
        }
        if (anext) { ss += shx(ss, 16, fr + 16 * fq); ss += shx(ss, 32, fr + 16 * fq); if (fq == 0) rsp[(size_t)(row0 + rr) * 16 + u.pn * 4 + wc] = ss; }
      }
#undef RES_LOAD
    } else {
#pragma unroll
      for (int ai = 0; ai < 2; ++ai)
#pragma unroll
        for (int m = 0; m < 4; ++m) {
          float* d = (float*)(w2 + slab_off) + (size_t)(u.k0 / u.nk) * MC * D + (size_t)(row0 + ai * 128 + m * 16 - MX) * D + col0;
#pragma unroll
          for (int bj = 0; bj < 2; ++bj)
#pragma unroll
            for (int n = 0; n < 2; ++n) *(f32x4*)(d + bj * 128 + n * 4) = gv[bj][n] * acc[ai][bj][m][n];
        }
    }
  }
};
struct EpiEvenIn {
  static constexpr bool PERM = false;
  bf16_t* UZ; bf16_t* Q; bf16_t* Kb; bf16_t* Vb; const float* ropeC; const float* ropeS; const float* rs; const float* bias;
  __device__ __forceinline__ void operator()(const AccT& acc, const Unit& u, int wr, int wc, int fr, int fq) const {
    const int row0 = u.pm * 256 + wr * 64 + fr;
    const int mi = u.pm < 64 ? 0 : (u.pm < 128 ? 1 : 2);
    const float* bp = bias + (size_t)mi * EVIN_N + u.pn * 256 + wc * 32 + 4 * fq;
    f32x4 bv[2][2]; float rv[2][4];
#pragma unroll
    for (int bj = 0; bj < 2; ++bj)
#pragma unroll
      for (int n = 0; n < 2; ++n) bv[bj][n] = *(const f32x4*)(bp + bj * 128 + n * 16);
#pragma unroll
    for (int ai = 0; ai < 2; ++ai)
#pragma unroll
      for (int m = 0; m < 4; ++m) rv[ai][m] = rs[row0 + ai * 128 + m * 16];
#pragma unroll
    for (int ai = 0; ai < 2; ++ai)
#pragma unroll
      for (int m = 0; m < 4; ++m) rv[ai][m] = rsqrtf(rv[ai][m] * (1.0f / 1024.0f) + 1e-6f);
    if (u.pn < 4) {
      const int col0 = u.pn * 256 + wc * 32 + 4 * fq;
#pragma unroll
      for (int ai = 0; ai < 2; ++ai)
#pragma unroll
        for (int m = 0; m < 4; ++m) {
          const int r = row0 + ai * 128 + m * 16;
          bf16_t* rowp = UZ + (size_t)r * D + col0;
#pragma unroll
          for (int bj = 0; bj < 2; ++bj)
#pragma unroll
            for (int n = 0; n < 2; ++n) { f32x4 v = acc[ai][bj][m][n] * rv[ai][m] + bv[bj][n];
#pragma unroll
              for (int j = 0; j < 4; ++j) v[j] = gelu_tanh(v[j]);
              *(u32x2*)(rowp + bj * 128 + n * 16) = pack4(v); }
        }
    } else {
      const bool rope_on = u.pm < 128;
      const bool by_col = (wc & 1) != 0;
      f32x4 csb[2], snb[2];
      { const int pos = row0 & (SEQ - 1); const int pidx = by_col ? (pos & 63) : (pos >> 6);
        csb[0] = *(const f32x4*)(ropeC + pidx * 16 + 4 * fq); snb[0] = *(const f32x4*)(ropeS + pidx * 16 + 4 * fq); }
#pragma unroll
      for (int st = 0; st < 8; ++st) {
        const int ai = st >> 2, m = st & 3, cur = st & 1;
        const int r = row0 + ai * 128 + m * 16;
        if (st < 7) { const int rn = row0 + ((st + 1) >> 2) * 128 + ((st + 1) & 3) * 16; const int pos = rn & (SEQ - 1); const int pidx = by_col ? (pos & 63) : (pos >> 6);
          csb[cur ^ 1] = *(const f32x4*)(ropeC + pidx * 16 + 4 * fq); snb[cur ^ 1] = *(const f32x4*)(ropeS + pidx * 16 + 4 * fq); }
        f32x4 cs = csb[cur], sn = snb[cur];
        if (!rope_on) { cs = (f32x4){1.f, 1.f, 1.f, 1.f}; sn = (f32x4){0.f, 0.f, 0.f, 0.f}; }
#pragma unroll
        for (int bj = 0; bj < 2; ++bj) {
          const f32x4 x1 = acc[ai][bj][m][0] * rv[ai][m] + bv[bj][0], x2 = acc[ai][bj][m][1] * rv[ai][m] + bv[bj][1];
          if (u.pn < 6) {
            const f32x4 o1 = (x1 * cs - x2 * sn) * 0.18033688011112042f, o2 = (x1 * sn + x2 * cs) * 0.18033688011112042f;
            bf16_t* qp = Q + (size_t)r * 512 + (u.pn - 4) * 256 + bj * 128 + wc * 32 + 4 * fq;
            *(u32x2*)(qp) = pack4(o1); *(u32x2*)(qp + 16) = pack4(o2);
          } else if (bj == 0) {
            const f32x4 o1 = x1 * cs - x2 * sn, o2 = x1 * sn + x2 * cs;
            bf16_t* kp = Kb + (size_t)r * 128 + wc * 32 + 4 * fq;
            *(u32x2*)(kp) = pack4(o1); *(u32x2*)(kp + 16) = pack4(o2);
          } else {
            bf16_t* vp = Vb + (size_t)r * 128 + wc * 32 + 4 * fq;
            *(u32x2*)(vp) = pack4(x1); *(u32x2*)(vp + 16) = pack4(x2);
          }
        }
      }
    }
  }
};
struct EpiOddIn {
  static constexpr bool PERM = false;
  bf16_t* G; bf16_t* XX; const float* rs; const float* bias;
  __device__ __forceinline__ void operator()(const AccT& acc, const Unit& u, int wr, int wc, int fr, int fq) const {
    const int row0 = u.pm * 256 + wr * 64 + fr;
    const int mi = u.pm < 64 ? 0 : (u.pm < 128 ? 1 : 2);
    const float* bp = bias + (size_t)mi * 2048 + u.pn * 256 + wc * 32 + 4 * fq;
    f32x4 bv[2][2];
#pragma unroll
    for (int bj = 0; bj < 2; ++bj)
#pragma unroll
      for (int n = 0; n < 2; ++n) bv[bj][n] = *(const f32x4*)(bp + bj * 128 + n * 16);
    float rvv[2][4];
#pragma unroll
    for (int ai = 0; ai < 2; ++ai)
#pragma unroll
      for (int m = 0; m < 4; ++m) rvv[ai][m] = rs[row0 + ai * 128 + m * 16];
#pragma unroll
    for (int ai = 0; ai < 2; ++ai)
#pragma unroll
      for (int m = 0; m < 4; ++m) rvv[ai][m] = rsqrtf(rvv[ai][m] * (1.0f / 1024.0f) + 1e-6f);
    const bool isg = u.pn < 4;
    bf16_t* base = isg ? G : XX;
    const int col0 = (u.pn & 3) * 256 + wc * 32 + 4 * fq;
#pragma unroll
    for (int ai = 0; ai < 2; ++ai)
#pragma unroll
      for (int m = 0; m < 4; ++m) {
        const int r = row0 + ai * 128 + m * 16;
        const float rv = rvv[ai][m];
        bf16_t* rowp = base + (size_t)r * D + col0;
#pragma unroll
        for (int bj = 0; bj < 2; ++bj)
#pragma unroll
          for (int n = 0; n < 2; ++n) { f32x4 v = acc[ai][bj][m][n] * rv + bv[bj][n];
            if (isg) {
#pragma unroll
              for (int j = 0; j < 4; ++j) v[j] = gelu_tanh(v[j]); }
            *(u32x2*)(rowp + bj * 128 + n * 16) = pack4(v); }
      }
  }
};
struct EpiRG {
  static constexpr bool PERM = false;
  const bf16_t* XC; bf16_t* LAB; const float* ba; const float* bx; const float* sp;
  __device__ __forceinline__ void operator()(const AccT& acc, const Unit& u, int wr, int wc, int fr, int fq) const {
    const int row0 = u.pm * 256 + wr * 64 + fr;
    const int d = u.pn >> 3, h = (u.pn >> 1) & 3, cb = u.pn & 1;
    const int ch0 = h * 256 + cb * 128 + wc * 32 + 4 * fq;
    bf16_t* LA = LAB + (size_t)(2 * d) * MR * D; bf16_t* BB = LA + (size_t)MR * D;
    f32x4 bav[2], bxv[2], spv[2]; u32x2 xw[2][2][4];
#pragma unroll
    for (int n = 0; n < 2; ++n) { bav[n] = *(const f32x4*)(ba + d * 1024 + ch0 + n * 16); bxv[n] = *(const f32x4*)(bx + d * 1024 + ch0 + n * 16); spv[n] = *(const f32x4*)(sp + d * 1024 + ch0 + n * 16); }
#pragma unroll
    for (int ai = 0; ai < 2; ++ai)
#pragma unroll
      for (int m = 0; m < 4; ++m) xw[0][ai][m] = *(const u32x2*)(XC + (size_t)(row0 + ai * 128 + m * 16) * D + ch0);
#pragma unroll
    for (int n = 0; n < 2; ++n)
#pragma unroll
      for (int ai = 0; ai < 2; ++ai)
#pragma unroll
        for (int m = 0; m < 4; ++m) {
          const size_t ro = (size_t)(row0 + ai * 128 + m * 16) * D + ch0 + n * 16;
          if (n == 0) xw[1][ai][m] = *(const u32x2*)(XC + ro + 16);
          const f32x4 xv = unpack4(xw[n][ai][m]);
          f32x4 la, bb;
#pragma unroll
          for (int j = 0; j < 4; ++j) {
            const float rr = fast_sigmoid(acc[ai][0][m][n][j] + bav[n][j]), ii = fast_sigmoid(acc[ai][1][m][n][j] + bxv[n][j]);
            const float l = rr * spv[n][j];
            la[j] = l; bb[j] = __fsqrt_rn(fmaxf(1.0f - __expf(2.0f * l), 0.f)) * ii * xv[j];
          }
          *(u32x2*)(LA + ro) = pack4(la); *(u32x2*)(BB + ro) = pack4(bb);
        }
  }
};

__device__ __forceinline__ void cvt_tile(const float* src, int ld, bf16_t* dst, int ldd, LAS float* tile) { const int tid_l = launder_v((int)threadIdx.x);
  const int t = tid_l, a = t >> 6, b = t & 63;
#pragma unroll
  for (int i = 0; i < 8; ++i) tile[(i * 8 + a) * 65 + b] = src[(size_t)(i * 8 + a) * ld + b];
  __syncthreads();
#pragma unroll
  for (int i = 0; i < 8; ++i) dst[(size_t)(i * 8 + a) * ldd + b] = f2bf(tile[b * 65 + i * 8 + a]);
  __syncthreads();
}
__device__ __forceinline__ void sincos_taylor(double r, double& s, double& c) {
  const double r2 = r * r; double ts = r, tc = 1.0; s = r; c = 1.0;
  for (int i = 1; i <= 15; ++i) { tc = -tc * r2 / (double)((2 * i - 1) * (2 * i)); ts = -ts * r2 / (double)((2 * i) * (2 * i + 1)); c += tc; s += ts; }
}
__device__ __forceinline__ void prologue(PK pk, LAS unsigned char* lds, const int bid, const int nb) { const int tid_l = launder_v((int)threadIdx.x);
  unsigned char* ws = pk->ws;
  const int tid = tid_l;
  LAS float* tile = (LAS float*)lds;
  LAS float* sc = (LAS float*)(lds + 16640);
  LAS float* red = (LAS float*)(lds + 16640 + 12288);
  for (int i = tid; i < 3072; i += 512) { const int v = i >> 10, k = i & 1023; const float x = v < 2 ? pk->in[I_C][v * 1024 + k] : pk->in[I_CCTX][k]; sc[i] = x * fast_sigmoid(x); }
  __syncthreads();
  float* mod = (float*)(ws + OFF_MOD);
  for (int it = bid; it < 288; it += nb) {
    const int l = it / 144, cb = it % 144, kg = tid >> 6, j = tid & 63;
    const float* w = pk->in[I_ADAW] + (size_t)l * D * NMOD + (size_t)(kg * 128) * NMOD + cb * 64 + j;
    float a0 = 0.f, a1 = 0.f, a2 = 0.f;
    for (int k = 0; k < 128; ++k) { const float wv = w[(size_t)k * NMOD]; a0 += sc[kg * 128 + k] * wv; a1 += sc[1024 + kg * 128 + k] * wv; a2 += sc[2048 + kg * 128 + k] * wv; }
    red[(kg * 3 + 0) * 64 + j] = a0; red[(kg * 3 + 1) * 64 + j] = a1; red[(kg * 3 + 2) * 64 + j] = a2;
    __syncthreads();
    if (tid < 192) { const int v = tid >> 6, jj = tid & 63; float s = pk->in[I_ADAB][l * NMOD + cb * 64 + jj];
      for (int q = 0; q < 8; ++q) s += red[(q * 3 + v) * 64 + jj];
      mod[((size_t)l * 3 + v) * NMOD + cb * 64 + jj] = s; }
    __syncthreads();
  }
  { float* rc = (float*)(ws + OFF_ROPE); float* rs = rc + 4096;
    for (int i = bid * 512 + tid; i < 4096; i += nb * 512) { const int pp = i >> 4, f = i & 15;
      const float inv = powf(10000.0f, -(float)f / 16.0f); const float ang = (float)pp * inv;
      const double ad = (double)ang; const double kq = rint(ad * 0.15915494309189535); const double r = ad - kq * 6.283185307179586477;
      double s, c; sincos_taylor(r, s, c); rc[i] = (float)c; rs[i] = (float)s; } }
  { float* sp = (float*)(ws + OFF_SP); for (int i = bid * 512 + tid; i < 2048; i += nb * 512) sp[i] = -8.0f * log1pf(expf(-pk->in[I_LAM][i])); }
  { float* cr = (float*)(ws + OFF_CTXR); const float* ci = pk->in[I_CTX]; for (int i = bid * 512 + tid_l; i < MC * D / 4; i += nb * 512) *(f32x4*)(cr + 4 * (size_t)i) = *(const f32x4*)(ci + 4 * (size_t)i); }
  { bf16_t* o = (bf16_t*)(ws + OFF_GMWS); for (int i = bid * 512 + tid; i < 65536; i += nb * 512) o[i] = f2bf(pk->in[I_GMWS][i]); }
  for (int ti = bid; ti < 10176; ti += nb) {
    int r = ti;
    if (r < 5632) { const int j = r / 1408, rem = r % 1408, nbk = rem >> 4, kb = rem & 15, pn = nbk >> 2, sub = nbk & 3;
      const float* src = (sub < 2 ? pk->in[I_WG] : pk->in[I_WU]) + (size_t)j * D * FF + (size_t)(kb * 64) * FF + pn * 128 + (sub & 1) * 64;
      cvt_tile(src, FF, (bf16_t*)(ws + OFF_W1 + j * SZ_W1) + (size_t)(nbk * 64) * D + kb * 64, D, tile); continue; }
    r -= 5632;
    if (r < 2816) { const int j = r / 704, rem = r % 704, nbk = rem / 44, kb = rem % 44;
      const float* src = pk->in[I_WD] + (size_t)j * FF * D + (size_t)(kb * 64) * D + nbk * 64;
      cvt_tile(src, D, (bf16_t*)(ws + OFF_W2 + j * SZ_W2) + (size_t)(nbk * 64) * FF + kb * 64, FF, tile); continue; }
    r -= 2816;
    if (r < 448) { const int nbk = r >> 4, kb = r & 15;
      cvt_tile(pk->in[I_EVIN] + (size_t)(kb * 64) * EVIN_N + nbk * 64, EVIN_N, (bf16_t*)(ws + OFF_EVIN) + (size_t)(nbk * 64) * D + kb * 64, D, tile); continue; }
    r -= 448;
    if (r < 256) { const int nbk = r >> 4, kb = r & 15;
      cvt_tile(pk->in[I_EVOUT] + (size_t)(kb * 64) * D + nbk * 64, D, (bf16_t*)(ws + OFF_EVOUT) + (size_t)(nbk * 64) * D + kb * 64, D, tile); continue; }
    r -= 256;
    if (r < 512) { const int nbk = r >> 4, kb = r & 15;
      cvt_tile(pk->in[I_ODIN] + (size_t)(kb * 64) * 2048 + nbk * 64, 2048, (bf16_t*)(ws + OFF_ODIN) + (size_t)(nbk * 64) * D + kb * 64, D, tile); continue; }
    r -= 512;
    if (r < 256) { const int nbk = r >> 4, kb = r & 15;
      cvt_tile(pk->in[I_ODOUT] + (size_t)(kb * 64) * D + nbk * 64, D, (bf16_t*)(ws + OFF_ODOUT) + (size_t)(nbk * 64) * D + kb * 64, D, tile); continue; }
    r -= 256;
    { const int nbk = r >> 2, kb = r & 3, t = nbk >> 2, sub = nbk & 3, d = t >> 3, h = (t >> 1) & 3, cb = t & 1;
      const float* src = (sub < 2 ? pk->in[I_RGWA] : pk->in[I_RGWX]) + (size_t)(d * 4 + h) * 65536 + (size_t)(kb * 64) * 256 + cb * 128 + (sub & 1) * 64;
      cvt_tile(src, 256, (bf16_t*)(ws + OFF_RGW) + (size_t)(nbk * 64) * 256 + kb * 64, 256, tile); }
  }
}

__device__ __forceinline__ void phase_prep(const float* src_lat, float* src_ctx, const float* gs, bf16_t* h, float* rs, int r0, const float* slab, int nslab, const float* rsp, bool reduce_lat, const int bid, const int nb) { const int tid_l = launder_v((int)threadIdx.x);
  const int lane = tid_l & 63, wv = tid_l >> 6;
  for (int rb = r0 + (bid * 8 + wv) * 2; rb < MR; rb += nb * 16) {
    f32x4 v[2][4];
#pragma unroll
    for (int q = 0; q < 2; ++q) { const int r = rb + q; const float* xr = r < MX ? src_lat + (size_t)r * D : src_ctx + (size_t)(r - MX) * D;
#pragma unroll
      for (int i = 0; i < 4; ++i) v[q][i] = *(const f32x4*)(xr + i * 256 + lane * 4); }
    if (rb >= MX && nslab > 0) {
      for (int sl = 0; sl < nslab; ++sl)
#pragma unroll
        for (int q = 0; q < 2; ++q)
#pragma unroll
          for (int i = 0; i < 4; ++i) v[q][i] = v[q][i] + *(const f32x4*)(slab + ((size_t)sl * MC + (rb + q - MX)) * D + i * 256 + lane * 4);
#pragma unroll
      for (int q = 0; q < 2; ++q)
#pragma unroll
        for (int i = 0; i < 4; ++i) *(f32x4*)(src_ctx + (size_t)(rb + q - MX) * D + i * 256 + lane * 4) = v[q][i];
    }
#pragma unroll
    for (int q = 0; q < 2; ++q) { const int r = rb + q; const int mi = r < SEQ ? 0 : (r < MX ? 1 : 2);
      float ss = 0.f;
#pragma unroll
      for (int i = 0; i < 4; ++i) { ss += v[q][i][0] * v[q][i][0] + v[q][i][1] * v[q][i][1] + v[q][i][2] * v[q][i][2] + v[q][i][3] * v[q][i][3];
        const f32x4 g4 = *(const f32x4*)(gs + mi * 1024 + i * 256 + lane * 4);
        *(u32x2*)(h + (size_t)r * D + i * 256 + lane * 4) = pack4(v[q][i] * g4); }
      ss = wave_sum(ss, lane);
      if (lane == 0) rs[r] = ss; }
  }
  if (reduce_lat) {
    for (int r = bid * 512 + tid_l; r < MX; r += nb * 512) {
      const f32x4 a = *(const f32x4*)(rsp + (size_t)r * 16), b = *(const f32x4*)(rsp + (size_t)r * 16 + 4), c = *(const f32x4*)(rsp + (size_t)r * 16 + 8), d = *(const f32x4*)(rsp + (size_t)r * 16 + 12);
      rs[r] = ((((a[0] + a[1]) + (a[2] + a[3])) + ((b[0] + b[1]) + (b[2] + b[3]))) + (((c[0] + c[1]) + (c[2] + c[3])) + ((d[0] + d[1]) + (d[2] + d[3]))));
    }
  }
}
__device__ __forceinline__ void prologue2(PK pk, const int bid, const int nb) { const int tid_l = launder_v((int)threadIdx.x);
  unsigned char* ws = pk->ws; const float* mod = (const float*)(ws + OFF_MOD);
  { float* gs = (float*)(ws + OFF_GS);
    for (int i = bid * 512 + tid_l; i < 2 * 3 * 3 * 1024; i += nb * 512) { const int c = i & 1023, mi = (i >> 10) % 3, lj = i / 3072, l = lj / 3, j = lj % 3;
      gs[i] = pk->in[I_NORMG][(size_t)(l * 3 + j) * D + c] * (1.0f + mod[(size_t)(l * 3 + mi) * NMOD + (3 * j + 1) * 1024 + c]); } }
  const int lane = tid_l & 63, wv = tid_l >> 6;
  for (int t = bid * 8 + wv; t < 4 * 5632 + 1792 + 2048; t += nb * 8) {
    const bf16_t* wrow; float* bo; int l, j, n, ncols;
    if (t < 4 * 5632) { const int j4 = t / 5632; n = t % 5632; l = j4 >> 1; j = (j4 & 1) * 2; ncols = 5632; wrow = (const bf16_t*)(ws + OFF_W1 + j4 * SZ_W1) + (size_t)n * D; bo = (float*)(ws + OFF_BIASF) + (size_t)j4 * 3 * 5632; }
    else if (t < 4 * 5632 + 1792) { n = t - 4 * 5632; l = 0; j = 1; ncols = 1792; wrow = (const bf16_t*)(ws + OFF_EVIN) + (size_t)n * D; bo = (float*)(ws + OFF_BIASE); }
    else { n = t - 4 * 5632 - 1792; l = 1; j = 1; ncols = 2048; wrow = (const bf16_t*)(ws + OFF_ODIN) + (size_t)n * D; bo = (float*)(ws + OFF_BIASO); }
    const u32x4 w0 = *(const u32x4*)(wrow + lane * 16), w1 = *(const u32x4*)(wrow + lane * 16 + 8);
    const float wf[16] = {bflo(w0.x), bfhi(w0.x), bflo(w0.y), bfhi(w0.y), bflo(w0.z), bfhi(w0.z), bflo(w0.w), bfhi(w0.w), bflo(w1.x), bfhi(w1.x), bflo(w1.y), bfhi(w1.y), bflo(w1.z), bfhi(w1.z), bflo(w1.w), bfhi(w1.w)};
#pragma unroll
    for (int mi = 0; mi < 3; ++mi) { const float* sh = mod + (size_t)(l * 3 + mi) * NMOD + (3 * j) * 1024 + lane * 16; float a = 0.f;
#pragma unroll
      for (int q = 0; q < 4; ++q) { const f32x4 s4 = *(const f32x4*)(sh + 4 * q); a += s4[0] * wf[4 * q] + s4[1] * wf[4 * q + 1] + s4[2] * wf[4 * q + 2] + s4[3] * wf[4 * q + 3]; }
      a = wave_sum(a, lane);
      if (lane == 0) bo[(size_t)mi * ncols + n] = a; }
  }
}
__device__ __forceinline__ void phase_final_norm(float* out, const bf16_t* xb, const float* g, const int bid, const int nb) { const int tid_l = launder_v((int)threadIdx.x);
  const int lane = tid_l & 63, wv = tid_l >> 6;
  f32x4 gv[2][2];
#pragma unroll
  for (int i = 0; i < 2; ++i) { gv[i][0] = *(const f32x4*)(g + i * 512 + lane * 8); gv[i][1] = *(const f32x4*)(g + i * 512 + lane * 8 + 4); }
  for (int rb = (bid * 8 + wv) * 8; rb < MX; rb += nb * 64) {
    u32x4 w[8][2];
#pragma unroll
    for (int q = 0; q < 8; ++q)
#pragma unroll
      for (int i = 0; i < 2; ++i) w[q][i] = *(const u32x4*)(xb + (size_t)(rb + q) * D + i * 512 + lane * 8);
#pragma unroll
    for (int q = 0; q < 8; ++q) {
      f32x4 v[2][2]; float ss = 0.f;
#pragma unroll
      for (int i = 0; i < 2; ++i) { u32x2 lo, hi; lo.x = w[q][i].x; lo.y = w[q][i].y; hi.x = w[q][i].z; hi.y = w[q][i].w; v[i][0] = unpack4(lo); v[i][1] = unpack4(hi);
#pragma unroll
        for (int h = 0; h < 2; ++h) ss += v[i][h][0] * v[i][h][0] + v[i][h][1] * v[i][h][1] + v[i][h][2] * v[i][h][2] + v[i][h][3] * v[i][h][3]; }
      ss = wave_sum(ss, lane);
      const float rstd = rsqrtf(ss * (1.0f / 1024.0f) + 1e-6f);
#pragma unroll
      for (int i = 0; i < 2; ++i)
#pragma unroll
        for (int h = 0; h < 2; ++h) *(f32x4*)(out + (size_t)(rb + q) * D + i * 512 + lane * 8 + h * 4) = v[i][h] * rstd * gv[i][h]; }
  }
}

constexpr int VSTR = 648;
__device__ __forceinline__ void attn_unit(PK pk, int u, LAS unsigned char* lds) { const int tid_l = launder_v((int)threadIdx.x);
  const bf16_t* Q = (const bf16_t*)(pk->ws + OFF_Q); const bf16_t* Kb = (const bf16_t*)(pk->ws + OFF_K); const bf16_t* Vb = (const bf16_t*)(pk->ws + OFF_V);
  bf16_t* MIX = (bf16_t*)(pk->ws + OFF_MIXE);
  const int tid = tid_l, wv = tid >> 6, lane = tid & 63, fr = lane & 15, fq = lane >> 4;
  const bool is_ctx = u >= 512;
  int b, qb, kvh;
  if (!is_ctx) { b = u >> 8; qb = (u >> 1) & 127; kvh = u & 1; } else { const int j = u - 512; b = j >> 2; qb = (j >> 1) & 1; kvh = j & 1; }
  const int qrow0 = is_ctx ? MX + b * CTXL + qb * 128 : b * SEQ + qb * 128;
  LAS bf16_t* VT = (LAS bf16_t*)lds;
#pragma unroll 1
  for (int c = 0; c < 5; ++c) {
    const bool active = c >= 3 ? true : (is_ctx ? false : (c == 0 ? qb > 0 : (c == 2 ? qb < 127 : true)));
    if (!active) continue;
    const int base = c >= 3 ? MX + b * CTXL + (c - 3) * 128 : qrow0 + (c - 1) * 128;
    const int kp = tid & 63, oc = tid >> 6;
    const bf16_t* vsrc = Vb + (size_t)(base + 2 * kp) * 128 + kvh * 64 + oc * 8;
    const u32x4 v0 = *(const u32x4*)(vsrc), v1 = *(const u32x4*)(vsrc + 128);
    LAS unsigned* vdst = (LAS unsigned*)(VT + (oc * 8) * VSTR + c * 128 + 2 * kp);
    vdst[0 * (VSTR / 2)] = (v0.x & 0xffffu) | (v1.x << 16); vdst[1 * (VSTR / 2)] = (v0.x >> 16) | (v1.x & 0xffff0000u);
    vdst[2 * (VSTR / 2)] = (v0.y & 0xffffu) | (v1.y << 16); vdst[3 * (VSTR / 2)] = (v0.y >> 16) | (v1.y & 0xffff0000u);
    vdst[4 * (VSTR / 2)] = (v0.z & 0xffffu) | (v1.z << 16); vdst[5 * (VSTR / 2)] = (v0.z >> 16) | (v1.z & 0xffff0000u);
    vdst[6 * (VSTR / 2)] = (v0.w & 0xffffu) | (v1.w << 16); vdst[7 * (VSTR / 2)] = (v0.w >> 16) | (v1.w & 0xffff0000u);
  }
  __syncthreads();
  const int head = kvh * 4 + (wv >> 1);
  const float LOG2E = 1.4426950408889634f;
  const float sink2 = pk->in[I_SINK][head] * LOG2E;
  LAS unsigned char* KB0 = lds + 83968;
  constexpr int KROW = 144, KBUF = 128 * KROW;
  const int skey = tid >> 2, sseg = (tid & 3) * 2;
#define ATT_ACTIVE(c_) ((c_) >= 3 ? true : (is_ctx ? false : ((c_) == 0 ? qb > 0 : ((c_) == 2 ? qb < 127 : true))))
#define ATT_BASE(c_) ((c_) >= 3 ? MX + b * CTXL + ((c_) - 3) * 128 : qrow0 + ((c_) - 1) * 128)
  int par = 0;
#pragma unroll 1
  for (int hq = 0; hq < 2; ++hq) {
    const int qoff = (wv & 1) * 64 + hq * 32;
    float mrun[2], lrun[2]; f32x4 o[2][4];
#pragma unroll
    for (int qt = 0; qt < 2; ++qt) { mrun[qt] = sink2; lrun[qt] = 0.25f;
#pragma unroll
      for (int dt = 0; dt < 4; ++dt) o[qt][dt] = (f32x4){0.f, 0.f, 0.f, 0.f}; }
    int c = is_ctx ? 3 : (qb > 0 ? 0 : 1);
    { const bf16_t* ks = Kb + (size_t)(ATT_BASE(c) + skey) * 128 + kvh * 64 + sseg * 8;
      const u32x4 a0 = *(const u32x4*)(ks), a1 = *(const u32x4*)(ks + 8);
      LAS unsigned char* kd = KB0 + par * KBUF + skey * KROW + sseg * 16;
      *(LAS u32x4*)(kd) = a0; *(LAS u32x4*)(kd + 16) = a1; }
    __syncthreads();
#pragma unroll 1
    while (c < 5) {
      int cn = c + 1; while (cn < 5 && !ATT_ACTIVE(cn)) ++cn;
      u32x4 n0 = {0u, 0u, 0u, 0u}, n1 = {0u, 0u, 0u, 0u};
      if (cn < 5) { const bf16_t* ks = Kb + (size_t)(ATT_BASE(cn) + skey) * 128 + kvh * 64 + sseg * 8; n0 = *(const u32x4*)(ks); n1 = *(const u32x4*)(ks + 8); }
      const int dlo = c == 0 ? 0 : -100000, dhi = c == 2 ? 0 : 100000;
      const LAS unsigned char* kcur = KB0 + par * KBUF + fr * KROW + fq * 16;
#pragma unroll
      for (int qt = 0; qt < 2; ++qt) {
        const int iq = qoff + qt * 16 + fr; const int dq = 4 * fq - iq;
        const bf16_t* qp = Q + (size_t)(qrow0 + iq) * 512 + head * 64 + fq * 8;
        const bf16x8 q0 = *(const bf16x8*)(qp), q1 = *(const bf16x8*)(qp + 32);
        f32x4 st[8];
#pragma unroll
        for (int kt = 0; kt < 8; ++kt) {
          const bf16x8 k0 = *(const LAS bf16x8*)(kcur + kt * 16 * KROW), k1 = *(const LAS bf16x8*)(kcur + kt * 16 * KROW + 64);
          f32x4 sx = __builtin_amdgcn_mfma_f32_16x16x32_bf16(k0, q0, (f32x4){0.f, 0.f, 0.f, 0.f}, 0, 0, 0);
          st[kt] = __builtin_amdgcn_mfma_f32_16x16x32_bf16(k1, q1, sx, 0, 0, 0);
        }
        float mx = -1e30f;
        if (c == 0 || c == 2) {
#pragma unroll
          for (int kt = 0; kt < 8; ++kt)
#pragma unroll
            for (int j = 0; j < 4; ++j) {
              const int df = kt * 16 + j + dq;
              float sv = st[kt][j];
              if (df < dlo || df > dhi) sv = -1e30f;
              st[kt][j] = sv; mx = fmaxf(mx, sv);
            }
        } else {
#pragma unroll
          for (int kt = 0; kt < 8; ++kt)
#pragma unroll
            for (int j = 0; j < 4; ++j) mx = fmaxf(mx, st[kt][j]);
        }
        mx = fmaxf(mx, shx(mx, 16, lane)); mx = fmaxf(mx, shx(mx, 32, lane));
        const float mnew = fmaxf(mrun[qt], mx), alpha = __builtin_amdgcn_exp2f(mrun[qt] - mnew);
        mrun[qt] = mnew;
        float ls = 0.f;
#pragma unroll
        for (int kt = 0; kt < 8; ++kt)
#pragma unroll
          for (int j = 0; j < 4; ++j) { const float pv = __builtin_amdgcn_exp2f(st[kt][j] - mnew); st[kt][j] = pv; ls += pv; }
        lrun[qt] = lrun[qt] * alpha + ls;
#pragma unroll
        for (int dt = 0; dt < 4; ++dt) o[qt][dt] = o[qt][dt] * alpha;
#pragma unroll
        for (int kk = 0; kk < 4; ++kk) {
          u32x4 pw; pw.x = cvt_pk_bf16(st[2 * kk][0], st[2 * kk][1]); pw.y = cvt_pk_bf16(st[2 * kk][2], st[2 * kk][3]);
          pw.z = cvt_pk_bf16(st[2 * kk + 1][0], st[2 * kk + 1][1]); pw.w = cvt_pk_bf16(st[2 * kk + 1][2], st[2 * kk + 1][3]);
          const bf16x8 pf = __builtin_bit_cast(bf16x8, pw);
#pragma unroll
          for (int dt = 0; dt < 4; ++dt) {
            const LAS bf16_t* vp = VT + (dt * 16 + fr) * VSTR + c * 128 + kk * 32 + 4 * fq;
            u32x4 vw; const u32x2 va = *(const LAS u32x2*)(vp), vb = *(const LAS u32x2*)(vp + 16);
            vw.x = va.x; vw.y = va.y; vw.z = vb.x; vw.w = vb.y;
            o[qt][dt] = __builtin_amdgcn_mfma_f32_16x16x32_bf16(__builtin_bit_cast(bf16x8, vw), pf, o[qt][dt], 0, 0, 0);
          }
        }
      }
      if (cn < 5) { LAS unsigned char* kd = KB0 + (par ^ 1) * KBUF + skey * KROW + sseg * 16; *(LAS u32x4*)(kd) = n0; *(LAS u32x4*)(kd + 16) = n1; }
      __syncthreads();
      c = cn; par ^= 1;
    }
#pragma unroll
    for (int qt = 0; qt < 2; ++qt) {
      float l = lrun[qt]; l += shx(l, 16, lane); l += shx(l, 32, lane);
      const float inv = 1.0f / l;
      bf16_t* op = MIX + (size_t)(qrow0 + qoff + qt * 16 + fr) * D + 512 + head * 64 + 4 * fq;
#pragma unroll
      for (int dt = 0; dt < 4; ++dt) *(u32x2*)(op + dt * 16) = pack4(o[qt][dt] * inv);
    }
  }
  __syncthreads();
}
__device__ __forceinline__ void gate_unit(PK pk, int u, LAS unsigned char* lds) { const int tid_l = launder_v((int)threadIdx.x);
  const bf16_t* UZ = (const bf16_t*)(pk->ws + OFF_UZ); bf16_t* MIX = (bf16_t*)(pk->ws + OFF_MIXE); const bf16_t* WS = (const bf16_t*)(pk->ws + OFF_GMWS);
  const int tid = tid_l, wv = tid >> 6, lane = tid & 63, fr = lane & 15, fq = lane >> 4;
  const int n = u >> 2, g = u & 3, row0 = n * 128;
  LAS float* rstd = (LAS float*)lds; LAS bf16_t* ZT = (LAS bf16_t*)(lds + 512);
  { u32x4 w[16];
#pragma unroll
    for (int i = 0; i < 16; ++i) w[i] = *(const u32x4*)(UZ + (size_t)(row0 + wv * 16 + i) * D + 512 + lane * 8);
#pragma unroll
    for (int i = 0; i < 16; ++i) {
      float ss = bflo(w[i].x) * bflo(w[i].x) + bfhi(w[i].x) * bfhi(w[i].x) + bflo(w[i].y) * bflo(w[i].y) + bfhi(w[i].y) * bfhi(w[i].y) + bflo(w[i].z) * bflo(w[i].z) + bfhi(w[i].z) * bfhi(w[i].z) + bflo(w[i].w) * bflo(w[i].w) + bfhi(w[i].w) * bfhi(w[i].w);
      ss = wave_sum(ss, lane);
      if (lane == 0) rstd[wv * 16 + i] = rsqrtf(ss * (1.0f / 512.0f) + 1e-6f); } }
  __syncthreads();
#pragma unroll
  for (int i = 0; i < 2; ++i) { const int tp = lane, oc = wv + 8 * i;
    const bf16_t* zsrc = UZ + (size_t)(row0 + 2 * tp) * D + 512 + g * 128 + oc * 8;
    const u32x4 z0 = *(const u32x4*)(zsrc), z1 = *(const u32x4*)(zsrc + D);
    const float r0 = rstd[2 * tp], r1 = rstd[2 * tp + 1]; const float* gn = pk->in[I_GMG] + g * 128 + oc * 8;
    const f32x4 g0 = *(const f32x4*)(gn), g1 = *(const f32x4*)(gn + 4);
    LAS unsigned* zd = (LAS unsigned*)(ZT + (oc * 8) * 136 + 2 * tp);
    zd[0 * 68] = cvt_pk_bf16(bflo(z0.x) * r0 * g0[0], bflo(z1.x) * r1 * g0[0]); zd[1 * 68] = cvt_pk_bf16(bfhi(z0.x) * r0 * g0[1], bfhi(z1.x) * r1 * g0[1]);
    zd[2 * 68] = cvt_pk_bf16(bflo(z0.y) * r0 * g0[2], bflo(z1.y) * r1 * g0[2]); zd[3 * 68] = cvt_pk_bf16(bfhi(z0.y) * r0 * g0[3], bfhi(z1.y) * r1 * g0[3]);
    zd[4 * 68] = cvt_pk_bf16(bflo(z0.z) * r0 * g1[0], bflo(z1.z) * r1 * g1[0]); zd[5 * 68] = cvt_pk_bf16(bfhi(z0.z) * r0 * g1[1], bfhi(z1.z) * r1 * g1[1]);
    zd[6 * 68] = cvt_pk_bf16(bflo(z0.w) * r0 * g1[2], bflo(z1.w) * r1 * g1[2]); zd[7 * 68] = cvt_pk_bf16(bfhi(z0.w) * r0 * g1[3], bfhi(z1.w) * r1 * g1[3]); }
  __syncthreads();
  bf16x8 bw[4];
#pragma unroll
  for (int kk = 0; kk < 4; ++kk) bw[kk] = *(const bf16x8*)(WS + (size_t)(g * 128 + wv * 16 + fr) * 128 + kk * 32 + fq * 8);
  const int row = row0 + wv * 16 + fr;
  const float bsv = pk->in[I_GMBS][g * 128 + wv * 16 + fr];
#pragma unroll
  for (int ct = 0; ct < 8; ++ct) {
    f32x4 acc = {0.f, 0.f, 0.f, 0.f};
#pragma unroll
    for (int kk = 0; kk < 4; ++kk) { const bf16x8 a = *(const LAS bf16x8*)(ZT + (ct * 16 + fr) * 136 + kk * 32 + fq * 8); acc = __builtin_amdgcn_mfma_f32_16x16x32_bf16(a, bw[kk], acc, 0, 0, 0); }
    const int col = g * 128 + ct * 16 + 4 * fq;
    const f32x4 uu = unpack4(*(const u32x2*)(UZ + (size_t)row * D + col));
    *(u32x2*)(MIX + (size_t)row * D + col) = pack4(uu * (acc + bsv));
  }
  __syncthreads();
}

__device__ __forceinline__ void phase_conv(PK pk, const int bid, const int nb) { const int tid_l = launder_v((int)threadIdx.x);
  const bf16_t* __restrict__ XX = (const bf16_t*)(pk->ws + OFF_XX); bf16_t* __restrict__ XC = (bf16_t*)(pk->ws + OFF_XC);
  const float* __restrict__ cw = pk->in[I_CONVW]; const float* __restrict__ cb = pk->in[I_CONVB];
#pragma unroll 4
  for (int idx = bid * 512 + tid_l; idx < MR * 128; idx += nb * 512) {
    const int r = idx >> 7, c = (idx & 127) * 8;
    int pos, len; if (r < MX) { pos = r & (SEQ - 1); len = SEQ; } else { pos = (r - MX) & (CTXL - 1); len = CTXL; }
    float a[8];
#pragma unroll
    for (int e = 0; e < 8; ++e) a[e] = cb[c + e];
#pragma unroll
    for (int j = 0; j < 4; ++j) { const int pp = pos - 1 + j;
      if (pp >= 0 && pp < len) { const u32x4 w = *(const u32x4*)(XX + (size_t)(r - 1 + j) * D + c); const float* cwj = cw + j * 1024 + c;
        a[0] += cwj[0] * bflo(w.x); a[1] += cwj[1] * bfhi(w.x); a[2] += cwj[2] * bflo(w.y); a[3] += cwj[3] * bfhi(w.y);
        a[4] += cwj[4] * bflo(w.z); a[5] += cwj[5] * bfhi(w.z); a[6] += cwj[6] * bflo(w.w); a[7] += cwj[7] * bfhi(w.w); } }
    u32x4 o; o.x = cvt_pk_bf16(a[0], a[1]); o.y = cvt_pk_bf16(a[2], a[3]); o.z = cvt_pk_bf16(a[4], a[5]); o.w = cvt_pk_bf16(a[6], a[7]);
    *(u32x4*)(XC + (size_t)r * D + c) = o;
  }
}
__device__ __forceinline__ void scan_item(int it, int& b, int& ci, int& row0, int& len) {
  if (it < 1024) { b = it >> 9; const int lc = it & 511; ci = 32 + lc; row0 = b * SEQ + lc * 32; len = 32; }
  else { const int j = it - 1024; b = j >> 5; ci = j & 31; row0 = MX + b * CTXL + ci * 8; len = 8; }
}
#define SCAN_STEP(H, LAW, BW) do { \
    H[0] = __expf(bflo(LAW.x)) * H[0] + bflo(BW.x); H[1] = __expf(bfhi(LAW.x)) * H[1] + bfhi(BW.x); \
    H[2] = __expf(bflo(LAW.y)) * H[2] + bflo(BW.y); H[3] = __expf(bfhi(LAW.y)) * H[3] + bfhi(BW.y); \
    H[4] = __expf(bflo(LAW.z)) * H[4] + bflo(BW.z); H[5] = __expf(bfhi(LAW.z)) * H[5] + bfhi(BW.z); \
    H[6] = __expf(bflo(LAW.w)) * H[6] + bflo(BW.w); H[7] = __expf(bfhi(LAW.w)) * H[7] + bfhi(BW.w); } while (0)
#define SCAN_ACCP(P, LAW) do { P[0] += bflo(LAW.x); P[1] += bfhi(LAW.x); P[2] += bflo(LAW.y); P[3] += bfhi(LAW.y); P[4] += bflo(LAW.z); P[5] += bfhi(LAW.z); P[6] += bflo(LAW.w); P[7] += bfhi(LAW.w); } while (0)
__device__ __forceinline__ void phase_scan1(PK pk, const int bid, const int nb) { const int tid_l = launder_v((int)threadIdx.x);
  const bf16_t* __restrict__ LAB = (const bf16_t*)(pk->ws + OFF_LAB); float* __restrict__ PE = (float*)(pk->ws + OFF_PE);
  const int ch = (tid_l & 127) * 8;
  for (int it = bid * 4 + (tid_l >> 7); it < 1088; it += nb * 4) {
    int b, ci, row0, len; scan_item(it, b, ci, row0, len);
#pragma unroll
    for (int d = 0; d < 2; ++d) {
      const bf16_t* __restrict__ LA = LAB + (size_t)(2 * d) * MR * D + ch; const bf16_t* __restrict__ BB = LAB + (size_t)(2 * d + 1) * MR * D + ch;
      float H[8], P[8];
#pragma unroll
      for (int e = 0; e < 8; ++e) { H[e] = 0.f; P[e] = 0.f; }
#pragma unroll 1
      for (int t0 = 0; t0 < len; t0 += 8) {
        u32x4 lw[8], bw[8];
#pragma unroll
        for (int k = 0; k < 8; ++k) { const int r = row0 + (d == 0 ? t0 + k : len - 1 - t0 - k); lw[k] = *(const u32x4*)(LA + (size_t)r * D); bw[k] = *(const u32x4*)(BB + (size_t)r * D); }
#pragma unroll
        for (int k = 0; k < 8; ++k) { SCAN_STEP(H, lw[k], bw[k]); SCAN_ACCP(P, lw[k]); }
      }
      float* pp = PE + ((size_t)(d * 2 + b) * NCH + ci) * 1024 + ch; float* ep = pp + (size_t)2 * 2 * NCH * 1024;
      *(f32x4*)(pp) = (f32x4){P[0], P[1], P[2], P[3]}; *(f32x4*)(pp + 4) = (f32x4){P[4], P[5], P[6], P[7]};
      *(f32x4*)(ep) = (f32x4){H[0], H[1], H[2], H[3]}; *(f32x4*)(ep + 4) = (f32x4){H[4], H[5], H[6], H[7]};
    }
  }
}
__device__ __forceinline__ void phase_scan2(PK pk, const int bid, const int nb) { const int tid_l = launder_v((int)threadIdx.x);
  const float* PE = (const float*)(pk->ws + OFF_PE); float* HIN = (float*)(pk->ws + OFF_HIN);
  if (bid >= 64 || tid_l >= 64) return;
  const int id = bid * 64 + tid_l, d = id >> 11, b = (id >> 10) & 1, ch = id & 1023;
  const float* pp = PE + (size_t)(d * 2 + b) * NCH * 1024 + ch; const float* ep = pp + (size_t)2 * 2 * NCH * 1024;
  float* hp = HIN + (size_t)(d * 2 + b) * NCH * 1024 + ch;
  float H = 0.f;
#pragma unroll 1
  for (int s0 = 0; s0 < NCH; s0 += 32) {
    float pv[32], ev[32];
#pragma unroll
    for (int k = 0; k < 32; ++k) { const int s = s0 + k; const int ci = d == 0 ? s : (s < 32 ? 31 - s : 575 - s); pv[k] = pp[(size_t)ci * 1024]; ev[k] = ep[(size_t)ci * 1024]; }
#pragma unroll
    for (int k = 0; k < 32; ++k) { const int s = s0 + k; const int ci = d == 0 ? s : (s < 32 ? 31 - s : 575 - s); hp[(size_t)ci * 1024] = H; H = __expf(pv[k]) * H + ev[k]; }
  }
}
__device__ __forceinline__ void phase_scan3(PK pk, LAS unsigned char* lds, const int bid, const int nb) { const int tid_l = launder_v((int)threadIdx.x);
  const bf16_t* __restrict__ LAB = (const bf16_t*)(pk->ws + OFF_LAB); const float* __restrict__ HIN = (const float*)(pk->ws + OFF_HIN);
  const bf16_t* __restrict__ G = (const bf16_t*)(pk->ws + OFF_G); bf16_t* MIX = (bf16_t*)(pk->ws + OFF_MIXO);
  const int ch = (tid_l & 127) * 8;
  LAS u32x4* slot = (LAS u32x4*)lds + tid_l;
#define S3_FWD_BATCH(T0, SINK) do { u32x4 lw[8], bw[8]; \
        _Pragma("unroll") for (int k = 0; k < 8; ++k) { const int r = row0 + (T0) + k; lw[k] = *(const u32x4*)(LA + (size_t)r * D); bw[k] = *(const u32x4*)(BB + (size_t)r * D); } \
        _Pragma("unroll") for (int k = 0; k < 8; ++k) { SCAN_STEP(H, lw[k], bw[k]); \
          u32x4 o; o.x = cvt_pk_bf16(H[0], H[1]); o.y = cvt_pk_bf16(H[2], H[3]); o.z = cvt_pk_bf16(H[4], H[5]); o.w = cvt_pk_bf16(H[6], H[7]); SINK; } } while (0)
#define S3_BWD_BATCH(T0, SRC) do { u32x4 lw[8], bw[8], gw[8]; \
        _Pragma("unroll") for (int k = 0; k < 8; ++k) { const int r = row0 + (T0) + 7 - k; lw[k] = *(const u32x4*)(LA + (size_t)r * D); bw[k] = *(const u32x4*)(BB + (size_t)r * D); gw[k] = *(const u32x4*)(G + (size_t)r * D + ch); } \
        _Pragma("unroll") for (int k = 0; k < 8; ++k) { const int r = row0 + (T0) + 7 - k; SCAN_STEP(H, lw[k], bw[k]); const u32x4 hf = SRC, gg = gw[k]; u32x4 o_; \
          o_.x = cvt_pk_bf16((bflo(hf.x) + H[0]) * bflo(gg.x), (bfhi(hf.x) + H[1]) * bfhi(gg.x)); \
          o_.y = cvt_pk_bf16((bflo(hf.y) + H[2]) * bflo(gg.y), (bfhi(hf.y) + H[3]) * bfhi(gg.y)); \
          o_.z = cvt_pk_bf16((bflo(hf.z) + H[4]) * bflo(gg.z), (bfhi(hf.z) + H[5]) * bfhi(gg.z)); \
          o_.w = cvt_pk_bf16((bflo(hf.w) + H[6]) * bflo(gg.w), (bfhi(hf.w) + H[7]) * bfhi(gg.w)); \
          *(u32x4*)(MIX + (size_t)r * D + ch) = o_; } } while (0)
  for (int it = bid * 4 + (tid_l >> 7); it < 1024  ; it += nb * 4) {
    int b, ci, row0, len; scan_item(it, b, ci, row0, len);
    u32x4 hfr[8];
    { const bf16_t* LA = LAB + ch; const bf16_t* __restrict__ BB = LAB + (size_t)MR * D + ch;
      const float* hp = HIN + ((size_t)(0 * 2 + b) * NCH + ci) * 1024 + ch;
      const f32x4 h0 = *(const f32x4*)(hp), h1 = *(const f32x4*)(hp + 4);
      float H[8] = {h0[0], h0[1], h0[2], h0[3], h1[0], h1[1], h1[2], h1[3]};
#pragma unroll 1
      for (int t0 = 0; t0 < 16; t0 += 8) S3_FWD_BATCH(t0, slot[(t0 + k) * 512] = o);
      S3_FWD_BATCH(16, *(u32x4*)(MIX + (size_t)(row0 + 16 + k) * D + ch) = o);
      S3_FWD_BATCH(24, hfr[k] = o);
    }
    { const bf16_t* __restrict__ LA = LAB + (size_t)2 * MR * D + ch; const bf16_t* __restrict__ BB = LAB + (size_t)3 * MR * D + ch;
      const float* hp = HIN + ((size_t)(1 * 2 + b) * NCH + ci) * 1024 + ch;
      const f32x4 h0 = *(const f32x4*)(hp), h1 = *(const f32x4*)(hp + 4);
      float H[8] = {h0[0], h0[1], h0[2], h0[3], h1[0], h1[1], h1[2], h1[3]};
      S3_BWD_BATCH(24, hfr[7 - k]);
      { u32x4 hfw[8];
#pragma unroll
        for (int k = 0; k < 8; ++k) hfw[k] = *(const u32x4*)(MIX + (size_t)(row0 + 23 - k) * D + ch);
        S3_BWD_BATCH(16, hfw[k]); }
#pragma unroll 1
      for (int t0 = 8; t0 >= 0; t0 -= 8) S3_BWD_BATCH(t0, slot[(t0 + 7 - k) * 512]);
    }
  }
#undef S3_FWD_BATCH
#undef S3_BWD_BATCH
}

#define XB_TMO      128
#define XB_XCNT(j)  (256  + 64 * (j))
#define XB_XSUB(j)  (1280 + 64 * (j))
#define XB_XGEN(j)  (2304 + 64 * (j))
#define XB_TOP      3328
#define XB_TOPGEN   3392
#define XCD_BAR_WORDS 3456
#define XB_SPIN_CAP (1u << 22)
__device__ __forceinline__ unsigned xb_ld(unsigned* p)              { return __hip_atomic_load(p, __ATOMIC_RELAXED, __HIP_MEMORY_SCOPE_AGENT); }
__device__ __forceinline__ unsigned xb_add(unsigned* p, unsigned v) { return __hip_atomic_fetch_add(p, v, __ATOMIC_RELAXED, __HIP_MEMORY_SCOPE_AGENT); }
__device__ __forceinline__ unsigned xb_xcc_id() { return (unsigned)__builtin_amdgcn_s_getreg((3 << 11) | 20) & 0xFu; }
#define XB_SPIN(cond, bar) do { unsigned _sp = 0; while (cond) { __builtin_amdgcn_s_sleep(1); \
    if ((++_sp & 255u) == 0u) { if (xb_ld(&(bar)[XB_TMO])) break; if (_sp > XB_SPIN_CAP) { atomicAdd(&(bar)[XB_TMO], 1u); break; } } } } while (0)
__device__ __forceinline__ void xcd_barrier_complete(unsigned* bar, unsigned x, unsigned& nloc, unsigned& nx) {
    const unsigned G = gridDim.x * gridDim.y * gridDim.z;
    unsigned sum, cnt, mine, sp = 0u;
    for (;;) {
        sum = 0u; cnt = 0u; mine = 0u;
#pragma unroll
        for (unsigned j = 0; j < 16; ++j) { const unsigned c = xb_ld(&bar[XB_XCNT(j)]); sum += c; cnt += (c > 0u) ? 1u : 0u; mine = (j == x) ? c : mine; }
        if (sum == G) break;
        __builtin_amdgcn_s_sleep(1);
        if ((++sp & 255u) == 0u) { if (xb_ld(&bar[XB_TMO])) break; if (sp > XB_SPIN_CAP) { atomicAdd(&bar[XB_TMO], 1u); break; } }
    }
    nloc = mine > 0u ? mine : 1u; nx = cnt > 0u ? cnt : 1u;
}
__device__ __forceinline__ void xcd_barrier(LAS unsigned char* lds) {
    asm volatile("s_waitcnt vmcnt(0)" ::: "memory");
    __syncthreads();
    if (threadIdx.x == 0) {
        PK pk_ = get_pk(); unsigned* bar = (unsigned*)(pk_->ws + OFF_BAR);
        volatile LAS unsigned* st = (volatile LAS unsigned*)(lds + 131072);
        const unsigned x = xb_xcc_id();
        __builtin_amdgcn_s_waitcnt(0);
        unsigned nloc = st[0], nx = st[1];
        if (nloc == 0u) { xcd_barrier_complete(bar, x, nloc, nx); st[0] = nloc; st[1] = nx; }
        const unsigned old = xb_add(&bar[XB_XSUB(x)], 1u);
        const unsigned gen = old / nloc;
        if (old + 1u == (gen + 1u) * nloc) {
            __builtin_amdgcn_fence(__ATOMIC_RELEASE, "agent");
            asm volatile("s_waitcnt vmcnt(0)" ::: "memory");
            const unsigned og = xb_add(&bar[XB_TOP], 1u);
            const unsigned tg = og / nx;
            if (og + 1u == (tg + 1u) * nx) xb_add(&bar[XB_TOPGEN], 1u);
            else XB_SPIN(xb_ld(&bar[XB_TOPGEN]) == tg, bar);
            __builtin_amdgcn_fence(__ATOMIC_ACQUIRE, "agent");
            xb_add(&bar[XB_XGEN(x)], 1u);
            asm volatile("s_waitcnt vmcnt(0)" ::: "memory");
        } else {
            XB_SPIN(xb_ld(&bar[XB_XGEN(x)]) == gen, bar);
            __builtin_amdgcn_fence(__ATOMIC_ACQUIRE, "agent");
            asm volatile("s_waitcnt vmcnt(0)" ::: "memory");
        }
    }
    __syncthreads();
}

#ifdef TPROBE
#define TSTAMP(k) do { PK pk_ = get_pk(); unsigned long long* ta_ = (unsigned long long*)(pk_->ws + OFF_PE); if (blockIdx.x == 0 && threadIdx.x == 0) { const unsigned long long now_ = wall_clock64(); ta_[k] += now_ - ta_[15]; ta_[15] = now_; } } while (0)
#else
#define TSTAMP(k) do {} while (0)
#endif
#define PHASE_VARS PK pk = get_pk(); const int bid = launder_i(cid), G = launder_i((int)gridDim.x); unsigned char* ws = pk->ws; (void)ws; (void)bid; (void)G
#define ZERO_RS(buf) do { float* z_ = (float*)(ws + OFF_RS) + (size_t)(buf) * MR; for (int i_ = bid * 512 + (int)threadIdx.x; i_ < MX; i_ += G * 512) z_[i_] = 0.f; } while (0)
__global__ void __launch_bounds__(512, 2) fwd_mega(Params p_unused) {
  extern __shared__ __attribute__((aligned(16))) unsigned char shm[];
  LAS unsigned char* lds = (LAS unsigned char*)shm;
  cg::grid_group grid = cg::this_grid();
  const int cid = (int)blockIdx.x;
  { PK pk_ = get_pk();
    if (threadIdx.x == 0) { const unsigned x = xb_xcc_id();
      ((volatile LAS unsigned*)(lds + 131072))[0] = 0u; ((volatile LAS unsigned*)(lds + 131072))[1] = 0u;
      (void)xb_add((unsigned*)(pk_->ws + OFF_BAR) + XB_XCNT(x), 1u); }
    __syncthreads(); }
#ifdef TPROBE
  { PK pk_ = get_pk(); unsigned long long* ta_ = (unsigned long long*)(pk_->ws + OFF_PE); if (blockIdx.x == 0 && threadIdx.x < 16) ta_[threadIdx.x] = threadIdx.x == 15 ? (unsigned long long)wall_clock64() : 0ull; }
#endif

  { PHASE_VARS; prologue(pk, lds, bid, G); }
  grid.sync();
#ifdef REP_PRO2
  { PHASE_VARS; prologue(pk, lds, bid, G); }
  xcd_barrier(lds);
#endif
  { PHASE_VARS; prologue2(pk, bid, G); }
  xcd_barrier(lds); TSTAMP(0);
#pragma unroll 1
  for (int l = 0; l < 2; ++l) {
#pragma unroll 1
    for (int s3 = 0; s3 < 3; ++s3) {
      const bool first = (l == 0 && s3 == 0);
      const bool lastp = (l == 1 && s3 == 2);
      const int q = l * 3 + s3, rb = q & 1;
      { PHASE_VARS;
        phase_prep(pk->in[I_X], (float*)(ws + OFF_CTXR), (const float*)(ws + OFF_GS) + (size_t)q * 3072, (bf16_t*)(ws + OFF_H), (float*)(ws + OFF_RS) + (size_t)rb * MR, first ? 0 : (lastp ? MR : MX),
                   (const float*)(ws + (s3 == 2 ? OFF_BIG : OFF_EXTRA)), first ? 0 : (s3 == 2 ? 4 : 11), (const float*)(ws + OFF_RSP), !first, bid, G); }
      xcd_barrier(lds); TSTAMP(1);
      if (s3 != 1) {
        const int f = s3 >> 1, j = l * 2 + f;
        { PHASE_VARS;
          pg8::Gemm g{(const bf16_t*)(ws + OFF_H), (const bf16_t*)(ws + OFF_W1 + j * SZ_W1), MR, 2 * FF, D, D, 0, 0};
          pg8::StaticOrder S; S.init(lastp ? MX : g.M, g.N, g.K, G, bid);
          EpiSwiglu e{(bf16_t*)(ws + OFF_BIG), (const float*)(ws + OFF_RS) + (size_t)rb * MR, (const float*)(ws + OFF_BIASF) + (size_t)j * 3 * 5632};
          pg8::gemm_phase(lds, g, S, e); }
        xcd_barrier(lds); TSTAMP(2);
        { PHASE_VARS;
          pg8::Gemm g{(const bf16_t*)(ws + OFF_BIG), (const bf16_t*)(ws + OFF_W2 + j * SZ_W2), MR, D, FF, FF, 0, 1};
          pg8::StaticOrder S; if (lastp) S.init(MX, g.N, g.K, G, bid); else S.init_split(g.N, g.K, G, bid, 11);
          if (first) { EpiResid<true, true> e{pk->in[I_X], (bf16_t*)pk->out, ws, q}; pg8::gemm_phase(lds, g, S, e); }
          else { EpiResid<false, true> e{pk->in[I_X], (bf16_t*)pk->out, ws, q}; pg8::gemm_phase(lds, g, S, e); } }
        xcd_barrier(lds); TSTAMP(3);
      } else if (l == 0) {
        { PHASE_VARS;
          pg8::Gemm g{(const bf16_t*)(ws + OFF_H), (const bf16_t*)(ws + OFF_EVIN), MR, EVIN_N, D, D, 0, 0};
          pg8::StaticOrder S; S.init(g.M, g.N, g.K, G, bid);
          EpiEvenIn e{(bf16_t*)(ws + OFF_UZ), (bf16_t*)(ws + OFF_Q), (bf16_t*)(ws + OFF_K), (bf16_t*)(ws + OFF_V), (const float*)(ws + OFF_ROPE), (const float*)(ws + OFF_ROPE) + 4096,
                      (const float*)(ws + OFF_RS) + (size_t)rb * MR, (const float*)(ws + OFF_BIASE)};
          pg8::gemm_phase(lds, g, S, e); }
        xcd_barrier(lds); TSTAMP(4);
#ifndef REP_ATT
#define REP_ATT 1
#endif
#ifndef ATT_LO
#define ATT_LO 0
#define ATT_HI 1560
#endif
        for (int rep = 0; rep < REP_ATT; ++rep) {
        { PHASE_VARS;
          for (int u = bid + (rep ? ATT_LO : 0); u < (rep ? ATT_HI : 520 + 1040); u += G) { if (u < 520) attn_unit(pk, u, lds); else gate_unit(pk, u - 520, lds); } }
        xcd_barrier(lds); } TSTAMP(5);
        { PHASE_VARS;
          pg8::Gemm g{(const bf16_t*)(ws + OFF_MIXE), (const bf16_t*)(ws + OFF_EVOUT), MR, D, D, D, 0, 0};
          pg8::StaticOrder S; S.init_split(g.N, g.K, G, bid, 4);
          EpiResid<false, false> e{pk->in[I_X], (bf16_t*)pk->out, ws, q};
          pg8::gemm_phase(lds, g, S, e); }
        xcd_barrier(lds); TSTAMP(6);
      } else {
        { PHASE_VARS;
          pg8::Gemm g{(const bf16_t*)(ws + OFF_H), (const bf16_t*)(ws + OFF_ODIN), MR, 2048, D, D, 0, 0};
          pg8::StaticOrder S; S.init(g.M, g.N, g.K, G, bid);
          EpiOddIn e{(bf16_t*)(ws + OFF_G), (bf16_t*)(ws + OFF_XX), (const float*)(ws + OFF_RS) + (size_t)rb * MR, (const float*)(ws + OFF_BIASO)};
          pg8::gemm_phase(lds, g, S, e); }
        xcd_barrier(lds); TSTAMP(7);
        { PHASE_VARS; phase_conv(pk, bid, G); }
        xcd_barrier(lds); TSTAMP(8);
        { PHASE_VARS;
          pg8::Gemm g{(const bf16_t*)(ws + OFF_XC), (const bf16_t*)(ws + OFF_RGW), MR, 4096, 256, D, 1, 0};
          pg8::StaticOrder S; S.init(g.M, g.N, g.K, G, bid);
          EpiRG e{(const bf16_t*)(ws + OFF_XC), (bf16_t*)(ws + OFF_LAB), pk->in[I_RGBA], pk->in[I_RGBX], (const float*)(ws + OFF_SP)};
          pg8::gemm_phase(lds, g, S, e); }
        xcd_barrier(lds); TSTAMP(9);
        { PHASE_VARS; phase_scan1(pk, bid, G); }
        xcd_barrier(lds); TSTAMP(10);
        { PHASE_VARS; phase_scan2(pk, bid, G); }
        xcd_barrier(lds); TSTAMP(11);
        { PHASE_VARS; phase_scan3(pk, lds, bid, G); }
        xcd_barrier(lds); TSTAMP(12);
        { PHASE_VARS;
          pg8::Gemm g{(const bf16_t*)(ws + OFF_MIXO), (const bf16_t*)(ws + OFF_ODOUT), MR, D, D, D, 0, 0};
          pg8::StaticOrder S; S.init(MX, g.N, g.K, G, bid);
          EpiResid<false, false> e{pk->in[I_X], (bf16_t*)pk->out, ws, q};
          pg8::gemm_phase(lds, g, S, e); }
        xcd_barrier(lds); TSTAMP(13);
      }
    }
  }
  { PHASE_VARS; phase_final_norm(pk->out, (const bf16_t*)(ws + OFF_H), pk->in[I_FNG], bid, G); }
}

extern "C" void kernel_launch(void* const* d_in, const int* in_sizes, int n_in, void* d_out, int out_size,
                              void* d_ws, size_t ws_size, hipStream_t stream) {
  static int grid_blocks = 0;
  if (!grid_blocks) {
    int dev = 0, cus = 0, per_cu = 0;
    (void)hipGetDevice(&dev);
    (void)hipDeviceGetAttribute(&cus, hipDeviceAttributeMultiprocessorCount, dev);
    (void)hipFuncSetAttribute((const void*)fwd_mega, hipFuncAttributeMaxDynamicSharedMemorySize, LDS_BYTES);
    (void)hipOccupancyMaxActiveBlocksPerMultiprocessor(&per_cu, (const void*)fwd_mega, 512, LDS_BYTES);
    (void)hipGetLastError();
    grid_blocks = cus > 0 ? cus : 256;
    if (ws_size < WS_NEED2 || n_in != 26) { fprintf(stderr, "kernel_launch: ws_size %zu < %zu or n_in %d != 26\n", ws_size, (size_t)WS_NEED, n_in); grid_blocks = -1; }
  }
  if (grid_blocks < 0) return;
  Params p{};
  for (int i = 0; i < 26; ++i) p.in[i] = (const float*)d_in[i];
  p.out = (float*)d_out; p.ws = (unsigned char*)d_ws;
  (void)hipMemsetAsync((unsigned char*)d_ws + OFF_CNT, 0, 256 + 3456 * 4, stream);
  void* args[] = {&p};
  hipError_t e = hipLaunchCooperativeKernel((const void*)fwd_mega, dim3(grid_blocks), dim3(512), args, LDS_BYTES, stream);
  if (e != hipSuccess) fprintf(stderr, "cooperative launch failed: %s (grid %d)\n", hipGetErrorString(e), grid_blocks);
}
```
